# Optimizing an MI355X kernel written in HIP

```python
import jax
import jax.numpy as jnp
from jax import lax
import numpy as np

D_MODEL = 1024
BATCH = 8
SEQ = 4096
DEPTH = 2

GRID_W = 64
CTX_LEN = 256
HEAD_DIM = 64
BRANCH_WIDTH = 512
N_BRANCH = 3
SGU_GROUPS = 4
SGU_GROUP_DIM = BRANCH_WIDTH // SGU_GROUPS
SGU_CHUNK = 128
SWA_Q_HEADS = BRANCH_WIDTH // HEAD_DIM
SWA_KV_HEADS = 2
SWA_GROUP = SWA_Q_HEADS // SWA_KV_HEADS
SWA_WINDOW = 128
SWA_BLOCK = 128
ROPE_BASE = 10000.0
GLA_HEADS = 4
GLA_DK = 64
GLA_DV = BRANCH_WIDTH // GLA_HEADS
GLA_RANK = 16
GLA_NORMALIZER = 16.0
GLA_CHUNK = 64
FFN_DIM = 4 * D_MODEL
EPS = 1e-6

IN_SPLITS = (
    BRANCH_WIDTH, BRANCH_WIDTH,
    SWA_Q_HEADS * HEAD_DIM, SWA_KV_HEADS * HEAD_DIM, SWA_KV_HEADS * HEAD_DIM,
    GLA_HEADS * GLA_DK, GLA_HEADS * GLA_DK, BRANCH_WIDTH, BRANCH_WIDTH,
    GLA_RANK, GLA_RANK,
    N_BRANCH * D_MODEL,
)
IN_DIM = sum(IN_SPLITS)

kernel_name = 'hybrid_gated_dit_block'


def rms_norm(x, gain=None):
    xf = x.astype(jnp.float32)
    y = xf * lax.rsqrt(jnp.mean(xf * xf, axis=-1, keepdims=True) + EPS)
    if gain is not None:
        y = y * gain.astype(jnp.float32)
    return y.astype(x.dtype)


def adaln(cond, w_ada, b_ada):
    return jnp.split(jax.nn.silu(cond) @ w_ada + b_ada, 6, axis=-1)


def modulate(x, shift, scale):
    return rms_norm(x) * (1.0 + scale) + shift


def project(h, w_in):
    idx = np.cumsum(IN_SPLITS)[:-1].tolist()
    return jnp.split(h @ w_in, idx, axis=-1)


def heads(t, dim):
    return t.reshape(*t.shape[:-1], -1, dim)


def axial_rope(x, row, col):
    n_freq = HEAD_DIM // 4
    freqs = ROPE_BASE ** (-jnp.arange(n_freq, dtype=jnp.float32) / n_freq)

    def rotate(xa, pos):
        ang = pos.astype(jnp.float32)[:, None] * freqs[None, :]
        cos = jnp.cos(ang)[None, :, None, :]
        sin = jnp.sin(ang)[None, :, None, :]
        x1, x2 = xa[..., :n_freq], xa[..., n_freq:]
        return jnp.concatenate([x1 * cos - x2 * sin, x1 * sin + x2 * cos], axis=-1)

    xf = x.astype(jnp.float32)
    half = HEAD_DIM // 2
    out = jnp.concatenate([rotate(xf[..., :half], row), rotate(xf[..., half:], col)], axis=-1)
    return out.astype(x.dtype)


def sgu_mix(u, v, gain, w_s, b_s):
    B, L, _ = u.shape
    nc = L // SGU_CHUNK
    u = jax.nn.gelu(u)
    v = rms_norm(jax.nn.gelu(v).reshape(B, L, SGU_GROUPS, SGU_GROUP_DIM),
                 gain.reshape(SGU_GROUPS, SGU_GROUP_DIM))
    v = v.reshape(B, nc, SGU_CHUNK, SGU_GROUPS, SGU_GROUP_DIM)
    s = jnp.einsum('gpq,bcqgd->bcpgd', w_s, v) + b_s.T[None, None, :, :, None]
    return u * s.reshape(B, L, BRANCH_WIDTH)


def swa_latent(q, k, v, k_ctx, v_ctx, sink):
    B, N = q.shape[0], q.shape[1]
    n_blk = N // SWA_BLOCK
    pad = ((0, 0), (SWA_BLOCK, SWA_BLOCK), (0, 0), (0, 0))
    k_pad = jnp.pad(k, pad)
    v_pad = jnp.pad(v, pad)
    scale = HEAD_DIM ** -0.5
    sink_l = jnp.broadcast_to(sink.reshape(SWA_KV_HEADS, SWA_GROUP).astype(jnp.float32)[None, :, :, None, None],
                              (B, SWA_KV_HEADS, SWA_GROUP, SWA_BLOCK, 1))
    rel = (jnp.arange(3 * SWA_BLOCK) - SWA_BLOCK)[None, :] - jnp.arange(SWA_BLOCK)[:, None]
    n_loc = 3 * SWA_BLOCK

    def one_block(i):
        start = i * SWA_BLOCK
        qb = lax.dynamic_slice_in_dim(q, start, SWA_BLOCK, axis=1)
        kb = lax.dynamic_slice_in_dim(k_pad, start, n_loc, axis=1)
        vb = lax.dynamic_slice_in_dim(v_pad, start, n_loc, axis=1)
        kpos = start - SWA_BLOCK + jnp.arange(n_loc)
        valid = (jnp.abs(rel) <= SWA_WINDOW) & ((kpos >= 0) & (kpos < N))[None, :]
        s_loc = jnp.einsum('bqhgd,bkhd->bhgqk', qb, kb).astype(jnp.float32) * scale
        s_loc = jnp.where(valid, s_loc, -jnp.inf)
        s_ctx = jnp.einsum('bqhgd,bkhd->bhgqk', qb, k_ctx).astype(jnp.float32) * scale
        p = jax.nn.softmax(jnp.concatenate([s_loc, s_ctx, sink_l], axis=-1), axis=-1).astype(v.dtype)
        o = jnp.einsum('bhgqk,bkhd->bqhgd', p[..., :n_loc], vb)
        o = o + jnp.einsum('bhgqk,bkhd->bqhgd', p[..., n_loc:n_loc + k_ctx.shape[1]], v_ctx)
        return o

    out = lax.map(one_block, jnp.arange(n_blk))
    return jnp.moveaxis(out, 0, 1).reshape(B, N, BRANCH_WIDTH)


def ctx_attention(q, k, v, sink):
    B, C = q.shape[0], q.shape[1]
    s = jnp.einsum('bqhgd,bkhd->bhgqk', q, k).astype(jnp.float32) * HEAD_DIM ** -0.5
    s_sink = jnp.broadcast_to(sink.reshape(SWA_KV_HEADS, SWA_GROUP).astype(jnp.float32)[None, :, :, None, None],
                              (B, SWA_KV_HEADS, SWA_GROUP, C, 1))
    p = jax.nn.softmax(jnp.concatenate([s, s_sink], axis=-1), axis=-1)[..., :-1].astype(v.dtype)
    return jnp.einsum('bhgqk,bkhd->bqhgd', p, v).reshape(B, C, BRANCH_WIDTH)


def gla_log_decay(z, w2, b2):
    logit = (z @ w2 + b2).astype(jnp.float32)
    return (jax.nn.log_sigmoid(logit) / GLA_NORMALIZER).reshape(*z.shape[:-1], GLA_HEADS, GLA_DK)


def gla_chunked(q, k, v, g, s0):
    B, L, H, DK = q.shape
    DV = v.shape[-1]
    nc = L // GLA_CHUNK

    def chunks(t):
        return t.astype(jnp.float32).reshape(B, nc, GLA_CHUNK, H, t.shape[-1])

    q = chunks(q) * GLA_DK ** -0.5
    k, v, g = chunks(k), chunks(v), chunks(g)
    b = jnp.cumsum(g, axis=2)
    b_ref = b[:, :, GLA_CHUNK // 2][:, :, None]
    b_tot = b[:, :, -1]
    scores = jnp.einsum('bclhd,bcmhd->bchlm', q * jnp.exp(b - b_ref), k * jnp.exp(b_ref - b))
    lower = jnp.tril(jnp.ones((GLA_CHUNK, GLA_CHUNK), dtype=bool))
    scores = jnp.where(lower, scores, 0.0)
    o_intra = jnp.einsum('bchlm,bcmhv->bclhv', scores, v)
    q_in = q * jnp.exp(b)
    k_out = k * jnp.exp(b_tot[:, :, None] - b)

    def step(state, inp):
        q_c, k_c, v_c, bt = inp
        o_c = jnp.einsum('blhd,bhdv->blhv', q_c, state)
        state = state * jnp.exp(bt)[..., None] + jnp.einsum('blhd,blhv->bhdv', k_c, v_c)
        return state, o_c

    xs = (jnp.moveaxis(q_in, 1, 0), jnp.moveaxis(k_out, 1, 0), jnp.moveaxis(v, 1, 0), jnp.moveaxis(b_tot, 1, 0))
    s_fin, o_inter = lax.scan(step, s0.astype(jnp.float32), xs)
    o = o_intra + jnp.moveaxis(o_inter, 0, 1)
    return o.reshape(B, L, H, DV), s_fin


def gla_bidir(q, k, v, g_f, g_b, s_f, s_b):
    o_f, sf = gla_chunked(q, k, v, g_f, s_f)
    o_b, sb = gla_chunked(jnp.flip(q, 1), jnp.flip(k, 1), jnp.flip(v, 1), jnp.flip(g_b, 1), s_b)
    return o_f + jnp.flip(o_b, 1), sf, sb


def gla_out(o, r, gain):
    return rms_norm(o, gain).astype(r.dtype).reshape(r.shape) * jax.nn.silu(r)


def merge_branches(a, b, cc, gates, w_br, w_o):
    br = jnp.stack([a, b, cc], axis=-2)
    proj = jnp.einsum('blkw,kwd->blkd', br, w_br)
    gate = jax.nn.sigmoid(gates.reshape(*gates.shape[:-1], N_BRANCH, D_MODEL))
    return jnp.sum(gate * proj, axis=-2) @ w_o


def sq_relu_ffn(h, w1, w2):
    return jnp.square(jax.nn.relu(h @ w1)) @ w2


def setup_inputs(seed: int = 0) -> dict:
    key = jax.random.key(seed)
    ks = jax.random.split(key, 24)

    def nrm(k, shape, scale):
        return jax.random.normal(k, shape, jnp.float32) * scale

    def gain(k, shape):
        return 1.0 + 0.02 * jax.random.normal(k, shape, jnp.float32)

    return {
        'x': nrm(ks[0], (BATCH, SEQ, D_MODEL), 1.0),
        'c': nrm(ks[1], (BATCH, D_MODEL), 1.0),
        'ctx': nrm(ks[2], (BATCH, CTX_LEN, D_MODEL), 1.0),
        'c_ctx': nrm(ks[3], (D_MODEL,), 1.0),
        'w_ada': nrm(ks[4], (DEPTH, D_MODEL, 6 * D_MODEL), D_MODEL ** -0.5),
        'b_ada': nrm(ks[5], (DEPTH, 6 * D_MODEL), 0.01),
        'w_in': nrm(ks[6], (DEPTH, D_MODEL, IN_DIM), D_MODEL ** -0.5),
        'q_norm': gain(ks[7], (DEPTH, HEAD_DIM)),
        'k_norm': gain(ks[8], (DEPTH, HEAD_DIM)),
        'sink': nrm(ks[9], (DEPTH, SWA_Q_HEADS), 1.0),
        'sgu_norm': gain(ks[10], (DEPTH, BRANCH_WIDTH)),
        'w_sgu': nrm(ks[11], (DEPTH, SGU_GROUPS, SGU_CHUNK, SGU_CHUNK), SGU_CHUNK ** -0.5),
        'b_sgu': 1.0 + nrm(ks[12], (DEPTH, SGU_GROUPS, SGU_CHUNK), 0.01),
        'w_gate_f': nrm(ks[13], (DEPTH, GLA_RANK, GLA_HEADS * GLA_DK), GLA_RANK ** -0.5),
        'b_gate_f': nrm(ks[14], (DEPTH, GLA_HEADS * GLA_DK), 0.01),
        'w_gate_b': nrm(ks[15], (DEPTH, GLA_RANK, GLA_HEADS * GLA_DK), GLA_RANK ** -0.5),
        'b_gate_b': nrm(ks[16], (DEPTH, GLA_HEADS * GLA_DK), 0.01),
        'gla_norm': gain(ks[17], (DEPTH, GLA_DV)),
        'w_br': nrm(ks[18], (DEPTH, N_BRANCH, BRANCH_WIDTH, D_MODEL), BRANCH_WIDTH ** -0.5),
        'w_o': nrm(ks[19], (DEPTH, D_MODEL, D_MODEL), D_MODEL ** -0.5),
        'w_ff1': nrm(ks[20], (DEPTH, D_MODEL, FFN_DIM), D_MODEL ** -0.5),
        'w_ff2': nrm(ks[21], (DEPTH, FFN_DIM, D_MODEL), FFN_DIM ** -0.5),
    }


def reference(x, c, ctx, c_ctx, w_ada, b_ada, w_in, q_norm, k_norm, sink, sgu_norm, w_sgu, b_sgu,
              w_gate_f, b_gate_f, w_gate_b, b_gate_b, gla_norm, w_br, w_o, w_ff1, w_ff2):
    B, N, _ = x.shape
    C = ctx.shape[1]
    rows = N // GRID_W
    row = jnp.repeat(jnp.arange(rows), GRID_W)
    col = jnp.tile(jnp.arange(GRID_W), rows)
    zero_state = jnp.zeros((B, GLA_HEADS, GLA_DK, GLA_DV), jnp.float32)

    for l in range(DEPTH):
        sh1, sc1, g1, sh2, sc2, g2 = [m[:, None, :] for m in adaln(c, w_ada[l], b_ada[l])]
        csh1, csc1, cg1, csh2, csc2, cg2 = adaln(c_ctx, w_ada[l], b_ada[l])

        (cu, cva, cqb, ckb, cvb, cqc, ckc, cvc, crc, czf, czb, cgates) = project(modulate(ctx, csh1, csc1), w_in[l])
        ck_att = rms_norm(heads(ckb, HEAD_DIM), k_norm[l])
        cv_att = heads(cvb, HEAD_DIM)
        oc, s_fwd, s_bwd = gla_bidir(heads(cqc, GLA_DK), heads(ckc, GLA_DK), heads(cvc, GLA_DV),
                                     gla_log_decay(czf, w_gate_f[l], b_gate_f[l]),
                                     gla_log_decay(czb, w_gate_b[l], b_gate_b[l]),
                                     zero_state, zero_state)

        (u, va, qb, kb, vb, qc, kc, vc, rc, zf, zb, gates) = project(modulate(x, sh1, sc1), w_in[l])
        a_out = sgu_mix(u, va, sgu_norm[l], w_sgu[l], b_sgu[l])
        q_att = axial_rope(rms_norm(heads(qb, HEAD_DIM), q_norm[l]), row, col)
        q_att = q_att.reshape(B, N, SWA_KV_HEADS, SWA_GROUP, HEAD_DIM)
        k_att = axial_rope(rms_norm(heads(kb, HEAD_DIM), k_norm[l]), row, col)
        b_out = swa_latent(q_att, k_att, heads(vb, HEAD_DIM), ck_att, cv_att, sink[l])
        o_lat, _, _ = gla_bidir(heads(qc, GLA_DK), heads(kc, GLA_DK), heads(vc, GLA_DV),
                                gla_log_decay(zf, w_gate_f[l], b_gate_f[l]),
                                gla_log_decay(zb, w_gate_b[l], b_gate_b[l]),
                                s_fwd, s_bwd)
        c_out = gla_out(o_lat, rc, gla_norm[l])
        x_new = x + g1 * merge_branches(a_out, b_out, c_out, gates, w_br[l], w_o[l])
        x_new = x_new + g2 * sq_relu_ffn(modulate(x_new, sh2, sc2), w_ff1[l], w_ff2[l])

        if l < DEPTH - 1:
            ca_out = sgu_mix(cu, cva, sgu_norm[l], w_sgu[l], b_sgu[l])
            cq_att = rms_norm(heads(cqb, HEAD_DIM), q_norm[l]).reshape(B, C, SWA_KV_HEADS, SWA_GROUP, HEAD_DIM)
            cb_out = ctx_attention(cq_att, ck_att, cv_att, sink[l])
            cc_out = gla_out(oc, crc, gla_norm[l])
            ctx = ctx + cg1 * merge_branches(ca_out, cb_out, cc_out, cgates, w_br[l], w_o[l])
            ctx = ctx + cg2 * sq_relu_ffn(modulate(ctx, csh2, csc2), w_ff1[l], w_ff2[l])
        x = x_new

    return x
```

```cpp
#include <hip/hip_runtime.h>
#include <hip/hip_cooperative_groups.h>
#include <cstdio>
#include <cstdint>
namespace cg = cooperative_groups;

#define DI __device__ __forceinline__
#define LAS __attribute__((address_space(3)))
#define GAS __attribute__((address_space(1)))
#define AIN(k) ((const GAS float*)a.in[k])
#define AOUT ((GAS float*)a.out)
#define AWS ((GAS unsigned char*)a.ws)
typedef unsigned short bf16_t;
typedef short bf16x8 __attribute__((ext_vector_type(8)));
typedef float f32x4 __attribute__((ext_vector_type(4)));
typedef unsigned u32x4 __attribute__((ext_vector_type(4)));
typedef unsigned u32x2 __attribute__((ext_vector_type(2)));

#define DST(p) (dry ? (decltype(p))(g_sink + ((size_t)(p) & 0xFFFFF0u)) : (p))
#ifndef DBL_BAR
#define DBL_BAR 0
#endif
#ifndef DRY_NOFENCE
#define DRY_NOFENCE 0
#endif
#ifndef P1_DRY_MODE
#define P1_DRY_MODE 0
#endif
#ifndef ATT_DRY_MODE
#define ATT_DRY_MODE 0
#endif
#ifndef DRYSEL
#define DRYSEL 7
#endif
#ifndef DRYMASK
#define DRYMASK 0
#endif
#ifndef DUPMASK
#define DUPMASK 0
#endif
#ifndef X1MASK
#define X1MASK 7
#endif
constexpr int DM = 1024, NB = 8, SEQ = 4096, CTXL = 256;
constexpr int NCTX = NB * CTXL;
constexpr int NLAT = NB * SEQ;
constexpr int NROW = NCTX + NLAT;
constexpr int LDP = 6432;
constexpr int NPAD = 6656;
constexpr int FF = 4096;
constexpr int C_U = 0, C_VA = 512, C_QB = 1024, C_KB = 1536, C_VB = 1664, C_QC = 1792, C_KC = 2048, C_VC = 2304, C_RC = 2816, C_ZF = 3328, C_ZB = 3344, C_G = 3360;
constexpr int HALF_ROWS = 16384;
constexpr float EPSV = 1e-6f;
constexpr float LOG2E = 1.4426950408889634f;

constexpr size_t MiB = 1u << 20;
constexpr size_t WS_ROPE = 1 * MiB;
constexpr size_t WS_MOD = 1 * MiB + 65536;
constexpr size_t WS_CTXST = 2 * MiB;
constexpr size_t WS_DEC = 4 * MiB;
constexpr size_t WS_WT = 8 * MiB;
constexpr size_t WT_LAYER = 34 * MiB;
constexpr size_t WT_IN = 0;
constexpr size_t WT_BR = (size_t)NPAD * 1024 * 2;
constexpr size_t WT_O = WT_BR + 3u * 1024 * 512 * 2;
constexpr size_t WT_F1 = WT_O + 1024u * 1024 * 2;
constexpr size_t WT_F2 = WT_F1 + 4096u * 1024 * 2;
constexpr size_t WS_CTXBUF = 76 * MiB;
constexpr size_t WS_H = 84 * MiB;
constexpr size_t WS_KV = 152 * MiB;
constexpr size_t WS_BIG = 188 * MiB;
constexpr size_t WS_PART = 460 * MiB;
constexpr size_t WS_END = 492 * MiB;
static_assert(WT_F2 + 1024u * 4096 * 2 <= WT_LAYER, "wt");

constexpr int LDS_BYTES = 147456;

struct Args { const float* in[22]; float* out; unsigned char* ws; int ph_lo, ph_hi; };

DI int otid() { int t = threadIdx.x; asm volatile("" : "+v"(t)); return t; }
DI int obid() { int t = blockIdx.x; asm volatile("" : "+s"(t)); return t; }
DI float bf2f(unsigned short h) { return __uint_as_float((unsigned)h << 16); }
DI unsigned f2bf(float f) { unsigned u = __float_as_uint(f); return (u + 0x7fffu + ((u >> 16) & 1u)) >> 16; }
typedef __bf16 bf16x2_t __attribute__((ext_vector_type(2)));
typedef float f32x2_t __attribute__((ext_vector_type(2)));
DI unsigned pk2(float lo, float hi) { f32x2_t v = {lo, hi}; bf16x2_t b = __builtin_convertvector(v, bf16x2_t); return __builtin_bit_cast(unsigned, b); }
DI void unpack8(const u32x4 w, float* f) {
#pragma unroll
    for (int i = 0; i < 4; ++i) { f[2 * i] = __uint_as_float(w[i] << 16); f[2 * i + 1] = __uint_as_float(w[i] & 0xffff0000u); }
}
DI u32x4 pack8(const float* f) { u32x4 w; w.x = pk2(f[0], f[1]); w.y = pk2(f[2], f[3]); w.z = pk2(f[4], f[5]); w.w = pk2(f[6], f[7]); return w; }
template <int CTRL, int RM> DI float dpp_f(float x) { return __builtin_bit_cast(float, __builtin_amdgcn_update_dpp(0, __builtin_bit_cast(int, x), CTRL, RM, 0xF, false)); }
DI float wave_sum(float v) {
#pragma unroll
    for (int o = 1; o < 64; o <<= 1) v += __shfl_xor(v, o);
    return v;
}
DI float sum8(float v) {
    v += dpp_f<0xB1, 0xF>(v); v += dpp_f<0x4E, 0xF>(v); v += dpp_f<0x141, 0xF>(v); return v;
}
DI float frcp(float x) { return __builtin_amdgcn_rcpf(x); }
DI float gelu_tanh(float x) { const float y = 0.7978845608028654f * (x + 0.044715f * x * x * x); return x * (1.f - frcp(1.f + __expf(2.f * y))); }
DI float log_sigmoid(float x) { return fminf(x, 0.f) - 0.6931471805599453f * __builtin_amdgcn_logf(1.f + __builtin_amdgcn_exp2f(-1.4426950408889634f * fabsf(x))); }
#define MFMA16(a, b, c) __builtin_amdgcn_mfma_f32_16x16x32_bf16((a), (b), (c), 0, 0, 0)

namespace pg8 {
constexpr int BM = 256, BK = 64, HALF = 128, HTB = HALF * BK * 2, STAGE_BYTES = 8 * HTB, NXCD = 8, WGM = 8;
DI int lds_byte(int r, int c) { const int st = (r >> 4) * 2 + (c >> 5), rr = r & 15, cc = c & 31, ob = rr * 64 + cc * 2; return st * 1024 + (ob ^ (((ob >> 9) & 1) << 5)); }
DI void stage_rc(int b, int& R, int& C) { const int st = b / 1024, sb = b % 1024, swz = sb ^ (((sb >> 9) & 1) << 5); R = (st >> 1) * 16 + swz / 64; C = (st & 1) * 32 + (swz % 64) / 2; }
DI int perm32(int rho) { const int n = rho >> 4, i = rho & 15; return 8 * (i >> 2) + 4 * n + (i & 3); }

struct Unit { int pm, pn, z; };
struct Gemm { const GAS char* A; const GAS char* Bt; int lda, ldb, K; int zA0, dA1, dA2, dB;
    DI size_t za(int z) const { return (size_t)(zA0 + z * dA1 + (z >> 1) * dA2); }
    DI size_t zb(int z) const { return (size_t)z * (size_t)dB; } };

struct Order {
    int pm0, nM, nN, nwg, G, c, nz, spread;
    DI void init(int pm0_, int nM_, int nN_, int nz_, int G_, int c_, int spread_ = 0) { pm0 = pm0_; nM = nM_; nN = nN_; nwg = nM * nN; G = G_; c = c_; nz = nz_; spread = spread_; }
    DI bool next(int i, Unit& u) const {
        if (spread) {
            const long L = (long)i * G + c; if (L >= (long)nwg * nz) return false;
            const int t = (int)(L / nz); u.z = (int)(L - (long)t * nz); u.pm = pm0 + t / nN; u.pn = t % nN; return true; }
        const int ti = i / nz; const int z = i - ti * nz;
        const long L = (long)ti * G + c; if (L >= nwg) return false;
        int wgid = (int)L; { const int q = nwg / NXCD, r = nwg % NXCD, xcd = wgid % NXCD, off = wgid / NXCD; wgid = (xcd < r ? xcd * (q + 1) : r * (q + 1) + (xcd - r) * q) + off; }
        const int nig = WGM * nN, gid = wgid / nig, fm = gid * WGM, gsz = (nM - fm) < WGM ? (nM - fm) : WGM;
        u.pm = pm0 + fm + ((wgid % nig) % gsz); u.pn = (wgid % nig) / gsz; u.z = z; return true;
    }
};

template <class Epi>
DI void gemm_phase(LAS unsigned char* lds, const Gemm g, const Order& S, const Epi& E) {
    const int tid = otid(), wid = __builtin_amdgcn_readfirstlane(tid >> 6), lane = tid & 63, wr = wid >> 2, wc = wid & 3, fr = lane & 15, fq = lane >> 4;
    const int nt = g.K / BK;
    unsigned voffA[2], voffB[2];
#pragma unroll
    for (int i = 0; i < 2; ++i) { int R, C; stage_rc(tid * 16 + i * 8192, R, C); const int Rb = (R & ~31) + perm32(R & 31);
        voffA[i] = (unsigned)(R * g.lda + C) * 2u; voffB[i] = (unsigned)(Rb * g.ldb + C) * 2u; }
    const size_t kstep = (size_t)(BK * 2);
    const size_t hstepA = (size_t)HALF * g.lda * 2, hstepB = (size_t)HALF * g.ldb * 2;
    const size_t tstepA = 2 * hstepA, tstepB = 2 * hstepB;
    const unsigned ldsw = (unsigned)wid * 1024u;
    const int aoff = lds_byte(wr * 64 + fr, fq * 8), boff = lds_byte(wc * 32 + fr, fq * 8);
#define PG8_SA(b, h) (((b) * 2 + (h)) * HTB)
#define PG8_SB(b, h) ((4 + (b) * 2 + (h)) * HTB)
#define PG8_STAGE(bufoff, gbase, voff) do { _Pragma("unroll") for (int _i = 0; _i < 2; ++_i) \
        __builtin_amdgcn_global_load_lds((const unsigned*)((const GAS char*)(gbase) + (voff)[_i]), (LAS unsigned*)(lds + (bufoff) + ldsw + _i * 8192), 16, 0, 0); } while (0)
#define PG8_LDA(dst, b, h) do { _Pragma("unroll") for (int m = 0; m < 4; ++m) _Pragma("unroll") for (int k = 0; k < 2; ++k) dst[m][k] = *(const LAS bf16x8*)(lds + PG8_SA(b, h) + aoff + m * 2048 + k * 1024); } while (0)
#define PG8_LDB(dst, b, h) do { _Pragma("unroll") for (int n = 0; n < 2; ++n) _Pragma("unroll") for (int k = 0; k < 2; ++k) dst[n][k] = *(const LAS bf16x8*)(lds + PG8_SB(b, h) + boff + n * 2048 + k * 1024); } while (0)
#define PG8_MMA(ai, bj, At, Bt) do { __builtin_amdgcn_s_setprio(1); _Pragma("unroll") for (int m = 0; m < 4; ++m) _Pragma("unroll") for (int n = 0; n < 2; ++n) _Pragma("unroll") for (int k = 0; k < 2; ++k) \
        acc[ai][bj][m][n] = __builtin_amdgcn_mfma_f32_16x16x32_bf16(Bt[n][k], At[m][k], acc[ai][bj][m][n], 0, 0, 0); __builtin_amdgcn_s_setprio(0); } while (0)
#define PG8_WAIT_V(n) asm volatile("s_waitcnt vmcnt(" #n ")" ::: "memory")
#define PG8_WAIT_L(n) asm volatile("s_waitcnt lgkmcnt(" #n ")" ::: "memory")
#define PG8_BAR __builtin_amdgcn_s_barrier()
#define PG8_SCHED __builtin_amdgcn_sched_barrier(0)
    Unit cur, nxt; int ui = 0;
    if (!S.next(0, cur)) return;
    f32x4 acc[2][2][4][2];
#pragma unroll
    for (int a = 0; a < 2; ++a)
#pragma unroll
        for (int b = 0; b < 2; ++b)
#pragma unroll
            for (int m = 0; m < 4; ++m)
#pragma unroll
                for (int n = 0; n < 2; ++n) acc[a][b][m][n] = (f32x4){0.f, 0.f, 0.f, 0.f};
    bf16x8 At[4][2], B0[2][2], B1[2][2];
    const GAS char* cA = g.A + (size_t)cur.pm * tstepA + g.za(cur.z); const GAS char* cB = g.Bt + (size_t)cur.pn * tstepB + g.zb(cur.z);
    PG8_STAGE(PG8_SB(0, 0), cB, voffB); PG8_STAGE(PG8_SB(0, 1), cB + hstepB, voffB); PG8_STAGE(PG8_SA(0, 0), cA, voffA); PG8_STAGE(PG8_SA(0, 1), cA + hstepA, voffA);
    if (wr == 1) PG8_BAR;
    PG8_WAIT_V(2); PG8_BAR;
    PG8_STAGE(PG8_SB(1, 0), cB + kstep, voffB); PG8_STAGE(PG8_SA(1, 0), cA + kstep, voffA); PG8_STAGE(PG8_SB(1, 1), cB + hstepB + kstep, voffB);
    PG8_WAIT_V(6); PG8_BAR;
    for (;;) {
        const bool has_next = S.next(ui + 1, nxt);
        const GAS char* nA = has_next ? g.A + (size_t)nxt.pm * tstepA + g.za(nxt.z) : cA; const GAS char* nB = has_next ? g.Bt + (size_t)nxt.pn * tstepB + g.zb(nxt.z) : cB;
        for (int t = 0; t < nt; t += 2) {
            const bool last = (t == nt - 2);
            const GAS char* a1 = cA + (size_t)(t + 1) * kstep;
            const GAS char* a2 = last ? nA : cA + (size_t)(t + 2) * kstep; const GAS char* b2 = last ? nB : cB + (size_t)(t + 2) * kstep;
            const GAS char* a3 = a2 + kstep; const GAS char* b3 = b2 + kstep;
            PG8_LDB(B0, 0, 0); PG8_LDB(B1, 0, 1); PG8_SCHED; PG8_LDA(At, 0, 0); PG8_STAGE(PG8_SA(1, 1), a1 + hstepA, voffA);
            PG8_WAIT_V(8); PG8_WAIT_L(0); PG8_BAR; PG8_MMA(0, 0, At, B0); PG8_MMA(0, 1, At, B1); PG8_BAR; PG8_SCHED;
            PG8_LDA(At, 0, 1); PG8_STAGE(PG8_SB(0, 0), b2, voffB); PG8_STAGE(PG8_SB(0, 1), b2 + hstepB, voffB); PG8_STAGE(PG8_SA(0, 0), a2, voffA);
            PG8_WAIT_V(8); PG8_WAIT_L(0); PG8_BAR; PG8_MMA(1, 0, At, B0); PG8_MMA(1, 1, At, B1); PG8_BAR; PG8_SCHED;
            PG8_LDB(B0, 1, 0); PG8_LDB(B1, 1, 1); PG8_SCHED; PG8_LDA(At, 1, 0); PG8_STAGE(PG8_SA(0, 1), a2 + hstepA, voffA);
            PG8_WAIT_V(8); PG8_WAIT_L(0); PG8_BAR; PG8_MMA(0, 0, At, B0); PG8_MMA(0, 1, At, B1); PG8_BAR; PG8_SCHED;
            PG8_LDA(At, 1, 1); PG8_STAGE(PG8_SB(1, 0), b3, voffB); PG8_STAGE(PG8_SB(1, 1), b3 + hstepB, voffB); PG8_STAGE(PG8_SA(1, 0), a3, voffA);
            PG8_WAIT_V(8); PG8_WAIT_L(0); PG8_BAR; PG8_MMA(1, 0, At, B0); PG8_MMA(1, 1, At, B1); PG8_BAR; PG8_SCHED;
        }
        if (wr == 0) PG8_BAR;
        E(acc, cur, wr, wc, fr, fq);
        if (!has_next) break;
#pragma unroll
        for (int a = 0; a < 2; ++a)
#pragma unroll
            for (int b = 0; b < 2; ++b)
#pragma unroll
                for (int m = 0; m < 4; ++m)
#pragma unroll
                    for (int n = 0; n < 2; ++n) acc[a][b][m][n] = (f32x4){0.f, 0.f, 0.f, 0.f};
        cur = nxt; cA = nA; cB = nB; ++ui;
        if (wr == 1) PG8_BAR;
    }
    PG8_WAIT_V(0);
    PG8_BAR;
#undef PG8_SA
#undef PG8_SB
#undef PG8_STAGE
#undef PG8_LDA
#undef PG8_LDB
#undef PG8_MMA
#undef PG8_WAIT_V
#undef PG8_WAIT_L
#undef PG8_BAR
#undef PG8_SCHED
}

struct EpiProj {
    GAS bf16_t* O; int rowshift;
    DI void operator()(const f32x4 (&acc)[2][2][4][2], const Unit& u, int wr, int wc, int fr, int fq) const {
        const int row0 = u.pm * BM + wr * 64 + fr - rowshift, col0 = u.pn * BM + wc * 32 + 8 * fq;
#pragma unroll
        for (int ai = 0; ai < 2; ++ai)
#pragma unroll
            for (int m = 0; m < 4; ++m) { GAS bf16_t* rowp = O + (size_t)(row0 + ai * HALF + m * 16) * LDP + col0;
#pragma unroll
                for (int bj = 0; bj < 2; ++bj) { if (col0 + bj * HALF < LDP) { const f32x4 v0 = acc[ai][bj][m][0], v1 = acc[ai][bj][m][1];
                    u32x4 w; w.x = pk2(v0[0], v0[1]); w.y = pk2(v0[2], v0[3]); w.z = pk2(v1[0], v1[1]); w.w = pk2(v1[2], v1[3]);
                    *(GAS u32x4*)(rowp + bj * HALF) = w; } } }
    }
};
struct EpiFF1 {
    GAS bf16_t* O;
    DI void operator()(const f32x4 (&acc)[2][2][4][2], const Unit& u, int wr, int wc, int fr, int fq) const {
        const int row0 = u.pm * BM + wr * 64 + fr, col0 = u.pn * BM + wc * 32 + 8 * fq;
#pragma unroll
        for (int ai = 0; ai < 2; ++ai)
#pragma unroll
            for (int m = 0; m < 4; ++m) { GAS bf16_t* rowp = O + (size_t)(row0 + ai * HALF + m * 16) * FF + col0;
#pragma unroll
                for (int bj = 0; bj < 2; ++bj) { f32x4 v0 = acc[ai][bj][m][0], v1 = acc[ai][bj][m][1];
#pragma unroll
                    for (int e = 0; e < 4; ++e) { const float a = fmaxf(v0[e], 0.f), b = fmaxf(v1[e], 0.f); v0[e] = a * a; v1[e] = b * b; }
                    u32x4 w; w.x = pk2(v0[0], v0[1]); w.y = pk2(v0[2], v0[3]); w.z = pk2(v1[0], v1[1]); w.w = pk2(v1[2], v1[3]);
                    *(GAS u32x4*)(rowp + bj * HALF) = w; } }
    }
};
struct EpiMerge {
    const GAS bf16_t* P; int rowshift; GAS bf16_t* Mg;
    DI void operator()(const f32x4 (&acc)[2][2][4][2], const Unit& u, int wr, int wc, int fr, int fq) const {
        const int row0 = u.pm * BM + wr * 64 + fr, col0 = u.pn * BM + wc * 32 + 8 * fq;
#pragma unroll
        for (int ai = 0; ai < 2; ++ai)
#pragma unroll
            for (int m = 0; m < 4; ++m) { const int row = row0 + ai * HALF + m * 16;
                const GAS bf16_t* gp = P + (size_t)(row - rowshift) * LDP + C_G + u.z * 1024 + col0; GAS bf16_t* op = Mg + (size_t)row * DM + col0;
#pragma unroll
                for (int bj = 0; bj < 2; ++bj) { const u32x4 gw = *(const GAS u32x4*)(gp + bj * HALF); float gv[8]; unpack8(gw, gv); float r[8];
#pragma unroll
                    for (int e = 0; e < 4; ++e) { r[e] = acc[ai][bj][m][0][e] * frcp(1.f + __expf(-gv[e])); r[4 + e] = acc[ai][bj][m][1][e] * frcp(1.f + __expf(-gv[4 + e])); }
                    if (u.z > 0) { const u32x4 ow = *(const GAS u32x4*)(op + bj * HALF); float ov[8]; unpack8(ow, ov);
#pragma unroll
                        for (int e = 0; e < 8; ++e) r[e] += ov[e]; }
                    *(GAS u32x4*)(op + bj * HALF) = pack8(r); } }
    }
};
struct EpiResid {
    const GAS float* base_ctx; const GAS float* base_lat; GAS float* out_ctx; GAS float* out_lat; const GAS float* gate;
    DI void operator()(const f32x4 (&acc)[2][2][4][2], const Unit& u, int wr, int wc, int fr, int fq) const {
        const int u0 = u.pm * BM; const bool isctx = u0 < NCTX; const int mi = isctx ? 8 : ((u0 - NCTX) >> 12);
        const GAS float* bp = isctx ? base_ctx + (size_t)u0 * DM : base_lat + (size_t)(u0 - NCTX) * DM;
        GAS float* op = isctx ? out_ctx + (size_t)u0 * DM : out_lat + (size_t)(u0 - NCTX) * DM;
        const int r0 = wr * 64 + fr, col0 = u.pn * BM + wc * 32 + 8 * fq;
        const GAS float* gp = gate + (size_t)mi * 6144 + col0;
        f32x4 gv[2][2];
#pragma unroll
        for (int bj = 0; bj < 2; ++bj)
#pragma unroll
            for (int n = 0; n < 2; ++n) gv[bj][n] = *(const GAS f32x4*)(gp + bj * HALF + 4 * n);
#pragma unroll
        for (int ai = 0; ai < 2; ++ai)
#pragma unroll
            for (int m = 0; m < 4; ++m) { const size_t off = (size_t)(r0 + ai * HALF + m * 16) * DM + col0;
#pragma unroll
                for (int bj = 0; bj < 2; ++bj)
#pragma unroll
                    for (int n = 0; n < 2; ++n) { const f32x4 b = *(const GAS f32x4*)(bp + off + bj * HALF + 4 * n);
                        *(GAS f32x4*)(op + off + bj * HALF + 4 * n) = b + gv[bj][n] * acc[ai][bj][m][n]; } }
    }
};
struct EpiPartial {
    GAS float* part; const GAS float* gate;
    DI void operator()(const f32x4 (&acc)[2][2][4][2], const Unit& u, int wr, int wc, int fr, int fq) const {
        GAS float* op = part + ((size_t)u.z * NCTX + (size_t)(u.pm * BM)) * DM;
        const int r0 = wr * 64 + fr, col0 = u.pn * BM + wc * 32 + 8 * fq;
        const GAS float* gp = gate + (size_t)8 * 6144 + col0;
        f32x4 gv[2][2];
#pragma unroll
        for (int bj = 0; bj < 2; ++bj)
#pragma unroll
            for (int n = 0; n < 2; ++n) gv[bj][n] = *(const GAS f32x4*)(gp + bj * HALF + 4 * n);
#pragma unroll
        for (int ai = 0; ai < 2; ++ai)
#pragma unroll
            for (int m = 0; m < 4; ++m) { const size_t off = (size_t)(r0 + ai * HALF + m * 16) * DM + col0;
#pragma unroll
                for (int bj = 0; bj < 2; ++bj)
#pragma unroll
                    for (int n = 0; n < 2; ++n) *(GAS f32x4*)(op + off + bj * HALF + 4 * n) = gv[bj][n] * acc[ai][bj][m][n]; }
    }
};
}

DI void p0_transpose_item(const GAS float* W, int K, int N, GAS bf16_t* WT, LAS float* scr, int item, int lane) {
    const int nblk = N / 32, kb = item / nblk, nb = item % nblk, k0 = 64 * kb, n0 = 32 * nb;
#pragma unroll 8
    for (int i = 0; i < 32; ++i) { const int kk = 2 * i + (lane >> 5); scr[kk * 33 + (lane & 31)] = W[(size_t)(k0 + kk) * N + n0 + (lane & 31)]; }
    asm volatile("s_waitcnt lgkmcnt(0)" ::: "memory");
    const int c = lane & 7;
#pragma unroll
    for (int j = 0; j < 4; ++j) { const int n = (lane >> 3) + 8 * j; const LAS float* s = scr + (8 * c) * 33 + n;
        u32x4 o; o.x = pk2(s[0 * 33], s[1 * 33]); o.y = pk2(s[2 * 33], s[3 * 33]); o.z = pk2(s[4 * 33], s[5 * 33]); o.w = pk2(s[6 * 33], s[7 * 33]);
        *(GAS u32x4*)(WT + (size_t)(n0 + n) * K + k0 + 8 * c) = o; }
    asm volatile("s_waitcnt lgkmcnt(0)" ::: "memory");
}

DI void phase_prologue(const Args& a, LAS unsigned char* lds) {
    const int tid = otid(), lane = tid & 63, wave = tid >> 6;
    GAS float* MOD = (GAS float*)(AWS + WS_MOD);
    if (blockIdx.x < 192) {
        LAS float* sc = (LAS float*)lds;
        LAS float* red = (LAS float*)(lds + 36864);
        for (int i = tid; i < 9 * 1024; i += 512) { const int mi = i >> 10, k = i & 1023; const float v = mi < 8 ? AIN(1)[mi * 1024 + k] : AIN(3)[k]; sc[i] = v / (1.f + __expf(-v)); }
        __syncthreads();
        const int l = blockIdx.x / 96, cgp = blockIdx.x % 96, col = cgp * 64 + lane;
        const GAS float* W = AIN(4) + (size_t)l * 1024 * 6144;
        float acc[9];
#pragma unroll
        for (int mi = 0; mi < 9; ++mi) acc[mi] = 0.f;
#pragma unroll 8
        for (int k = wave * 128; k < wave * 128 + 128; ++k) { const float w = W[(size_t)k * 6144 + col];
#pragma unroll
            for (int mi = 0; mi < 9; ++mi) acc[mi] += sc[mi * 1024 + k] * w; }
#pragma unroll
        for (int mi = 0; mi < 9; ++mi) red[(wave * 9 + mi) * 64 + lane] = acc[mi];
        __syncthreads();
        for (int idx = tid; idx < 576; idx += 512) { const int mi = idx >> 6, ln = idx & 63; float s = 0.f;
            for (int w = 0; w < 8; ++w) s += red[(w * 9 + mi) * 64 + ln];
            MOD[(size_t)(l * 9 + mi) * 6144 + cgp * 64 + ln] = s + AIN(5)[l * 6144 + cgp * 64 + ln]; }
        __syncthreads();
    }
    if (blockIdx.x == gridDim.x - 1) {
        GAS float* rope = (GAS float*)(AWS + WS_ROPE);
        for (int i = tid; i < 1024; i += 512) { const int pos = i >> 4, f = i & 15; const float freq = powf(10000.0f, -(float)f / 16.0f); const float ang = (float)pos * freq;
            rope[2 * i] = cosf(ang); rope[2 * i + 1] = sinf(ang); }
    }
    LAS float* scr = (LAS float*)(lds + wave * 16384);
    const int gw = blockIdx.x * 8 + wave, NGW = gridDim.x * 8;
    constexpr int I_IN = 16 * 201, I_BR = 8 * 32, I_O = 16 * 32, I_1 = 16 * 128, I_2 = 64 * 32;
    constexpr int PER_L = I_IN + 3 * I_BR + I_O + I_1 + I_2;
    for (int it = gw; it < 2 * PER_L; it += NGW) {
        const int l = it / PER_L; int r = it % PER_L;
        GAS GAS unsigned char* wt = AWS + WS_WT + (size_t)l * WT_LAYER;
        if (r < I_IN) { p0_transpose_item(AIN(6) + (size_t)l * 1024 * LDP, 1024, LDP, (GAS bf16_t*)(wt + WT_IN), scr, r, lane); continue; } r -= I_IN;
        if (r < 3 * I_BR) { const int k = r / I_BR; p0_transpose_item(AIN(18) + (size_t)(l * 3 + k) * 512 * 1024, 512, 1024, (GAS bf16_t*)(wt + WT_BR) + (size_t)k * 1024 * 512, scr, r % I_BR, lane); continue; } r -= 3 * I_BR;
        if (r < I_O) { p0_transpose_item(AIN(19) + (size_t)l * 1024 * 1024, 1024, 1024, (GAS bf16_t*)(wt + WT_O), scr, r, lane); continue; } r -= I_O;
        if (r < I_1) { p0_transpose_item(AIN(20) + (size_t)l * 1024 * 4096, 1024, 4096, (GAS bf16_t*)(wt + WT_F1), scr, r, lane); continue; } r -= I_1;
        p0_transpose_item(AIN(21) + (size_t)l * 4096 * 1024, 4096, 1024, (GAS bf16_t*)(wt + WT_F2), scr, r, lane);
    }
    for (int l = 0; l < 2; ++l) { GAS u32x4* z = (GAS u32x4*)(AWS + WS_WT + (size_t)l * WT_LAYER + WT_IN + (size_t)LDP * 1024 * 2);
        const int n16 = (NPAD - LDP) * 1024 * 2 / 16;
        for (int i = blockIdx.x * 512 + tid; i < n16; i += gridDim.x * 512) z[i] = (u32x4){0u, 0u, 0u, 0u}; }
}

DI void phase_modulate(const Args& a, int l, int which, int u_lo) {
    const int tid_ = otid(); const int lane = tid_ & 63, wave = tid_ >> 6;
    const GAS float* MOD = (const GAS float*)(AWS + WS_MOD);
    GAS bf16_t* H = (GAS bf16_t*)(AWS + WS_H);
    const bool from_in = (l == 0 && which == 0);
    const GAS float* xc = from_in ? AIN(2) : (const GAS float*)(AWS + WS_CTXBUF);
    const GAS float* xl = from_in ? AIN(0) : AOUT;
    const int gw = blockIdx.x * 8 + wave, NGW = gridDim.x * 8;
    for (int u = u_lo + gw; u < NROW; u += NGW) {
        const GAS float* xr = u < NCTX ? xc + (size_t)u * DM : xl + (size_t)(u - NCTX) * DM;
        const int mi = u < NCTX ? 8 : ((u - NCTX) >> 12);
        const GAS float* shift = MOD + (size_t)(l * 9 + mi) * 6144 + (which ? 3 : 0) * 1024;
        const GAS float* scale = shift + 1024;
        f32x4 v[4]; float ss = 0.f;
        const bool addpart = (l == 1 && which == 0 && u < NCTX);
#pragma unroll
        for (int j = 0; j < 4; ++j) { v[j] = *(const GAS f32x4*)(xr + 4 * lane + 256 * j);
            if (addpart) { const GAS float* pp = (const GAS float*)(AWS + WS_PART) + (size_t)u * DM + 4 * lane + 256 * j;
#pragma unroll
                for (int z = 0; z < 4; ++z) v[j] += *(const GAS f32x4*)(pp + (size_t)z * NCTX * DM); }
            ss += (v[j].x * v[j].x + v[j].y * v[j].y) + (v[j].z * v[j].z + v[j].w * v[j].w); }
        const float rstd = rsqrtf(wave_sum(ss) * (1.f / DM) + EPSV);
#pragma unroll
        for (int j = 0; j < 4; ++j) { const f32x4 sh = *(const GAS f32x4*)(shift + 4 * lane + 256 * j), sc = *(const GAS f32x4*)(scale + 4 * lane + 256 * j);
            const f32x4 o = v[j] * rstd * (sc + 1.f) + sh; u32x2 w; w.x = pk2(o.x, o.y); w.y = pk2(o.z, o.w);
            *(GAS u32x2*)(H + (size_t)u * DM + 4 * lane + 256 * j) = w; }
    }
}

DI void stage_T(LAS bf16_t* dst, const GAS bf16_t* src, int ncols, int tid) {
    const int ntask = (ncols >> 3) * 32;
    for (int task = tid; task < ntask; task += 512) { const int tp = task & 31, cgp = task >> 5;
        const u32x4 v0 = *(const GAS u32x4*)(src + (size_t)(2 * tp) * LDP + 8 * cgp), v1 = *(const GAS u32x4*)(src + (size_t)(2 * tp + 1) * LDP + 8 * cgp);
        LAS unsigned* d = (LAS unsigned*)(dst + (8 * cgp) * 72 + 2 * tp);
#pragma unroll
        for (int i = 0; i < 4; ++i) { d[(2 * i) * 36] = (v0[i] & 0xffffu) | (v1[i] << 16); d[(2 * i + 1) * 36] = (v0[i] >> 16) | (v1[i] & 0xffff0000u); } }
}

struct GlaW { const GAS float *wf, *bf, *wb, *bb; };

#define GLA_SWEEP() \
    const int d = tid >> 8, p = (tid >> 7) & 1, c = tid & 127, C = hp * 128 + c; \
    float bl[32]; { const GAS float* wg = d ? gw.wb : gw.wf; float w2[16]; _Pragma("unroll") for (int r = 0; r < 16; ++r) w2[r] = wg[r * 256 + C]; \
      const float bias = (d ? gw.bb : gw.bf)[C]; float cum = 0.f; \
      _Pragma("unroll") for (int i = 0; i < 32; ++i) { const int s = 32 * p + i, t = d ? 63 - s : s; float lg = bias, lg1 = 0.f, lg2 = 0.f, lg3 = 0.f; \
          _Pragma("unroll") for (int r = 0; r < 16; r += 4) { lg += zs[t * 32 + d * 16 + r] * w2[r]; lg1 += zs[t * 32 + d * 16 + r + 1] * w2[r + 1]; lg2 += zs[t * 32 + d * 16 + r + 2] * w2[r + 2]; lg3 += zs[t * 32 + d * 16 + r + 3] * w2[r + 3]; } \
          lg = (lg + lg1) + (lg2 + lg3); \
          cum += log_sigmoid(lg) * (1.f / 16.f); bl[i] = cum; if ((i & 3) == 3) __builtin_amdgcn_sched_barrier(0); } \
      xt[(d * 2 + p) * 128 + c] = cum; if (p) xt[512 + d * 128 + c] = bl[0]; }

DI void gla_pass1_item(const GAS bf16_t* P, int hp, GAS bf16_t* kv, GAS float* dec, const GlaW& gw, LAS unsigned char* lds, bool dry) {
    GAS char* g_sink = (GAS char*)*(volatile LAS unsigned long long*)(lds + 143376);
    const int tid = otid(), lane = tid & 63, wave = tid >> 6, fr = lane & 15, fq = lane >> 4;
    LAS float* zs = (LAS float*)lds; LAS float* xt = (LAS float*)(lds + 8192);
    LAS bf16_t* KO = (LAS bf16_t*)(lds + 16384);
    LAS bf16_t* VT = (LAS bf16_t*)(lds + 53248);
    if (!(dry && (P1_DRY_MODE & 8))) {
    if (tid < 256) { const int r = tid >> 2, cc = tid & 3; const u32x4 v = *(const GAS u32x4*)(P + (size_t)r * LDP + C_ZF + cc * 8); float f[8]; unpack8(v, f);
#pragma unroll
        for (int j = 0; j < 8; ++j) zs[r * 32 + cc * 8 + j] = f[j]; }
    stage_T(VT, P + C_VC + hp * 256, 256, tid); }
    unsigned short kpre[32];
    { const int d_ = tid >> 8, p_ = (tid >> 7) & 1, C_ = hp * 128 + (tid & 127);
#pragma unroll
      for (int i = 0; i < 32; ++i) { const int s = 32 * p_ + i, t = d_ ? 63 - s : s; kpre[i] = (dry && (P1_DRY_MODE & 16)) ? (unsigned short)i : P[(size_t)t * LDP + C_KC + C_]; } }
    __syncthreads();
    GLA_SWEEP();
    __syncthreads();
    if (!(dry && (P1_DRY_MODE & 2)))
    { const float off = p ? xt[(d * 2) * 128 + c] : 0.f; const float btot = xt[(d * 2) * 128 + c] + xt[(d * 2 + 1) * 128 + c];
#pragma unroll
      for (int i = 0; i < 32; ++i) { const int s = 32 * p + i, t = d ? 63 - s : s; const float kvv = bf2f(kpre[i]);
          KO[(d * 128 + c) * 72 + t] = (bf16_t)f2bf(kvv * __expf(btot - (bl[i] + off))); if ((i & 7) == 7) __builtin_amdgcn_sched_barrier(0); }
      if (p == 0) *DST(dec + d * 256 + C) = __expf(btot); }
    __syncthreads();
    if (!(dry && (P1_DRY_MODE & 1)))
    { const int dd = wave >> 2, h2 = (wave >> 1) & 1, dvh = wave & 1;
#pragma unroll
      for (int dkt = 0; dkt < 4; ++dkt) {
          const LAS bf16_t* ap = KO + (dd * 128 + h2 * 64 + dkt * 16 + fr) * 72 + fq * 8;
          const bf16x8 a0 = *(const LAS bf16x8*)ap, a1 = *(const LAS bf16x8*)(ap + 32);
#pragma unroll
          for (int dvt = 0; dvt < 4; ++dvt) { const int dv = (dvh * 4 + dvt) * 16 + fr;
              const LAS bf16_t* bp = VT + (h2 * 128 + dv) * 72 + fq * 8;
              const bf16x8 b0 = *(const LAS bf16x8*)bp, b1 = *(const LAS bf16x8*)(bp + 32);
              f32x4 acc = (f32x4){0.f, 0.f, 0.f, 0.f}; acc = MFMA16(a0, b0, acc); acc = MFMA16(a1, b1, acc);
              u32x2 w; w.x = pk2(acc[0], acc[1]); w.y = pk2(acc[2], acc[3]);
              *DST((GAS u32x2*)(kv + (size_t)((dd * 4 + hp * 2 + h2) * 128 + dv) * 64 + dkt * 16 + fq * 4)) = w; } } }
    __syncthreads();
}

DI void gla_pass3_item(GAS bf16_t* P, int hp, const GAS bf16_t* sin, const GlaW& gw, const GAS float* gnorm, LAS unsigned char* lds, bool dry) {
    GAS char* g_sink = (GAS char*)*(volatile LAS unsigned long long*)(lds + 143376);
    const int tid = otid(), lane = tid & 63, wave = tid >> 6, fr = lane & 15, fq = lane >> 4;
    LAS float* zs = (LAS float*)lds; LAS float* xt = (LAS float*)(lds + 8192);
    LAS bf16_t* QS = (LAS bf16_t*)(lds + 16384);
    LAS bf16_t* KS = (LAS bf16_t*)(lds + 53248);
    LAS bf16_t* VT = (LAS bf16_t*)(lds + 90112);
    if (tid < 256) { const int r = tid >> 2, cc = tid & 3; const u32x4 v = *(const GAS u32x4*)(P + (size_t)r * LDP + C_ZF + cc * 8); float f[8]; unpack8(v, f);
#pragma unroll
        for (int j = 0; j < 8; ++j) zs[r * 32 + cc * 8 + j] = f[j]; }
    stage_T(VT, P + C_VC + hp * 256, 256, tid);
    unsigned short kpre[32], qpre[32];
    { const int d_ = tid >> 8, p_ = (tid >> 7) & 1, C_ = hp * 128 + (tid & 127);
#pragma unroll
      for (int i = 0; i < 32; ++i) { const int s = 32 * p_ + i, t = d_ ? 63 - s : s; kpre[i] = P[(size_t)t * LDP + C_KC + C_]; qpre[i] = P[(size_t)t * LDP + C_QC + C_]; } }
    __syncthreads();
    GLA_SWEEP();
    __syncthreads();
    { const float off = p ? xt[(d * 2) * 128 + c] : 0.f; const float bref = xt[(d * 2) * 128 + c] + xt[512 + d * 128 + c];
      const int h2 = c >> 6, dk = c & 63;
#pragma unroll
      for (int i = 0; i < 32; ++i) { const int s = 32 * p + i, t = d ? 63 - s : s; const float bt = bl[i] + off;
          const float qv = bf2f(qpre[i]), kvv = bf2f(kpre[i]);
          QS[((d * 2 + h2) * 64 + t) * 72 + dk] = (bf16_t)f2bf(qv * 0.125f * __expf(bt - bref));
          KS[((d * 2 + h2) * 64 + t) * 72 + dk] = (bf16_t)f2bf(kvv * __expf(bref - bt)); if ((i & 7) == 7) __builtin_amdgcn_sched_barrier(0); }
      if (p == 0) xt[768 + d * 128 + c] = __expf(bref); }
    __syncthreads();
    {
        const int dd = wave >> 2, h2 = (wave >> 1) & 1, lh = wave & 1;
        f32x4 sc[2][4];
#pragma unroll
        for (int li = 0; li < 2; ++li) { const LAS bf16_t* qp = QS + ((dd * 2 + h2) * 64 + (2 * lh + li) * 16 + fr) * 72 + fq * 8;
            const bf16x8 q0 = *(const LAS bf16x8*)qp, q1 = *(const LAS bf16x8*)(qp + 32);
#pragma unroll
            for (int mt = 0; mt < 4; ++mt) { const LAS bf16_t* kp = KS + ((dd * 2 + h2) * 64 + mt * 16 + fr) * 72 + fq * 8;
                const bf16x8 k0 = *(const LAS bf16x8*)kp, k1 = *(const LAS bf16x8*)(kp + 32);
                f32x4 s = (f32x4){0.f, 0.f, 0.f, 0.f}; s = MFMA16(k0, q0, s); s = MFMA16(k1, q1, s); sc[li][mt] = s; } }
        __syncthreads();
#pragma unroll
        for (int li = 0; li < 2; ++li) { const int lrow = (2 * lh + li) * 16 + fr;
#pragma unroll
            for (int mt = 0; mt < 4; ++mt) { float v[4];
#pragma unroll
                for (int j = 0; j < 4; ++j) { const int mcol = mt * 16 + fq * 4 + j; const bool keep = dd ? (mcol >= lrow) : (mcol <= lrow); v[j] = keep ? sc[li][mt][j] : 0.f; }
                u32x2 w; w.x = pk2(v[0], v[1]); w.y = pk2(v[2], v[3]);
                *(LAS u32x2*)(KS + ((dd * 2 + h2) * 64 + lrow) * 72 + mt * 16 + fq * 4) = w; } }
    }
    __syncthreads();
    {
        const int h2 = wave >> 2, lt = wave & 3; const int h = hp * 2 + h2;
        f32x4 acc[8];
#pragma unroll
        for (int i = 0; i < 8; ++i) acc[i] = (f32x4){0.f, 0.f, 0.f, 0.f};
#pragma unroll 1
        for (int dd = 0; dd < 2; ++dd) {
            const LAS bf16_t* pp = KS + ((dd * 2 + h2) * 64 + lt * 16 + fr) * 72 + fq * 8;
            const LAS bf16_t* qp = QS + ((dd * 2 + h2) * 64 + lt * 16 + fr) * 72 + fq * 8;
            const bf16x8 p0 = *(const LAS bf16x8*)pp, p1 = *(const LAS bf16x8*)(pp + 32), q0 = *(const LAS bf16x8*)qp, q1 = *(const LAS bf16x8*)(qp + 32);
            float e0[8], e1[8];
#pragma unroll
            for (int j = 0; j < 8; ++j) { e0[j] = xt[768 + dd * 128 + h2 * 64 + fq * 8 + j]; e1[j] = xt[768 + dd * 128 + h2 * 64 + 32 + fq * 8 + j]; }
            u32x4 spre[8][2];
#pragma unroll
            for (int dvt = 0; dvt < 8; ++dvt) { const GAS bf16_t* sp = sin + (size_t)((dd * 4 + h) * 128 + dvt * 16 + fr) * 64 + fq * 8; spre[dvt][0] = *(const GAS u32x4*)sp; spre[dvt][1] = *(const GAS u32x4*)(sp + 32); }
#pragma unroll
            for (int dvt = 0; dvt < 8; ++dvt) {
                const LAS bf16_t* vp = VT + (h2 * 128 + dvt * 16 + fr) * 72 + fq * 8;
                const bf16x8 v0 = *(const LAS bf16x8*)vp, v1 = *(const LAS bf16x8*)(vp + 32);
                acc[dvt] = MFMA16(v0, p0, acc[dvt]); acc[dvt] = MFMA16(v1, p1, acc[dvt]);
                const u32x4 s0 = spre[dvt][0], s1 = spre[dvt][1];
                float f0[8], f1[8]; unpack8(s0, f0); unpack8(s1, f1);
#pragma unroll
                for (int j = 0; j < 8; ++j) { f0[j] *= e0[j]; f1[j] *= e1[j]; }
                const u32x4 t0 = pack8(f0), t1 = pack8(f1);
                acc[dvt] = MFMA16(__builtin_bit_cast(bf16x8, t0), q0, acc[dvt]); acc[dvt] = MFMA16(__builtin_bit_cast(bf16x8, t1), q1, acc[dvt]);
                __builtin_amdgcn_sched_barrier(0);
            }
        }
        float ss = 0.f;
#pragma unroll
        for (int i = 0; i < 8; ++i) ss += (acc[i][0] * acc[i][0] + acc[i][1] * acc[i][1]) + (acc[i][2] * acc[i][2] + acc[i][3] * acc[i][3]);
        ss += __shfl_xor(ss, 16); ss += __shfl_xor(ss, 32);
        const float rstd = rsqrtf(ss * (1.f / 128.f) + EPSV);
        GAS bf16_t* rp = P + (size_t)(lt * 16 + fr) * LDP + C_RC + h * 128;
#pragma unroll
        for (int dvt = 0; dvt < 8; ++dvt) { const int dv = dvt * 16 + fq * 4; const u32x2 rw = *(const GAS u32x2*)(rp + dv); const f32x4 gn = *(const GAS f32x4*)(gnorm + dv);
            float rv[4] = {__uint_as_float(rw.x << 16), __uint_as_float(rw.x & 0xffff0000u), __uint_as_float(rw.y << 16), __uint_as_float(rw.y & 0xffff0000u)}; float o[4];
#pragma unroll
            for (int j = 0; j < 4; ++j) o[j] = acc[dvt][j] * rstd * gn[j] * (rv[j] * frcp(1.f + __expf(-rv[j])));
            u32x2 w; w.x = pk2(o[0], o[1]); w.y = pk2(o[2], o[3]); *DST((GAS u32x2*)(rp + dv)) = w; }
    }
    __syncthreads();
}

DI void gla_scan_item(const Args& a, int hf, int b, int d, int slice, bool dry) {
    GAS char* g_sink = (GAS char*)(AWS + WS_PART);
    const int tid = otid(); const int e = slice * 2048 + tid * 4; const int h = e >> 13, dk = e & 63;
    GAS bf16_t* KV = (GAS bf16_t*)(AWS + WS_KV); const GAS float* DEC = (const GAS float*)(AWS + WS_DEC); GAS float* CST = (GAS float*)(AWS + WS_CTXST) + (size_t)(b * 2 + d) * 32768 + e;
    f32x4 st;
    if (hf == 0) {
        { float z0 = 0.f; asm volatile("" : "+v"(z0)); st = (f32x4){z0, z0, z0, z0}; }
#pragma unroll
        for (int s = 0; s < 4; ++s) { const int cid = b * 4 + (d ? 3 - s : s);
            GAS bf16_t* kp = KV + (size_t)cid * 65536 + d * 32768 + e; const u32x2 kw = *(const GAS u32x2*)kp; const f32x4 dc = *(const GAS f32x4*)(DEC + cid * 512 + d * 256 + h * 64 + dk);
            u32x2 w; w.x = pk2(st.x, st.y); w.y = pk2(st.z, st.w); *DST((GAS u32x2*)kp) = w;
            const f32x4 kvv = (f32x4){__uint_as_float(kw.x << 16), __uint_as_float(kw.x & 0xffff0000u), __uint_as_float(kw.y << 16), __uint_as_float(kw.y & 0xffff0000u)};
            st = st * dc + kvv; }
        *DST((GAS f32x4*)CST) = st;
        if (b >= 4) return;
    } else { st = *(const GAS f32x4*)CST; }
    const int cbase = 32 + (b & 3) * 64;
    u32x2 kwn[4]; f32x4 dcn[4];
#pragma unroll
    for (int k = 0; k < 4; ++k) { const int cid = cbase + (d ? 63 - k : k);
        kwn[k] = *(const GAS u32x2*)(KV + (size_t)cid * 65536 + d * 32768 + e); dcn[k] = *(const GAS f32x4*)(DEC + cid * 512 + d * 256 + h * 64 + dk); }
    for (int s0 = 0; s0 < 64; s0 += 4) {
        u32x2 kw[4]; f32x4 dc[4]; GAS bf16_t* kp[4];
#pragma unroll
        for (int k = 0; k < 4; ++k) { const int s = s0 + k; const int cid = cbase + (d ? 63 - s : s); kp[k] = KV + (size_t)cid * 65536 + d * 32768 + e; kw[k] = kwn[k]; dc[k] = dcn[k]; }
        if (s0 + 4 < 64) {
#pragma unroll
            for (int k = 0; k < 4; ++k) { const int s = s0 + 4 + k; const int cid = cbase + (d ? 63 - s : s);
                kwn[k] = *(const GAS u32x2*)(KV + (size_t)cid * 65536 + d * 32768 + e); dcn[k] = *(const GAS f32x4*)(DEC + cid * 512 + d * 256 + h * 64 + dk); } }
#pragma unroll
        for (int k = 0; k < 4; ++k) { u32x2 w; w.x = pk2(st.x, st.y); w.y = pk2(st.z, st.w); *DST((GAS u32x2*)kp[k]) = w;
            const f32x4 kvv = (f32x4){__uint_as_float(kw[k].x << 16), __uint_as_float(kw[k].x & 0xffff0000u), __uint_as_float(kw[k].y << 16), __uint_as_float(kw[k].y & 0xffff0000u)};
            st = st * dc[k] + kvv; }
    }
}

DI void sgu_item(GAS bf16_t* P, int g, const GAS float* ws_l  , const GAS float* bs_l  , const GAS float* gn_l  , LAS unsigned char* lds, bool dry) {
    GAS char* g_sink = (GAS char*)*(volatile LAS unsigned long long*)(lds + 143376);
    const int tid = otid(), lane = tid & 63, wave = tid >> 6, fr = lane & 15, fq = lane >> 4;
    LAS bf16_t* VT = (LAS bf16_t*)lds;
    const float g0 = gn_l[g * 128 + lane], g1 = gn_l[g * 128 + 64 + lane];
    { unsigned short r0[16], r1[16];
#pragma unroll
      for (int i = 0; i < 16; ++i) { const GAS bf16_t* vp = P + (size_t)(wave + 8 * i) * LDP + C_VA + g * 128; r0[i] = vp[lane]; r1[i] = vp[64 + lane]; }
#pragma unroll
      for (int i = 0; i < 16; ++i) { const int q = wave + 8 * i;
        const float x0 = gelu_tanh(bf2f(r0[i])), x1 = gelu_tanh(bf2f(r1[i]));
        const float rstd = rsqrtf(wave_sum(x0 * x0 + x1 * x1) * (1.f / 128.f) + EPSV);
        VT[lane * 136 + q] = (bf16_t)f2bf(x0 * rstd * g0); VT[(64 + lane) * 136 + q] = (bf16_t)f2bf(x1 * rstd * g1); } }
    bf16x8 wf[4];
    { const GAS float* wp = ws_l + (size_t)(g * 128 + wave * 16 + fr) * 128 + fq * 8;
#pragma unroll
      for (int ks = 0; ks < 4; ++ks) { const f32x4 w0 = *(const GAS f32x4*)(wp + ks * 32), w1 = *(const GAS f32x4*)(wp + ks * 32 + 4);
          u32x4 t; t.x = pk2(w0.x, w0.y); t.y = pk2(w0.z, w0.w); t.z = pk2(w1.x, w1.y); t.w = pk2(w1.z, w1.w); wf[ks] = __builtin_bit_cast(bf16x8, t); } }
    __syncthreads();
    const int prow = wave * 16 + fr; const float bias = bs_l[g * 128 + prow];
    GAS bf16_t* up = P + (size_t)prow * LDP + C_U + g * 128;
#pragma unroll
    for (int dt = 0; dt < 8; ++dt) { f32x4 acc = (f32x4){0.f, 0.f, 0.f, 0.f};
#pragma unroll
        for (int ks = 0; ks < 4; ++ks) { const bf16x8 av = *(const LAS bf16x8*)(VT + (dt * 16 + fr) * 136 + ks * 32 + fq * 8); acc = MFMA16(av, wf[ks], acc); }
        const int dcol = dt * 16 + fq * 4; const u32x2 uw = *(const GAS u32x2*)(up + dcol);
        const float uv[4] = {__uint_as_float(uw.x << 16), __uint_as_float(uw.x & 0xffff0000u), __uint_as_float(uw.y << 16), __uint_as_float(uw.y & 0xffff0000u)}; float o[4];
#pragma unroll
        for (int j = 0; j < 4; ++j) o[j] = gelu_tanh(uv[j]) * (acc[j] + bias);
        u32x2 w; w.x = pk2(o[0], o[1]); w.y = pk2(o[2], o[3]); *DST((GAS u32x2*)(up + dcol)) = w; }
    __syncthreads();
}

DI void qkprep_item(GAS bf16_t* P, int t0, bool doq, const GAS float* qn, const GAS float* kn, const GAS float* rope, bool dry, LAS unsigned char* lds) {
    GAS char* g_sink = (GAS char*)*(volatile LAS unsigned long long*)(lds + 143376);
    const int tid = otid(), lane = tid & 63, wave = tid >> 6, sub = lane & 7;
    LAS float* rtab = (LAS float*)lds;
    LAS float* gtab = (LAS float*)(lds + 8192);
    *(LAS f32x4*)(rtab + 4 * tid) = *(const GAS f32x4*)(rope + 4 * tid);
    if (tid < 128) gtab[tid] = tid < 64 ? qn[tid] : kn[tid - 64];
    __syncthreads();
    u32x4 xpre[10];
#pragma unroll
    for (int ii = 0; ii < 10; ++ii) { const int pr = (wave + 8 * ii) * 8 + (lane >> 3); const int r = pr / 10, hh = pr - r * 10; const bool isq = hh < 8;
        xpre[ii] = *(const GAS u32x4*)(P + (size_t)r * LDP + (isq ? C_QB + hh * 64 : C_KB + (hh - 8) * 64) + sub * 8); }
#pragma unroll
    for (int ii = 0; ii < 10; ++ii) { const int it = wave + 8 * ii; const int pr = it * 8 + (lane >> 3); const int r = pr / 10, hh = pr - r * 10; const bool isq = hh < 8;
        if (isq && !doq) continue;
        GAS bf16_t* xp = P + (size_t)r * LDP + (isq ? C_QB + hh * 64 : C_KB + (hh - 8) * 64) + sub * 8;
        const u32x4 xw = xpre[ii]; float x[8]; unpack8(xw, x);
        float ss = 0.f;
#pragma unroll
        for (int j = 0; j < 8; ++j) ss += x[j] * x[j];
        ss += __shfl_xor(ss, 1); ss += __shfl_xor(ss, 2); ss += __shfl_xor(ss, 4);
        const float rstd = rsqrtf(ss * (1.f / 64.f) + EPSV);
        const LAS float* gp = gtab + (isq ? 0 : 64) + sub * 8;
#pragma unroll
        for (int j = 0; j < 8; ++j) x[j] = x[j] * rstd * gp[j];
        if (t0 >= 0) { const int t = t0 + r; const int pos = (sub < 4) ? (t >> 6) : (t & 63); const LAS float* tb = rtab + (pos * 16 + 8 * (sub & 1)) * 2;
#pragma unroll
            for (int j = 0; j < 8; ++j) { const float o = __shfl_xor(x[j], 2); const float cs = tb[2 * j], sn = tb[2 * j + 1]; x[j] = (sub & 2) ? (o * sn + x[j] * cs) : (x[j] * cs - o * sn); } }
        if (isq) {
#pragma unroll
            for (int j = 0; j < 8; ++j) x[j] *= 0.125f * LOG2E; }
        *DST((GAS u32x4*)xp) = pack8(x);
    }
    __syncthreads();
}

DI void attn_item(GAS bf16_t* Q, const GAS bf16_t* Klat, const GAS bf16_t* Vlat, int qb, const GAS bf16_t* Kctx, const GAS bf16_t* Vctx, const GAS float* sink4, LAS unsigned char* lds, bool dry) {
    GAS char* g_sink = (GAS char*)*(volatile LAS unsigned long long*)(lds + 143376);
    const int tid = otid(), lane = tid & 63, wave = tid >> 6, fr = lane & 15, fq = lane >> 4;
    const int g = wave & 3, half = wave >> 2;
    LAS bf16_t* Ks0 = (LAS bf16_t*)lds;
    LAS bf16_t* Vt0 = (LAS bf16_t*)(lds + 9216);
    bf16x8 qf[4][2];
#pragma unroll
    for (int rt = 0; rt < 4; ++rt) { const GAS bf16_t* qp = Q + (size_t)(half * 64 + rt * 16 + fr) * LDP + g * 64 + fq * 8;
        qf[rt][0] = *(const GAS bf16x8*)qp; qf[rt][1] = *(const GAS bf16x8*)(qp + 32); }
    const float snk = sink4[g] * LOG2E;
    float mrow[4], lrow[4]; f32x4 O[4][4];
#pragma unroll
    for (int rt = 0; rt < 4; ++rt) { mrow[rt] = snk; lrow[rt] = (fq == 0) ? 1.f : 0.f;
#pragma unroll
        for (int dt = 0; dt < 4; ++dt) O[dt][rt] = (f32x4){0.f, 0.f, 0.f, 0.f}; }
    const int ntl = Klat ? 6 : 0, ntile = ntl + 4;
    const int kr = tid >> 3, kc = tid & 7;
    const int vtp = tid & 31, vcg = (tid >> 5) & 7;
    u32x4 kreg, v0reg, v1reg; int jn = 0;
    auto tile_valid = [&](int j) -> bool { if (j >= ntl) return true; const int kp0 = qb * 128 - 128 + 64 * j; return kp0 >= 0 && kp0 < SEQ; };
    auto tile_k = [&](int j) -> const GAS bf16_t* { return j < ntl ? Klat + (size_t)(qb * 128 - 128 + 64 * j) * LDP : Kctx + (size_t)((j - ntl) * 64) * LDP; };
    auto tile_v = [&](int j) -> const GAS bf16_t* { return j < ntl ? Vlat + (size_t)(qb * 128 - 128 + 64 * j) * LDP : Vctx + (size_t)((j - ntl) * 64) * LDP; };
    while (jn < ntile && !tile_valid(jn)) ++jn;
    { const GAS bf16_t* kp = tile_k(jn); const GAS bf16_t* vp = tile_v(jn);
      kreg = *(const GAS u32x4*)(kp + (size_t)kr * LDP + kc * 8);
      if (tid < 256) { v0reg = *(const GAS u32x4*)(vp + (size_t)(2 * vtp) * LDP + vcg * 8); v1reg = *(const GAS u32x4*)(vp + (size_t)(2 * vtp + 1) * LDP + vcg * 8); } }
    int pp = 0;
    while (jn < ntile) {
        const int j = jn;
        LAS bf16_t* Ks = Ks0 + pp * 9216; LAS bf16_t* Vt = Vt0 + pp * 9216; pp ^= 1;
        *(LAS u32x4*)(Ks + kr * 72 + kc * 8) = kreg;
        if (tid < 256) { LAS unsigned* dp = (LAS unsigned*)(Vt + (8 * vcg) * 72 + 2 * vtp);
#pragma unroll
            for (int i = 0; i < 4; ++i) { dp[(2 * i) * 36] = (v0reg[i] & 0xffffu) | (v1reg[i] << 16); dp[(2 * i + 1) * 36] = (v0reg[i] >> 16) | (v1reg[i] & 0xffff0000u); } }
        __syncthreads();
        ++jn; while (jn < ntile && !tile_valid(jn)) ++jn;
        if (jn < ntile && !(dry && (ATT_DRY_MODE & 2))) { const GAS bf16_t* kp = tile_k(jn); const GAS bf16_t* vp = tile_v(jn);
            kreg = *(const GAS u32x4*)(kp + (size_t)kr * LDP + kc * 8);
            if (tid < 256) { v0reg = *(const GAS u32x4*)(vp + (size_t)(2 * vtp) * LDP + vcg * 8); v1reg = *(const GAS u32x4*)(vp + (size_t)(2 * vtp + 1) * LDP + vcg * 8); } }
        const bool local = j < ntl;
        if (local && ((half == 0 && j == 5) || (half == 1 && j == 0))) continue;
        f32x4 S[4][4];
#pragma unroll
        for (int kt = 0; kt < 4; ++kt) { const LAS bf16_t* kp = Ks + (kt * 16 + fr) * 72 + fq * 8; const bf16x8 k0 = *(const LAS bf16x8*)kp, k1 = *(const LAS bf16x8*)(kp + 32);
#pragma unroll
            for (int rt = 0; rt < 4; ++rt) { f32x4 sv = (f32x4){0.f, 0.f, 0.f, 0.f}; sv = MFMA16(k0, qf[rt][0], sv); sv = MFMA16(k1, qf[rt][1], sv); S[rt][kt] = sv; } }
        if (dry && (ATT_DRY_MODE & 1)) { O[0][0] += S[0][0] + S[1][1] + S[2][2] + S[3][3]; continue; }
        if (local && (64 * j - 64 * half == 0 || 64 * j - 64 * half == 256)) { const int kk0 = -128 + 64 * j;
#pragma unroll
            for (int rt = 0; rt < 4; ++rt) { const int qq = half * 64 + rt * 16 + fr;
#pragma unroll
                for (int kt = 0; kt < 4; ++kt)
#pragma unroll
                    for (int e = 0; e < 4; ++e) { const int df = kk0 + kt * 16 + fq * 4 + e - qq; if (df < -128 || df > 128) S[rt][kt][e] = -INFINITY; } } }
        bf16x8 pb[4][2];
#pragma unroll
        for (int rt = 0; rt < 4; ++rt) { float mx = -INFINITY;
#pragma unroll
            for (int kt = 0; kt < 4; ++kt) mx = fmaxf(mx, fmaxf(fmaxf(S[rt][kt][0], S[rt][kt][1]), fmaxf(S[rt][kt][2], S[rt][kt][3])));
            mx = fmaxf(mx, __shfl_xor(mx, 16)); mx = fmaxf(mx, __shfl_xor(mx, 32));
            const float mnew = fmaxf(mrow[rt], mx), alpha = __builtin_amdgcn_exp2f(mrow[rt] - mnew); mrow[rt] = mnew;
            float ps = 0.f;
#pragma unroll
            for (int kt = 0; kt < 4; ++kt)
#pragma unroll
                for (int e = 0; e < 4; ++e) { const float pv = __builtin_amdgcn_exp2f(S[rt][kt][e] - mnew); S[rt][kt][e] = pv; ps += pv; }
            lrow[rt] = lrow[rt] * alpha + ps;
#pragma unroll
            for (int dt = 0; dt < 4; ++dt) O[dt][rt] = O[dt][rt] * alpha;
#pragma unroll
            for (int sidx = 0; sidx < 2; ++sidx) { u32x4 t; t.x = pk2(S[rt][2 * sidx][0], S[rt][2 * sidx][1]); t.y = pk2(S[rt][2 * sidx][2], S[rt][2 * sidx][3]); t.z = pk2(S[rt][2 * sidx + 1][0], S[rt][2 * sidx + 1][1]); t.w = pk2(S[rt][2 * sidx + 1][2], S[rt][2 * sidx + 1][3]);
                pb[rt][sidx] = __builtin_bit_cast(bf16x8, t); } }
#pragma unroll
        for (int dt = 0; dt < 4; ++dt)
#pragma unroll
            for (int sidx = 0; sidx < 2; ++sidx) { const LAS bf16_t* vp = Vt + (dt * 16 + fr) * 72 + 32 * sidx + 4 * fq;
                const u32x2 lo = *(const LAS u32x2*)vp, hi = *(const LAS u32x2*)(vp + 16);
                const u32x4 t = (u32x4){lo.x, lo.y, hi.x, hi.y}; const bf16x8 av = __builtin_bit_cast(bf16x8, t);
#pragma unroll
                for (int rt = 0; rt < 4; ++rt) O[dt][rt] = MFMA16(av, pb[rt][sidx], O[dt][rt]); }
    }
#pragma unroll
    for (int rt = 0; rt < 4; ++rt) { float l = lrow[rt]; l += __shfl_xor(l, 16); l += __shfl_xor(l, 32); const float inv = 1.f / l;
        GAS bf16_t* op = Q + (size_t)(half * 64 + rt * 16 + fr) * LDP + g * 64;
#pragma unroll
        for (int dt = 0; dt < 4; ++dt) { const f32x4 o = O[dt][rt] * inv; u32x2 w; w.x = pk2(o[0], o[1]); w.y = pk2(o[2], o[3]); *DST((GAS u32x2*)(op + dt * 16 + fq * 4)) = w; } }
    __syncthreads();
}

DI int xcd_vb() { const int G = gridDim.x, bx = blockIdx.x; return (G % 8 == 0) ? (bx % 8) * (G / 8) + bx / 8 : bx; }
DI void phase_x1(const Args& a, int l, int hf, LAS unsigned char* lds, bool dry) {
    GAS bf16_t* PJ = (GAS bf16_t*)(AWS + WS_BIG);
    const int c0 = hf ? 32 : 0;
    const int nch = hf ? 256 : 288;
    const bool ctx_mix = (hf == 0 && l == 0);
    const int s0 = (hf == 0 && !ctx_mix) ? 16 : (hf ? 16 : 0);
    const int nsg = 144 - s0;
    const int n_sgu = nsg * 4, n_g1 = nch * 2, n_pp = nch;
    const GlaW gw{AIN(13) + l * 16 * 256, AIN(14) + l * 256, AIN(15) + l * 16 * 256, AIN(16) + l * 256};
    for (int it = xcd_vb(); it < n_sgu + n_g1 + n_pp; it += gridDim.x) {
        if (it < n_sgu) { const int ck = s0 + (it >> 2), g = it & 3;
            if (!dry || (DRYSEL & 1)) sgu_item(PJ + (size_t)ck * 128 * LDP, g, AIN(11) + (size_t)l * 4 * 128 * 128, AIN(12) + l * 512, AIN(10) + l * 512, lds, dry);
        } else if (it < n_sgu + n_g1) { const int r = it - n_sgu; const int cid = c0 + (r >> 1), hp = r & 1;
            if (!dry || (DRYSEL & 2)) gla_pass1_item(PJ + (size_t)cid * 64 * LDP, hp, (GAS bf16_t*)(AWS + WS_KV) + (size_t)cid * 65536, (GAS float*)(AWS + WS_DEC) + cid * 512, gw, lds, dry);
        } else { const int cid = c0 + (it - n_sgu - n_g1); const bool isctx = cid < 32;
            const int t0 = isctx ? -1 : (((cid - 32) * 64) & 4095);
            if (!dry || (DRYSEL & 4)) qkprep_item(PJ + (size_t)cid * 64 * LDP, t0, !isctx || l == 0, AIN(7) + l * 64, AIN(8) + l * 64, (const GAS float*)(AWS + WS_ROPE), dry, lds);
        }
    }
}

DI void phase_x2(const Args& a, int l, int hf, LAS unsigned char* lds, bool dry) {
    GAS bf16_t* PJ = (GAS bf16_t*)(AWS + WS_BIG);
    const int n_att_lat = 256, n_att_ctx = 0;
    const int n_scan = hf ? 128 : 256;
    const int n_att = n_att_lat + n_att_ctx;
    for (int it = xcd_vb(); it < n_att + n_scan; it += gridDim.x) {
        if (it < n_att_lat) { const int kh = it & 1, qb = (it >> 1) & 31, bl = it >> 6;
            const int b = hf * 4 + bl;
            GAS bf16_t* lat0 = PJ + (size_t)(NCTX + bl * SEQ) * LDP;
            const GAS bf16_t* cx0 = PJ + (size_t)(b * CTXL) * LDP;
            if (!dry || (DRYSEL & 1)) attn_item(lat0 + (size_t)(qb * 128) * LDP + C_QB + kh * 256, lat0 + C_KB + kh * 64, lat0 + C_VB + kh * 64, qb, cx0 + C_KB + kh * 64, cx0 + C_VB + kh * 64, AIN(9) + l * 8 + kh * 4, lds, dry);
        } else if (it < n_att) { const int r = it - n_att_lat; const int kh = r & 1, qb = (r >> 1) & 1, b = r >> 2;
            GAS bf16_t* cx0 = PJ + (size_t)(b * CTXL) * LDP;
            if (!dry || (DRYSEL & 1)) attn_item(cx0 + (size_t)(qb * 128) * LDP + C_QB + kh * 256, nullptr, nullptr, qb, cx0 + C_KB + kh * 64, cx0 + C_VB + kh * 64, AIN(9) + l * 8 + kh * 4, lds, dry);
        } else { const int r = it - n_att; const int slice = r & 15, d = (r >> 4) & 1, bb = r >> 5;
            if (!dry || (DRYSEL & 2)) gla_scan_item(a, hf, hf ? 4 + bb : bb, d, slice, dry);
        }
    }
}

DI void phase_x3(const Args& a, int l, int hf, LAS unsigned char* lds, bool dry) {
    GAS bf16_t* PJ = (GAS bf16_t*)(AWS + WS_BIG);
    const int c0 = (hf == 0 && l == 0) ? 0 : 32;
    const int nch = 288 - c0;
    const GlaW gw{AIN(13) + l * 16 * 256, AIN(14) + l * 256, AIN(15) + l * 16 * 256, AIN(16) + l * 256};
    for (int it = xcd_vb(); it < nch * 2; it += gridDim.x) { const int cid = c0 + (it >> 1), hp = it & 1;
        gla_pass3_item(PJ + (size_t)cid * 64 * LDP, hp, (const GAS bf16_t*)(AWS + WS_KV) + (size_t)cid * 65536, gw, AIN(17) + l * 128, lds, dry); }
    if (hf == 0 && l == 0 && xcd_vb() >= (int)gridDim.x - 32) {
        const int r = xcd_vb() - ((int)gridDim.x - 32); const int kh = r & 1, qb = (r >> 1) & 1, b = r >> 2;
        GAS bf16_t* cx0 = PJ + (size_t)(b * CTXL) * LDP;
        attn_item(cx0 + (size_t)(qb * 128) * LDP + C_QB + kh * 256, nullptr, nullptr, qb, cx0 + C_KB + kh * 64, cx0 + C_VB + kh * 64, AIN(9) + l * 8 + kh * 4, lds, dry); }
}


#define XB_TMO      128
#define XB_XCNT(j)  (256  + 64 * (j))
#define XB_XSUB(j)  (1280 + 64 * (j))
#define XB_XGEN(j)  (2304 + 64 * (j))
#define XB_TOP      3328
#define XB_TOPGEN   3392
#define XCD_BAR_WORDS 3456
#define XB_SPIN_CAP (1u << 18)
DI unsigned xb_ld(unsigned* p)              { return __hip_atomic_load(p, __ATOMIC_RELAXED, __HIP_MEMORY_SCOPE_AGENT); }
DI unsigned xb_add(unsigned* p, unsigned v) { return __hip_atomic_fetch_add(p, v, __ATOMIC_RELAXED, __HIP_MEMORY_SCOPE_AGENT); }
DI unsigned xb_xcc_id() { return (unsigned)__builtin_amdgcn_s_getreg((3 << 11) | 20) & 0xFu; }
#define XB_SPIN(cond, bar) do { unsigned _sp = 0; while (cond) { __builtin_amdgcn_s_sleep(1); \
    if ((++_sp & 255u) == 0u) { if (xb_ld(&(bar)[XB_TMO])) break; if (_sp > XB_SPIN_CAP) { atomicAdd(&(bar)[XB_TMO], 1u); break; } } } } while (0)
struct XcdBarrier { unsigned* bar; unsigned x; volatile LAS unsigned* st; };
DI XcdBarrier xcd_barrier_post(unsigned* bar, volatile LAS unsigned* st) {
    XcdBarrier b; b.bar = bar; b.x = xb_xcc_id(); b.st = st;
    if (threadIdx.x == 0) (void)xb_add(&bar[XB_XCNT(b.x)], 1u);
    return b;
}
DI void xcd_barrier_complete(unsigned* bar, unsigned x, unsigned& nloc, unsigned& nx) {
    const unsigned G = gridDim.x * gridDim.y * gridDim.z;
    unsigned sum, cnt, mine, sp = 0u;
    for (;;) {
        sum = 0u; cnt = 0u; mine = 0u;
#pragma unroll
        for (unsigned j = 0; j < 16; ++j) { const unsigned c = xb_ld(&bar[XB_XCNT(j)]); sum += c; cnt += (c > 0u) ? 1u : 0u; mine = (j == x) ? c : mine; }
        if (sum == G) break;
        __builtin_amdgcn_s_sleep(1);
        if ((++sp & 255u) == 0u) { if (xb_ld(&bar[XB_TMO])) break; if (sp > XB_SPIN_CAP) { atomicAdd(&bar[XB_TMO], 1u); break; } }
    }
    nloc = mine > 0u ? mine : 1u; nx = cnt > 0u ? cnt : 1u;
}
template <int NOFENCE = 0> DI void xcd_barrier(const XcdBarrier& b) {
    asm volatile("s_waitcnt vmcnt(0)" ::: "memory");
    __syncthreads();
    if (threadIdx.x == 0) {
        unsigned* bar = b.bar;
        __builtin_amdgcn_s_waitcnt(0);
        unsigned nloc = b.st[0], nx = b.st[1]; const unsigned round = b.st[2];
        if (nloc == 0u) { xcd_barrier_complete(bar, b.x, nloc, nx); b.st[0] = nloc; b.st[1] = nx; }
        b.st[2] = round + 1u;
        const unsigned old = xb_add(&bar[XB_XSUB(b.x)], 1u);
        if (old + 1u == (round + 1u) * nloc) {
            __builtin_amdgcn_fence(__ATOMIC_RELEASE, "agent");
            asm volatile("s_waitcnt vmcnt(0)" ::: "memory");
            const unsigned og = xb_add(&bar[XB_TOP], 1u);
            if (og + 1u == (round + 1u) * nx) xb_add(&bar[XB_TOPGEN], 1u);
        }
        XB_SPIN(xb_ld(&bar[XB_TOPGEN]) == round, bar);
        __builtin_amdgcn_fence(__ATOMIC_ACQUIRE, "agent");
        asm volatile("s_waitcnt vmcnt(0)" ::: "memory");
    }
    __syncthreads();
}

constexpr int NPHASE = 31;
#ifndef DBG_N
#define DBG_N NPHASE
#endif
#ifndef DBG_NELEM
#define DBG_NELEM 0
#endif
#ifndef DBG_OFF
#define DBG_OFF 0
#endif
#ifndef DBG_F32
#define DBG_F32 0
#endif
#ifndef DBG_NELEM2
#define DBG_NELEM2 0
#endif
#ifndef DBG_OFF2
#define DBG_OFF2 0
#endif
#ifndef PHM
#define PHM 0xFFFF
#endif

DI void run_phase(const Args& a, int ph, LAS unsigned char* lds, bool dry) {
    if (ph == 0) { if (PHM & 1) phase_prologue(a, lds); return; }
    const int l = (ph - 1) / 15, q = (ph - 1) % 15;
    GAS GAS unsigned char* wt = AWS + WS_WT + (size_t)l * WT_LAYER;
    const int G = gridDim.x, cidx = blockIdx.x;
    const GAS float* MOD = (const GAS float*)(AWS + WS_MOD);
    if (q == 0) { if (PHM & 2) phase_modulate(a, l, 0, 0); return; }
    if (q >= 1 && q <= 10) {
        const int hf = (q - 1) / 5, k = (q - 1) % 5;
        const int rowshift = hf ? HALF_ROWS : 0;
        if (k == 0) { if (PHM & 4) {
            pg8::Gemm g{(const GAS char*)(AWS + WS_H) + (size_t)rowshift * DM * 2, (const GAS char*)(wt + WT_IN), DM, DM, DM, 0, 0, 0, 0};
            pg8::Order S; S.init(hf ? 8 : 0, hf ? 64 : 72, NPAD / 256, 1, G, cidx);
            pg8::EpiProj E{(GAS bf16_t*)(AWS + WS_BIG), 0};
            pg8::gemm_phase<pg8::EpiProj>(lds, g, S, E); }
        } else if (k == 1) { if (PHM & 8) phase_x1(a, l, hf, lds, dry); }
        else if (k == 2) { if (PHM & 16) phase_x2(a, l, hf, lds, dry); }
        else if (k == 3) { if (PHM & 32) phase_x3(a, l, hf, lds, dry); }
        else if (PHM & 64) {
            const bool withctx = (hf == 0 && l == 0);
            pg8::Gemm g{(const GAS char*)(AWS + WS_BIG), (const GAS char*)(wt + WT_BR), LDP, 512, 512, C_U * 2, (C_QB - C_U) * 2, (C_RC - 2 * C_QB + C_U) * 2, 1024 * 512 * 2};
            pg8::Order S; S.init(withctx ? 0 : 8, withctx ? 72 : 64, 4, 3, G, cidx);
            pg8::EpiMerge E{(const GAS bf16_t*)(AWS + WS_BIG), 0, (GAS bf16_t*)(AWS + WS_H) + (size_t)rowshift * DM};
            pg8::gemm_phase<pg8::EpiMerge>(lds, g, S, E);
        }
        return;
    }
    const int pm0 = (l == 0) ? 0 : 8, nM = 136 - pm0;
    if (q == 11) { if (PHM & 128) {
        pg8::Gemm g{(const GAS char*)(AWS + WS_H), (const GAS char*)(wt + WT_O), DM, DM, DM, 0, 0, 0, 0};
        pg8::Order S; S.init(pm0, nM, 4, 1, G, cidx);
        pg8::EpiResid E{l == 0 ? AIN(2) : (const GAS float*)(AWS + WS_CTXBUF), l == 0 ? AIN(0) : (const GAS float*)AOUT, (GAS float*)(AWS + WS_CTXBUF), AOUT, MOD + (size_t)(l * 9) * 6144 + 2 * 1024};
        pg8::gemm_phase<pg8::EpiResid>(lds, g, S, E); }
    } else if (q == 12) { if (PHM & 2) phase_modulate(a, l, 1, pm0 * 256);
    } else if (q == 13) { if (PHM & 256) {
        pg8::Gemm g{(const GAS char*)(AWS + WS_H), (const GAS char*)(wt + WT_F1), DM, DM, DM, 0, 0, 0, 0};
        pg8::Order S; S.init(pm0, nM, 16, 1, G, cidx);
        pg8::EpiFF1 E{(GAS bf16_t*)(AWS + WS_BIG)};
        pg8::gemm_phase<pg8::EpiFF1>(lds, g, S, E); }
    } else if (PHM & 512) {
        { pg8::Gemm g{(const GAS char*)(AWS + WS_BIG), (const GAS char*)(wt + WT_F2), FF, FF, FF, 0, 0, 0, 0};
          pg8::Order S; S.init(8, 128, 4, 1, G, cidx);
          pg8::EpiResid E{(const GAS float*)(AWS + WS_CTXBUF), (const GAS float*)AOUT, (GAS float*)(AWS + WS_CTXBUF), AOUT, MOD + (size_t)(l * 9) * 6144 + 5 * 1024};
          pg8::gemm_phase<pg8::EpiResid>(lds, g, S, E); }
        if (l == 0) {
          pg8::Gemm g{(const GAS char*)(AWS + WS_BIG), (const GAS char*)(wt + WT_F2), FF, FF, 1024, 0, 2048, 0, 2048};
          pg8::Order S; S.init(0, 8, 4, 4, G, cidx, 1);
          pg8::EpiPartial E{(GAS float*)(AWS + WS_PART), MOD + (size_t)(l * 9) * 6144 + 5 * 1024};
          pg8::gemm_phase<pg8::EpiPartial>(lds, g, S, E); }
    }
}

__global__ void __launch_bounds__(512, 2) mega_fwd(Args a) {
    extern __shared__ __attribute__((aligned(16))) unsigned char lds_raw[];
    LAS unsigned char* lds = (LAS unsigned char*)lds_raw;
    cg::grid_group grid = cg::this_grid();
    volatile LAS unsigned* misc = (volatile LAS unsigned*)(lds + 143360);
    if (threadIdx.x < 4) misc[threadIdx.x] = 0u;
    if (threadIdx.x == 0) *(volatile LAS unsigned long long*)(lds + 143376) = (unsigned long long)(AWS + WS_PART);
    __syncthreads();
    XcdBarrier bar = xcd_barrier_post((unsigned*)AWS + 4096, misc);
    if (a.ph_lo < 0) grid.sync();
    for (int ph = a.ph_lo; ph < a.ph_hi; ++ph) {
        Args b = a; int phv = ph;
        asm volatile("" : "+s"(b.ws), "+s"(b.out), "+s"(phv));
        int nrep = 1, drymatch = 0;
        if (DRYMASK && phv > 0) { const int q_ = (phv - 1) % 15; const int k_ = (q_ >= 1 && q_ <= 10) ? (q_ - 1) % 5 : 0;
            if (k_ >= 1 && k_ <= 3 && ((DRYMASK >> (k_ - 1)) & 1)) { nrep = 2; drymatch = 1; } }
        if (DUPMASK) { const int q_ = (phv - 1) % 15; bool dup = false;
            if (phv > 0) { if ((DUPMASK & 1) && (q_ == 1 || q_ == 6)) dup = true; if ((DUPMASK & 2) && q_ == 13) dup = true; if ((DUPMASK & 4) && (q_ == 0 || q_ == 12)) dup = true; if ((DUPMASK & 8) && (q_ == 5 || q_ == 10)) dup = true; }
            else if (DUPMASK & 16) dup = true;
            if (dup) nrep = 2; }
        nrep = __builtin_amdgcn_readfirstlane(nrep); drymatch = __builtin_amdgcn_readfirstlane(drymatch);
        for (int rep = 0; rep < nrep; ++rep) {
            run_phase(b, phv, lds, drymatch != 0 && rep == 0);
            if (rep + 1 < nrep) xcd_barrier(bar);
        }
        if (ph + 1 < a.ph_hi) { xcd_barrier(bar); if (DBL_BAR) xcd_barrier(bar); }
    }
    if (DBG_NELEM > 0) {
        xcd_barrier(bar);
        for (size_t i = (size_t)blockIdx.x * 512 + threadIdx.x; i < (size_t)NLAT * DM; i += (size_t)gridDim.x * 512) {
            float v = DBG_F32 ? ((const GAS float*)(AWS + (size_t)DBG_OFF))[i % (size_t)DBG_NELEM] : bf2f(((const GAS bf16_t*)(AWS + (size_t)DBG_OFF))[i % (size_t)DBG_NELEM]);
            if (DBG_NELEM2 > 0) v += bf2f(((const GAS bf16_t*)(AWS + (size_t)DBG_OFF2))[i % (size_t)DBG_NELEM2]);
            AOUT[i] = v; }
    }
}

extern "C" void kernel_launch(void* const* d_in, const int* in_sizes, int n_in, void* d_out, int out_size, void* d_ws, size_t ws_size, hipStream_t stream) {
    static int grid = 0;
    if (grid == 0) {
        int dev = 0, cus = 0, per_cu = 0;
        hipGetDevice(&dev);
        hipDeviceGetAttribute(&cus, hipDeviceAttributeMultiprocessorCount, dev);
        hipFuncSetAttribute((const void*)mega_fwd, hipFuncAttributeMaxDynamicSharedMemorySize, LDS_BYTES);
        hipOccupancyMaxActiveBlocksPerMultiprocessor(&per_cu, (const void*)mega_fwd, 512, LDS_BYTES);
        (void)hipGetLastError();
        if (per_cu < 1) per_cu = 1;
        grid = cus * 1;
        if (ws_size < WS_END) fprintf(stderr, "kernel_launch: workspace too small: %zu < %zu\n", ws_size, (size_t)WS_END);
        if (n_in != 22) fprintf(stderr, "kernel_launch: expected 22 inputs, got %d\n", n_in);
    }
    if (hipMemsetAsync(d_ws, 0, 65536, stream) != hipSuccess) fprintf(stderr, "kernel_launch: memset failed\n");
    Args a{};
    for (int i = 0; i < 22; ++i) a.in[i] = (const float*)d_in[i];
    a.out = (float*)d_out; a.ws = (unsigned char*)d_ws; a.ph_lo = 0; a.ph_hi = DBG_N;
    void* args[] = {&a};
    hipError_t e = hipLaunchCooperativeKernel((const void*)mega_fwd, dim3(grid), dim3(512), args, LDS_BYTES, stream);
    if (e != hipSuccess) fprintf(stderr, "cooperative launch failed: %s (grid %d)\n", hipGetErrorString(e), grid);
}
```

```cpp
#include <hip/hip_runtime.h>
#include <hip/hip_cooperative_groups.h>
#include <cstdio>
#include <cstdint>
namespace cg = cooperative_groups;

#define DI __device__ __forceinline__
#define LAS __attribute__((address_space(3)))
#define GAS __attribute__((address_space(1)))
#define AIN(k) ((const GAS float*)a.in[k])
#define AOUT ((GAS float*)a.out)
#define AWS ((GAS unsigned char*)a.ws)
typedef unsigned short bf16_t;
typedef short bf16x8 __attribute__((ext_vector_type(8)));
typedef float f32x4 __attribute__((ext_vector_type(4)));
typedef unsigned u32x4 __attribute__((ext_vector_type(4)));
typedef unsigned u32x2 __attribute__((ext_vector_type(2)));

#define DST(p) (dry ? (decltype(p))(g_sink + ((size_t)(p) & 0xFFFFF0u)) : (p))
#ifndef DBL_BAR
#define DBL_BAR 0
#endif
#ifndef DRY_NOFENCE
#define DRY_NOFENCE 0
#endif
#ifndef P1_DRY_MODE
#define P1_DRY_MODE 0
#endif
#ifndef ATT_DRY_MODE
#define ATT_DRY_MODE 0
#endif
#ifndef DRYSEL
#define DRYSEL 7
#endif
#ifndef DRYMASK
#define DRYMASK 0
#endif
#ifndef DUPMASK
#define DUPMASK 0
#endif
#ifndef X1MASK
#define X1MASK 7
#endif
constexpr int DM = 1024, NB = 8, SEQ = 4096, CTXL = 256;
constexpr int NCTX = NB * CTXL;
constexpr int NLAT = NB * SEQ;
constexpr int NROW = NCTX + NLAT;
constexpr int LDP = 6432;
constexpr int NPAD = 6656;
constexpr int FF = 4096;
constexpr int C_U = 0, C_VA = 512, C_QB = 1024, C_KB = 1536, C_VB = 1664, C_QC = 1792, C_KC = 2048, C_VC = 2304, C_RC = 2816, C_ZF = 3328, C_ZB = 3344, C_G = 3360;
constexpr int HALF_ROWS = 16384;
constexpr float EPSV = 1e-6f;
constexpr float LOG2E = 1.4426950408889634f;

constexpr size_t MiB = 1u << 20;
constexpr size_t WS_ROPE = 1 * MiB;
constexpr size_t WS_MOD = 1 * MiB + 65536;
constexpr size_t WS_CTXST = 2 * MiB;
constexpr size_t WS_DEC = 4 * MiB;
constexpr size_t WS_WT = 8 * MiB;
constexpr size_t WT_LAYER = 34 * MiB;
constexpr size_t WT_IN = 0;
constexpr size_t WT_BR = (size_t)NPAD * 1024 * 2;
constexpr size_t WT_O = WT_BR + 3u * 1024 * 512 * 2;
constexpr size_t WT_F1 = WT_O + 1024u * 1024 * 2;
constexpr size_t WT_F2 = WT_F1 + 4096u * 1024 * 2;
constexpr size_t WS_CTXBUF = 76 * MiB;
constexpr size_t WS_H = 84 * MiB;
constexpr size_t WS_KV = 152 * MiB;
constexpr size_t WS_BIG = 188 * MiB;
constexpr size_t WS_PART = 460 * MiB;
constexpr size_t WS_END = 492 * MiB;
static_assert(WT_F2 + 1024u * 4096 * 2 <= WT_LAYER, "wt");

constexpr int LDS_BYTES = 147456;

struct Args { const float* in[22]; float* out; unsigned char* ws; int ph_lo, ph_hi; };

DI int otid() { int t = threadIdx.x; asm volatile("" : "+v"(t)); return t; }
DI int obid() { int t = blockIdx.x; asm volatile("" : "+s"(t)); return t; }
DI float bf2f(unsigned short h) { return __uint_as_float((unsigned)h << 16); }
DI unsigned f2bf(float f) { unsigned u = __float_as_uint(f); return (u + 0x7fffu + ((u >> 16) & 1u)) >> 16; }
typedef __bf16 bf16x2_t __attribute__((ext_vector_type(2)));
typedef float f32x2_t __attribute__((ext_vector_type(2)));
DI unsigned pk2(float lo, float hi) { f32x2_t v = {lo, hi}; bf16x2_t b = __builtin_convertvector(v, bf16x2_t); return __builtin_bit_cast(unsigned, b); }
DI void unpack8(const u32x4 w, float* f) {
#pragma unroll
    for (int i = 0; i < 4; ++i) { f[2 * i] = __uint_as_float(w[i] << 16); f[2 * i + 1] = __uint_as_float(w[i] & 0xffff0000u); }
}
DI u32x4 pack8(const float* f) { u32x4 w; w.x = pk2(f[0], f[1]); w.y = pk2(f[2], f[3]); w.z = pk2(f[4], f[5]); w.w = pk2(f[6], f[7]); return w; }
template <int CTRL, int RM> DI float dpp_f(float x) { return __builtin_bit_cast(float, __builtin_amdgcn_update_dpp(0, __builtin_bit_cast(int, x), CTRL, RM, 0xF, false)); }
DI float wave_sum(float v) {
#pragma unroll
    for (int o = 1; o < 64; o <<= 1) v += __shfl_xor(v, o);
    return v;
}
DI float sum8(float v) {
    v += dpp_f<0xB1, 0xF>(v); v += dpp_f<0x4E, 0xF>(v); v += dpp_f<0x141, 0xF>(v); return v;
}
DI float frcp(float x) { return __builtin_amdgcn_rcpf(x); }
DI float gelu_tanh(float x) { const float y = 0.7978845608028654f * (x + 0.044715f * x * x * x); return x * (1.f - frcp(1.f + __expf(2.f * y))); }
DI float log_sigmoid(float x) { return fminf(x, 0.f) - 0.6931471805599453f * __builtin_amdgcn_logf(1.f + __builtin_amdgcn_exp2f(-1.4426950408889634f * fabsf(x))); }
#define MFMA16(a, b, c) __builtin_amdgcn_mfma_f32_16x16x32_bf16((a), (b), (c), 0, 0, 0)

namespace pg8 {
constexpr int BM = 256, BK = 64, HALF = 128, HTB = HALF * BK * 2, STAGE_BYTES = 8 * HTB, NXCD = 8, WGM = 8;
DI int lds_byte(int r, int c) { const int st = (r >> 4) * 2 + (c >> 5), rr = r & 15, cc = c & 31, ob = rr * 64 + cc * 2; return st * 1024 + (ob ^ (((ob >> 9) & 1) << 5)); }
DI void stage_rc(int b, int& R, int& C) { const int st = b / 1024, sb = b % 1024, swz = sb ^ (((sb >> 9) & 1) << 5); R = (st >> 1) * 16 + swz / 64; C = (st & 1) * 32 + (swz % 64) / 2; }
DI int perm32(int rho) { const int n = rho >> 4, i = rho & 15; return 8 * (i >> 2) + 4 * n + (i & 3); }

struct Unit { int pm, pn, z; };
struct Gemm { const GAS char* A; const GAS char* Bt; int lda, ldb, K; int zA0, dA1, dA2, dB;
    DI size_t za(int z) const { return (size_t)(zA0 + z * dA1 + (z >> 1) * dA2); }
    DI size_t zb(int z) const { return (size_t)z * (size_t)dB; } };

struct Order {
    int pm0, nM, nN, nwg, G, c, nz, spread;
    DI void init(int pm0_, int nM_, int nN_, int nz_, int G_, int c_, int spread_ = 0) { pm0 = pm0_; nM = nM_; nN = nN_; nwg = nM * nN; G = G_; c = c_; nz = nz_; spread = spread_; }
    DI bool next(int i, Unit& u) const {
        if (spread) {
            const long L = (long)i * G + c; if (L >= (long)nwg * nz) return false;
            const int t = (int)(L / nz); u.z = (int)(L - (long)t * nz); u.pm = pm0 + t / nN; u.pn = t % nN; return true; }
        const int ti = i / nz; const int z = i - ti * nz;
        const long L = (long)ti * G + c; if (L >= nwg) return false;
        int wgid = (int)L; { const int q = nwg / NXCD, r = nwg % NXCD, xcd = wgid % NXCD, off = wgid / NXCD; wgid = (xcd < r ? xcd * (q + 1) : r * (q + 1) + (xcd - r) * q) + off; }
        const int nig = WGM * nN, gid = wgid / nig, fm = gid * WGM, gsz = (nM - fm) < WGM ? (nM - fm) : WGM;
        u.pm = pm0 + fm + ((wgid % nig) % gsz); u.pn = (wgid % nig) / gsz; u.z = z; return true;
    }
};

template <class Epi>
DI void gemm_phase(LAS unsigned char* lds, const Gemm g, const Order& S, const Epi& E) {
    const int tid = otid(), wid = __builtin_amdgcn_readfirstlane(tid >> 6), lane = tid & 63, wr = wid >> 2, wc = wid & 3, fr = lane & 15, fq = lane >> 4;
    const int nt = g.K / BK;
    unsigned voffA[2], voffB[2];
#pragma unroll
    for (int i = 0; i < 2; ++i) { int R, C; stage_rc(tid * 16 + i * 8192, R, C); const int Rb = (R & ~31) + perm32(R & 31);
        voffA[i] = (unsigned)(R * g.lda + C) * 2u; voffB[i] = (unsigned)(Rb * g.ldb + C) * 2u; }
    const size_t kstep = (size_t)(BK * 2);
    const size_t hstepA = (size_t)HALF * g.lda * 2, hstepB = (size_t)HALF * g.ldb * 2;
    const size_t tstepA = 2 * hstepA, tstepB = 2 * hstepB;
    const unsigned ldsw = (unsigned)wid * 1024u;
    const int aoff = lds_byte(wr * 64 + fr, fq * 8), boff = lds_byte(wc * 32 + fr, fq * 8);
#define PG8_SA(b, h) (((b) * 2 + (h)) * HTB)
#define PG8_SB(b, h) ((4 + (b) * 2 + (h)) * HTB)
#define PG8_STAGE(bufoff, gbase, voff) do { _Pragma("unroll") for (int _i = 0; _i < 2; ++_i) \
        __builtin_amdgcn_global_load_lds((const unsigned*)((const GAS char*)(gbase) + (voff)[_i]), (LAS unsigned*)(lds + (bufoff) + ldsw + _i * 8192), 16, 0, 0); } while (0)
#define PG8_LDA(dst, b, h) do { _Pragma("unroll") for (int m = 0; m < 4; ++m) _Pragma("unroll") for (int k = 0; k < 2; ++k) dst[m][k] = *(const LAS bf16x8*)(lds + PG8_SA(b, h) + aoff + m * 2048 + k * 1024); } while (0)
#define PG8_LDB(dst, b, h) do { _Pragma("unroll") for (int n = 0; n < 2; ++n) _Pragma("unroll") for (int k = 0; k < 2; ++k) dst[n][k] = *(const LAS bf16x8*)(lds + PG8_SB(b, h) + boff + n * 2048 + k * 1024); } while (0)
#define PG8_MMA(ai, bj, At, Bt) do { __builtin_amdgcn_s_setprio(1); _Pragma("unroll") for (int m = 0; m < 4; ++m) _Pragma("unroll") for (int n = 0; n < 2; ++n) _Pragma("unroll") for (int k = 0; k < 2; ++k) \
        acc[ai][bj][m][n] = __builtin_amdgcn_mfma_f32_16x16x32_bf16(Bt[n][k], At[m][k], acc[ai][bj][m][n], 0, 0, 0); __builtin_amdgcn_s_setprio(0); } while (0)
#define PG8_WAIT_V(n) asm volatile("s_waitcnt vmcnt(" #n ")" ::: "memory")
#define PG8_WAIT_L(n) asm volatile("s_waitcnt lgkmcnt(" #n ")" ::: "memory")
#define PG8_BAR __builtin_amdgcn_s_barrier()
#define PG8_SCHED __builtin_amdgcn_sched_barrier(0)
    Unit cur, nxt; int ui = 0;
    if (!S.next(0, cur)) return;
    f32x4 acc[2][2][4][2];
#pragma unroll
    for (int a = 0; a < 2; ++a)
#pragma unroll
        for (int b = 0; b < 2; ++b)
#pragma unroll
            for (int m = 0; m < 4; ++m)
#pragma unroll
                for (int n = 0; n < 2; ++n) acc[a][b][m][n] = (f32x4){0.f, 0.f, 0.f, 0.f};
    bf16x8 At[4][2], B0[2][2], B1[2][2];
    const GAS char* cA = g.A + (size_t)cur.pm * tstepA + g.za(cur.z); const GAS char* cB = g.Bt + (size_t)cur.pn * tstepB + g.zb(cur.z);
    PG8_STAGE(PG8_SB(0, 0), cB, voffB); PG8_STAGE(PG8_SB(0, 1), cB + hstepB, voffB); PG8_STAGE(PG8_SA(0, 0), cA, voffA); PG8_STAGE(PG8_SA(0, 1), cA + hstepA, voffA);
    if (wr == 1) PG8_BAR;
    PG8_WAIT_V(2); PG8_BAR;
    PG8_STAGE(PG8_SB(1, 0), cB + kstep, voffB); PG8_STAGE(PG8_SA(1, 0), cA + kstep, voffA); PG8_STAGE(PG8_SB(1, 1), cB + hstepB + kstep, voffB);
    PG8_WAIT_V(6); PG8_BAR;
    for (;;) {
        const bool has_next = S.next(ui + 1, nxt);
        const GAS char* nA = has_next ? g.A + (size_t)nxt.pm * tstepA + g.za(nxt.z) : cA; const GAS char* nB = has_next ? g.Bt + (size_t)nxt.pn * tstepB + g.zb(nxt.z) : cB;
        for (int t = 0; t < nt; t += 2) {
            const bool last = (t == nt - 2);
            const GAS char* a1 = cA + (size_t)(t + 1) * kstep;
            const GAS char* a2 = last ? nA : cA + (size_t)(t + 2) * kstep; const GAS char* b2 = last ? nB : cB + (size_t)(t + 2) * kstep;
            const GAS char* a3 = a2 + kstep; const GAS char* b3 = b2 + kstep;
            PG8_LDB(B0, 0, 0); PG8_LDB(B1, 0, 1); PG8_SCHED; PG8_LDA(At, 0, 0); PG8_STAGE(PG8_SA(1, 1), a1 + hstepA, voffA);
            PG8_WAIT_V(8); PG8_WAIT_L(0); PG8_BAR; PG8_MMA(0, 0, At, B0); PG8_MMA(0, 1, At, B1); PG8_BAR; PG8_SCHED;
            PG8_LDA(At, 0, 1); PG8_STAGE(PG8_SB(0, 0), b2, voffB); PG8_STAGE(PG8_SB(0, 1), b2 + hstepB, voffB); PG8_STAGE(PG8_SA(0, 0), a2, voffA);
            PG8_WAIT_V(8); PG8_WAIT_L(0); PG8_BAR; PG8_MMA(1, 0, At, B0); PG8_MMA(1, 1, At, B1); PG8_BAR; PG8_SCHED;
            PG8_LDB(B0, 1, 0); PG8_LDB(B1, 1, 1); PG8_SCHED; PG8_LDA(At, 1, 0); PG8_STAGE(PG8_SA(0, 1), a2 + hstepA, voffA);
            PG8_WAIT_V(8); PG8_WAIT_L(0); PG8_BAR; PG8_MMA(0, 0, At, B0); PG8_MMA(0, 1, At, B1); PG8_BAR; PG8_SCHED;
            PG8_LDA(At, 1, 1); PG8_STAGE(PG8_SB(1, 0), b3, voffB); PG8_STAGE(PG8_SB(1, 1), b3 + hstepB, voffB); PG8_STAGE(PG8_SA(1, 0), a3, voffA);
            PG8_WAIT_V(8); PG8_WAIT_L(0); PG8_BAR; PG8_MMA(1, 0, At, B0); PG8_MMA(1, 1, At, B1); PG8_BAR; PG8_SCHED;
        }
        if (wr == 0) PG8_BAR;
        E(acc, cur, wr, wc, fr, fq);
        if (!has_next) break;
#pragma unroll
        for (int a = 0; a < 2; ++a)
#pragma unroll
            for (int b = 0; b < 2; ++b)
#pragma unroll
                for (int m = 0; m < 4; ++m)
#pragma unroll
                    for (int n = 0; n < 2; ++n) acc[a][b][m][n] = (f32x4){0.f, 0.f, 0.f, 0.f};
        cur = nxt; cA = nA; cB = nB; ++ui;
        if (wr == 1) PG8_BAR;
    }
    PG8_WAIT_V(0);
    PG8_BAR;
#undef PG8_SA
#undef PG8_SB
#undef PG8_STAGE
#undef PG8_LDA
#undef PG8_LDB
#undef PG8_MMA
#undef PG8_WAIT_V
#undef PG8_WAIT_L
#undef PG8_BAR
#undef PG8_SCHED
}

struct EpiProj {
    GAS bf16_t* O; int rowshift;
    DI void operator()(const f32x4 (&acc)[2][2][4][2], const Unit& u, int wr, int wc, int fr, int fq) const {
        const int row0 = u.pm * BM + wr * 64 + fr - rowshift, col0 = u.pn * BM + wc * 32 + 8 * fq;
#pragma unroll
        for (int ai = 0; ai < 2; ++ai)
#pragma unroll
            for (int m = 0; m < 4; ++m) { GAS bf16_t* rowp = O + (size_t)(row0 + ai * HALF + m * 16) * LDP + col0;
#pragma unroll
                for (int bj = 0; bj < 2; ++bj) { if (col0 + bj * HALF < LDP) { const f32x4 v0 = acc[ai][bj][m][0], v1 = acc[ai][bj][m][1];
                    u32x4 w; w.x = pk2(v0[0], v0[1]); w.y = pk2(v0[2], v0[3]); w.z = pk2(v1[0], v1[1]); w.w = pk2(v1[2], v1[3]);
                    *(GAS u32x4*)(rowp + bj * HALF) = w; } } }
    }
};
struct EpiFF1 {
    GAS bf16_t* O;
    DI void operator()(const f32x4 (&acc)[2][2][4][2], const Unit& u, int wr, int wc, int fr, int fq) const {
        const int row0 = u.pm * BM + wr * 64 + fr, col0 = u.pn * BM + wc * 32 + 8 * fq;
#pragma unroll
        for (int ai = 0; ai < 2; ++ai)
#pragma unroll
            for (int m = 0; m < 4; ++m) { GAS bf16_t* rowp = O + (size_t)(row0 + ai * HALF + m * 16) * FF + col0;
#pragma unroll
                for (int bj = 0; bj < 2; ++bj) { f32x4 v0 = acc[ai][bj][m][0], v1 = acc[ai][bj][m][1];
#pragma unroll
                    for (int e = 0; e < 4; ++e) { const float a = fmaxf(v0[e], 0.f), b = fmaxf(v1[e], 0.f); v0[e] = a * a; v1[e] = b * b; }
                    u32x4 w; w.x = pk2(v0[0], v0[1]); w.y = pk2(v0[2], v0[3]); w.z = pk2(v1[0], v1[1]); w.w = pk2(v1[2], v1[3]);
                    *(GAS u32x4*)(rowp + bj * HALF) = w; } }
    }
};
struct EpiMerge {
    const GAS bf16_t* P; int rowshift; GAS bf16_t* Mg;
    DI void operator()(const f32x4 (&acc)[2][2][4][2], const Unit& u, int wr, int wc, int fr, int fq) const {
        const int row0 = u.pm * BM + wr * 64 + fr, col0 = u.pn * BM + wc * 32 + 8 * fq;
#pragma unroll
        for (int ai = 0; ai < 2; ++ai)
#pragma unroll
            for (int m = 0; m < 4; ++m) { const int row = row0 + ai * HALF + m * 16;
                const GAS bf16_t* gp = P + (size_t)(row - rowshift) * LDP + C_G + u.z * 1024 + col0; GAS bf16_t* op = Mg + (size_t)row * DM + col0;
#pragma unroll
                for (int bj = 0; bj < 2; ++bj) { const u32x4 gw = *(const GAS u32x4*)(gp + bj * HALF); float gv[8]; unpack8(gw, gv); float r[8];
#pragma unroll
                    for (int e = 0; e < 4; ++e) { r[e] = acc[ai][bj][m][0][e] * frcp(1.f + __expf(-gv[e])); r[4 + e] = acc[ai][bj][m][1][e] * frcp(1.f + __expf(-gv[4 + e])); }
                    if (u.z > 0) { const u32x4 ow = *(const GAS u32x4*)(op + bj * HALF); float ov[8]; unpack8(ow, ov);
#pragma unroll
                        for (int e = 0; e < 8; ++e) r[e] += ov[e]; }
                    *(GAS u32x4*)(op + bj * HALF) = pack8(r); } }
    }
};
struct EpiResid {
    const GAS float* base_ctx; const GAS float* base_lat; GAS float* out_ctx; GAS float* out_lat; const GAS float* gate;
    DI void operator()(const f32x4 (&acc)[2][2][4][2], const Unit& u, int wr, int wc, int fr, int fq) const {
        const int u0 = u.pm * BM; const bool isctx = u0 < NCTX; const int mi = isctx ? 8 : ((u0 - NCTX) >> 12);
        const GAS float* bp = isctx ? base_ctx + (size_t)u0 * DM : base_lat + (size_t)(u0 - NCTX) * DM;
        GAS float* op = isctx ? out_ctx + (size_t)u0 * DM : out_lat + (size_t)(u0 - NCTX) * DM;
        const int r0 = wr * 64 + fr, col0 = u.pn * BM + wc * 32 + 8 * fq;
        const GAS float* gp = gate + (size_t)mi * 6144 + col0;
        f32x4 gv[2][2];
#pragma unroll
        for (int bj = 0; bj < 2; ++bj)
#pragma unroll
            for (int n = 0; n < 2; ++n) gv[bj][n] = *(const GAS f32x4*)(gp + bj * HALF + 4 * n);
#pragma unroll
        for (int ai = 0; ai < 2; ++ai)
#pragma unroll
            for (int m = 0; m < 4; ++m) { const size_t off = (size_t)(r0 + ai * HALF + m * 16) * DM + col0;
#pragma unroll
                for (int bj = 0; bj < 2; ++bj)
#pragma unroll
                    for (int n = 0; n < 2; ++n) { const f32x4 b = *(const GAS f32x4*)(bp + off + bj * HALF + 4 * n);
                        *(GAS f32x4*)(op + off + bj * HALF + 4 * n) = b + gv[bj][n] * acc[ai][bj][m][n]; } }
    }
};
struct EpiPartial {
    GAS float* part; const GAS float* gate;
    DI void operator()(const f32x4 (&acc)[2][2][4][2], const Unit& u, int wr, int wc, int fr, int fq) const {
        GAS float* op = part + ((size_t)u.z * NCTX + (size_t)(u.pm * BM)) * DM;
        const int r0 = wr * 64 + fr, col0 = u.pn * BM + wc * 32 + 8 * fq;
        const GAS float* gp = gate + (size_t)8 * 6144 + col0;
        f32x4 gv[2][2];
#pragma unroll
        for (int bj = 0; bj < 2; ++bj)
#pragma unroll
            for (int n = 0; n < 2; ++n) gv[bj][n] = *(const GAS f32x4*)(gp + bj * HALF + 4 * n);
#pragma unroll
        for (int ai = 0; ai < 2; ++ai)
#pragma unroll
            for (int m = 0; m < 4; ++m) { const size_t off = (size_t)(r0 + ai * HALF + m * 16) * DM + col0;
#pragma unroll
                for (int bj = 0; bj < 2; ++bj)
#pragma unroll
                    for (int n = 0; n < 2; ++n) *(GAS f32x4*)(op + off + bj * HALF + 4 * n) = gv[bj][n] * acc[ai][bj][m][n]; }
    }
};
}

DI void p0_transpose_item(const GAS float* W, int K, int N, GAS bf16_t* WT, LAS float* scr, int item, int lane) {
    const int nblk = N / 32, kb = item / nblk, nb = item % nblk, k0 = 64 * kb, n0 = 32 * nb;
#pragma unroll 8
    for (int i = 0; i < 32; ++i) { const int kk = 2 * i + (lane >> 5); scr[kk * 33 + (lane & 31)] = W[(size_t)(k0 + kk) * N + n0 + (lane & 31)]; }
    asm volatile("s_waitcnt lgkmcnt(0)" ::: "memory");
    const int c = lane & 7;
#pragma unroll
    for (int j = 0; j < 4; ++j) { const int n = (lane >> 3) + 8 * j; const LAS float* s = scr + (8 * c) * 33 + n;
        u32x4 o; o.x = pk2(s[0 * 33], s[1 * 33]); o.y = pk2(s[2 * 33], s[3 * 33]); o.z = pk2(s[4 * 33], s[5 * 33]); o.w = pk2(s[6 * 33], s[7 * 33]);
        *(GAS u32x4*)(WT + (size_t)(n0 + n) * K + k0 + 8 * c) = o; }
    asm volatile("s_waitcnt lgkmcnt(0)" ::: "memory");
}

constexpr int I_IN = 16 * 201, I_BR = 8 * 32, I_O = 16 * 32, I_1 = 16 * 128, I_2 = 64 * 32;
constexpr int PER_L_ITEMS = I_IN + 3 * I_BR + I_O + I_1 + I_2;
DI void transpose_item_of_layer(const Args& a, int l, int r, LAS float* scr, int lane) {
    GAS GAS unsigned char* wt = AWS + WS_WT + (size_t)l * WT_LAYER;
    if (r < I_IN) { p0_transpose_item(AIN(6) + (size_t)l * 1024 * LDP, 1024, LDP, (GAS bf16_t*)(wt + WT_IN), scr, r, lane); return; } r -= I_IN;
    if (r < 3 * I_BR) { const int k = r / I_BR; p0_transpose_item(AIN(18) + (size_t)(l * 3 + k) * 512 * 1024, 512, 1024, (GAS bf16_t*)(wt + WT_BR) + (size_t)k * 1024 * 512, scr, r % I_BR, lane); return; } r -= 3 * I_BR;
    if (r < I_O) { p0_transpose_item(AIN(19) + (size_t)l * 1024 * 1024, 1024, 1024, (GAS bf16_t*)(wt + WT_O), scr, r, lane); return; } r -= I_O;
    if (r < I_1) { p0_transpose_item(AIN(20) + (size_t)l * 1024 * 4096, 1024, 4096, (GAS bf16_t*)(wt + WT_F1), scr, r, lane); return; } r -= I_1;
    p0_transpose_item(AIN(21) + (size_t)l * 4096 * 1024, 4096, 1024, (GAS bf16_t*)(wt + WT_F2), scr, r, lane);
}
DI void phase_prologue(const Args& a, LAS unsigned char* lds) {
    const int tid = otid(), lane = tid & 63, wave = tid >> 6;
    GAS float* MOD = (GAS float*)(AWS + WS_MOD);
    if (blockIdx.x < 192) {
        LAS float* sc = (LAS float*)lds;
        LAS float* red = (LAS float*)(lds + 36864);
        for (int i = tid; i < 9 * 1024; i += 512) { const int mi = i >> 10, k = i & 1023; const float v = mi < 8 ? AIN(1)[mi * 1024 + k] : AIN(3)[k]; sc[i] = v / (1.f + __expf(-v)); }
        __syncthreads();
        const int l = blockIdx.x / 96, cgp = blockIdx.x % 96, col = cgp * 64 + lane;
        const GAS float* W = AIN(4) + (size_t)l * 1024 * 6144;
        float acc[9];
#pragma unroll
        for (int mi = 0; mi < 9; ++mi) acc[mi] = 0.f;
#pragma unroll 8
        for (int k = wave * 128; k < wave * 128 + 128; ++k) { const float w = W[(size_t)k * 6144 + col];
#pragma unroll
            for (int mi = 0; mi < 9; ++mi) acc[mi] += sc[mi * 1024 + k] * w; }
#pragma unroll
        for (int mi = 0; mi < 9; ++mi) red[(wave * 9 + mi) * 64 + lane] = acc[mi];
        __syncthreads();
        for (int idx = tid; idx < 576; idx += 512) { const int mi = idx >> 6, ln = idx & 63; float s = 0.f;
            for (int w = 0; w < 8; ++w) s += red[(w * 9 + mi) * 64 + ln];
            MOD[(size_t)(l * 9 + mi) * 6144 + cgp * 64 + ln] = s + AIN(5)[l * 6144 + cgp * 64 + ln]; }
        __syncthreads();
    }
    if (blockIdx.x == gridDim.x - 1) {
        GAS float* rope = (GAS float*)(AWS + WS_ROPE);
        for (int i = tid; i < 1024; i += 512) { const int pos = i >> 4, f = i & 15; const float freq = powf(10000.0f, -(float)f / 16.0f); const float ang = (float)pos * freq;
            rope[2 * i] = cosf(ang); rope[2 * i + 1] = sinf(ang); }
    }
    { const int gw = blockIdx.x * 8 + wave, NGW = gridDim.x * 8;
      for (int it = gw; it < PER_L_ITEMS; it += NGW) transpose_item_of_layer(a, 0, it, (LAS float*)(lds + wave * 16384), lane); }
    for (int l = 0; l < 2; ++l) { GAS u32x4* z = (GAS u32x4*)(AWS + WS_WT + (size_t)l * WT_LAYER + WT_IN + (size_t)LDP * 1024 * 2);
        const int n16 = (NPAD - LDP) * 1024 * 2 / 16;
        for (int i = blockIdx.x * 512 + tid; i < n16; i += gridDim.x * 512) z[i] = (u32x4){0u, 0u, 0u, 0u}; }
}

DI void phase_modulate(const Args& a, int l, int which, int u_lo) {
    const int tid_ = otid(); const int lane = tid_ & 63, wave = tid_ >> 6;
    const GAS float* MOD = (const GAS float*)(AWS + WS_MOD);
    GAS bf16_t* H = (GAS bf16_t*)(AWS + WS_H);
    const bool from_in = (l == 0 && which == 0);
    const GAS float* xc = from_in ? AIN(2) : (const GAS float*)(AWS + WS_CTXBUF);
    const GAS float* xl = from_in ? AIN(0) : AOUT;
    const int gw = blockIdx.x * 8 + wave, NGW = gridDim.x * 8;
    for (int u = u_lo + gw; u < NROW; u += NGW) {
        const GAS float* xr = u < NCTX ? xc + (size_t)u * DM : xl + (size_t)(u - NCTX) * DM;
        const int mi = u < NCTX ? 8 : ((u - NCTX) >> 12);
        const GAS float* shift = MOD + (size_t)(l * 9 + mi) * 6144 + (which ? 3 : 0) * 1024;
        const GAS float* scale = shift + 1024;
        f32x4 v[4]; float ss = 0.f;
        const bool addpart = (l == 1 && which == 0 && u < NCTX);
#pragma unroll
        for (int j = 0; j < 4; ++j) { v[j] = *(const GAS f32x4*)(xr + 4 * lane + 256 * j);
            if (addpart) { const GAS float* pp = (const GAS float*)(AWS + WS_PART) + (size_t)u * DM + 4 * lane + 256 * j;
#pragma unroll
                for (int z = 0; z < 4; ++z) v[j] += *(const GAS f32x4*)(pp + (size_t)z * NCTX * DM); }
            ss += (v[j].x * v[j].x + v[j].y * v[j].y) + (v[j].z * v[j].z + v[j].w * v[j].w); }
        const float rstd = rsqrtf(wave_sum(ss) * (1.f / DM) + EPSV);
#pragma unroll
        for (int j = 0; j < 4; ++j) { const f32x4 sh = *(const GAS f32x4*)(shift + 4 * lane + 256 * j), sc = *(const GAS f32x4*)(scale + 4 * lane + 256 * j);
            const f32x4 o = v[j] * rstd * (sc + 1.f) + sh; u32x2 w; w.x = pk2(o.x, o.y); w.y = pk2(o.z, o.w);
            *(GAS u32x2*)(H + (size_t)u * DM + 4 * lane + 256 * j) = w; }
    }
}

DI void stage_T(LAS bf16_t* dst, const GAS bf16_t* src, int ncols, int tid) {
    const int ntask = (ncols >> 3) * 32;
    for (int task = tid; task < ntask; task += 512) { const int tp = task & 31, cgp = task >> 5;
        const u32x4 v0 = *(const GAS u32x4*)(src + (size_t)(2 * tp) * LDP + 8 * cgp), v1 = *(const GAS u32x4*)(src + (size_t)(2 * tp + 1) * LDP + 8 * cgp);
        LAS unsigned* d = (LAS unsigned*)(dst + (8 * cgp) * 72 + 2 * tp);
#pragma unroll
        for (int i = 0; i < 4; ++i) { d[(2 * i) * 36] = (v0[i] & 0xffffu) | (v1[i] << 16); d[(2 * i + 1) * 36] = (v0[i] >> 16) | (v1[i] & 0xffff0000u); } }
}

struct GlaW { const GAS float *wf, *bf, *wb, *bb; };

#define GLA_SWEEP() \
    const int d = tid >> 8, p = (tid >> 7) & 1, c = tid & 127, C = hp * 128 + c; \
    float bl[32]; { const GAS float* wg = d ? gw.wb : gw.wf; float w2[16]; _Pragma("unroll") for (int r = 0; r < 16; ++r) w2[r] = wg[r * 256 + C]; \
      const float bias = (d ? gw.bb : gw.bf)[C]; float cum = 0.f; \
      _Pragma("unroll") for (int i = 0; i < 32; ++i) { const int s = 32 * p + i, t = d ? 63 - s : s; float lg = bias, lg1 = 0.f, lg2 = 0.f, lg3 = 0.f; \
          _Pragma("unroll") for (int r = 0; r < 16; r += 4) { lg += zs[t * 32 + d * 16 + r] * w2[r]; lg1 += zs[t * 32 + d * 16 + r + 1] * w2[r + 1]; lg2 += zs[t * 32 + d * 16 + r + 2] * w2[r + 2]; lg3 += zs[t * 32 + d * 16 + r + 3] * w2[r + 3]; } \
          lg = (lg + lg1) + (lg2 + lg3); \
          cum += log_sigmoid(lg) * (1.f / 16.f); bl[i] = cum; if ((i & 3) == 3) __builtin_amdgcn_sched_barrier(0); } \
      xt[(d * 2 + p) * 128 + c] = cum; if (p) xt[512 + d * 128 + c] = bl[0]; }

DI void gla_pass1_item(const GAS bf16_t* P, int hp, GAS bf16_t* kv, GAS float* dec, const GlaW& gw, LAS unsigned char* lds, bool dry) {
    GAS char* g_sink = (GAS char*)*(volatile LAS unsigned long long*)(lds + 143376);
    const int tid = otid(), lane = tid & 63, wave = tid >> 6, fr = lane & 15, fq = lane >> 4;
    LAS float* zs = (LAS float*)lds; LAS float* xt = (LAS float*)(lds + 8192);
    LAS bf16_t* KO = (LAS bf16_t*)(lds + 16384);
    LAS bf16_t* VT = (LAS bf16_t*)(lds + 53248);
    if (!(dry && (P1_DRY_MODE & 8))) {
    if (tid < 256) { const int r = tid >> 2, cc = tid & 3; const u32x4 v = *(const GAS u32x4*)(P + (size_t)r * LDP + C_ZF + cc * 8); float f[8]; unpack8(v, f);
#pragma unroll
        for (int j = 0; j < 8; ++j) zs[r * 32 + cc * 8 + j] = f[j]; }
    stage_T(VT, P + C_VC + hp * 256, 256, tid); }
    unsigned short kpre[32];
    { const int d_ = tid >> 8, p_ = (tid >> 7) & 1, C_ = hp * 128 + (tid & 127);
#pragma unroll
      for (int i = 0; i < 32; ++i) { const int s = 32 * p_ + i, t = d_ ? 63 - s : s; kpre[i] = (dry && (P1_DRY_MODE & 16)) ? (unsigned short)i : P[(size_t)t * LDP + C_KC + C_]; } }
    __syncthreads();
    GLA_SWEEP();
    __syncthreads();
    if (!(dry && (P1_DRY_MODE & 2)))
    { const float off = p ? xt[(d * 2) * 128 + c] : 0.f; const float btot = xt[(d * 2) * 128 + c] + xt[(d * 2 + 1) * 128 + c];
#pragma unroll
      for (int i = 0; i < 32; ++i) { const int s = 32 * p + i, t = d ? 63 - s : s; const float kvv = bf2f(kpre[i]);
          KO[(d * 128 + c) * 72 + t] = (bf16_t)f2bf(kvv * __expf(btot - (bl[i] + off))); if ((i & 7) == 7) __builtin_amdgcn_sched_barrier(0); }
      if (p == 0) *DST(dec + d * 256 + C) = __expf(btot); }
    __syncthreads();
    if (!(dry && (P1_DRY_MODE & 1)))
    { const int dd = wave >> 2, h2 = (wave >> 1) & 1, dvh = wave & 1;
#pragma unroll 1
      for (int dkt = 0; dkt < 4; ++dkt) {
          const LAS bf16_t* ap = KO + (dd * 128 + h2 * 64 + dkt * 16 + fr) * 72 + fq * 8;
          const bf16x8 a0 = *(const LAS bf16x8*)ap, a1 = *(const LAS bf16x8*)(ap + 32);
#pragma unroll
          for (int dvt = 0; dvt < 4; ++dvt) { const int dv = (dvh * 4 + dvt) * 16 + fr;
              const LAS bf16_t* bp = VT + (h2 * 128 + dv) * 72 + fq * 8;
              const bf16x8 b0 = *(const LAS bf16x8*)bp, b1 = *(const LAS bf16x8*)(bp + 32);
              f32x4 acc = (f32x4){0.f, 0.f, 0.f, 0.f}; acc = MFMA16(a0, b0, acc); acc = MFMA16(a1, b1, acc);
              u32x2 w; w.x = pk2(acc[0], acc[1]); w.y = pk2(acc[2], acc[3]);
              *DST((GAS u32x2*)(kv + (size_t)((dd * 4 + hp * 2 + h2) * 128 + dv) * 64 + dkt * 16 + fq * 4)) = w; } } }
    __syncthreads();
}

DI void gla_pass3_item(GAS bf16_t* P, int hp, const GAS bf16_t* sin, const GlaW& gw, const GAS float* gnorm, LAS unsigned char* lds, bool dry) {
    GAS char* g_sink = (GAS char*)*(volatile LAS unsigned long long*)(lds + 143376);
    const int tid = otid(), lane = tid & 63, wave = tid >> 6, fr = lane & 15, fq = lane >> 4;
    LAS float* zs = (LAS float*)lds; LAS float* xt = (LAS float*)(lds + 8192);
    LAS bf16_t* QS = (LAS bf16_t*)(lds + 16384);
    LAS bf16_t* KS = (LAS bf16_t*)(lds + 53248);
    LAS bf16_t* VT = (LAS bf16_t*)(lds + 90112);
    if (tid < 256) { const int r = tid >> 2, cc = tid & 3; const u32x4 v = *(const GAS u32x4*)(P + (size_t)r * LDP + C_ZF + cc * 8); float f[8]; unpack8(v, f);
#pragma unroll
        for (int j = 0; j < 8; ++j) zs[r * 32 + cc * 8 + j] = f[j]; }
    stage_T(VT, P + C_VC + hp * 256, 256, tid);
    unsigned short kpre[32], qpre[32];
    { const int d_ = tid >> 8, p_ = (tid >> 7) & 1, C_ = hp * 128 + (tid & 127);
#pragma unroll
      for (int i = 0; i < 32; ++i) { const int s = 32 * p_ + i, t = d_ ? 63 - s : s; kpre[i] = P[(size_t)t * LDP + C_KC + C_]; qpre[i] = P[(size_t)t * LDP + C_QC + C_]; } }
    __syncthreads();
    GLA_SWEEP();
    __syncthreads();
    { const float off = p ? xt[(d * 2) * 128 + c] : 0.f; const float bref = xt[(d * 2) * 128 + c] + xt[512 + d * 128 + c];
      const int h2 = c >> 6, dk = c & 63;
#pragma unroll
      for (int i = 0; i < 32; ++i) { const int s = 32 * p + i, t = d ? 63 - s : s; const float bt = bl[i] + off;
          const float qv = bf2f(qpre[i]), kvv = bf2f(kpre[i]);
          QS[((d * 2 + h2) * 64 + t) * 72 + dk] = (bf16_t)f2bf(qv * 0.125f * __expf(bt - bref));
          KS[((d * 2 + h2) * 64 + t) * 72 + dk] = (bf16_t)f2bf(kvv * __expf(bref - bt)); if ((i & 7) == 7) __builtin_amdgcn_sched_barrier(0); }
      if (p == 0) xt[768 + d * 128 + c] = __expf(bref); }
    __syncthreads();
    {
        const int dd = wave >> 2, h2 = (wave >> 1) & 1, lh = wave & 1;
        f32x4 sc[2][4];
#pragma unroll
        for (int li = 0; li < 2; ++li) { const LAS bf16_t* qp = QS + ((dd * 2 + h2) * 64 + (2 * lh + li) * 16 + fr) * 72 + fq * 8;
            const bf16x8 q0 = *(const LAS bf16x8*)qp, q1 = *(const LAS bf16x8*)(qp + 32);
#pragma unroll
            for (int mt = 0; mt < 4; ++mt) { const LAS bf16_t* kp = KS + ((dd * 2 + h2) * 64 + mt * 16 + fr) * 72 + fq * 8;
                const bf16x8 k0 = *(const LAS bf16x8*)kp, k1 = *(const LAS bf16x8*)(kp + 32);
                f32x4 s = (f32x4){0.f, 0.f, 0.f, 0.f}; s = MFMA16(k0, q0, s); s = MFMA16(k1, q1, s); sc[li][mt] = s; } }
        __syncthreads();
#pragma unroll
        for (int li = 0; li < 2; ++li) { const int lrow = (2 * lh + li) * 16 + fr;
#pragma unroll
            for (int mt = 0; mt < 4; ++mt) { float v[4];
#pragma unroll
                for (int j = 0; j < 4; ++j) { const int mcol = mt * 16 + fq * 4 + j; const bool keep = dd ? (mcol >= lrow) : (mcol <= lrow); v[j] = keep ? sc[li][mt][j] : 0.f; }
                u32x2 w; w.x = pk2(v[0], v[1]); w.y = pk2(v[2], v[3]);
                *(LAS u32x2*)(KS + ((dd * 2 + h2) * 64 + lrow) * 72 + mt * 16 + fq * 4) = w; } }
    }
    __syncthreads();
    {
        const int h2 = wave >> 2, lt = wave & 3; const int h = hp * 2 + h2;
        f32x4 acc[8];
#pragma unroll
        for (int i = 0; i < 8; ++i) acc[i] = (f32x4){0.f, 0.f, 0.f, 0.f};
#pragma unroll 1
        for (int dd = 0; dd < 2; ++dd) {
            const LAS bf16_t* pp = KS + ((dd * 2 + h2) * 64 + lt * 16 + fr) * 72 + fq * 8;
            const LAS bf16_t* qp = QS + ((dd * 2 + h2) * 64 + lt * 16 + fr) * 72 + fq * 8;
            const bf16x8 p0 = *(const LAS bf16x8*)pp, p1 = *(const LAS bf16x8*)(pp + 32), q0 = *(const LAS bf16x8*)qp, q1 = *(const LAS bf16x8*)(qp + 32);
            float e0[8], e1[8];
#pragma unroll
            for (int j = 0; j < 8; ++j) { e0[j] = xt[768 + dd * 128 + h2 * 64 + fq * 8 + j]; e1[j] = xt[768 + dd * 128 + h2 * 64 + 32 + fq * 8 + j]; }
            u32x4 spre[8][2];
#pragma unroll
            for (int dvt = 0; dvt < 8; ++dvt) { const GAS bf16_t* sp = sin + (size_t)((dd * 4 + h) * 128 + dvt * 16 + fr) * 64 + fq * 8; spre[dvt][0] = *(const GAS u32x4*)sp; spre[dvt][1] = *(const GAS u32x4*)(sp + 32); }
#pragma unroll
            for (int dvt = 0; dvt < 8; ++dvt) {
                const LAS bf16_t* vp = VT + (h2 * 128 + dvt * 16 + fr) * 72 + fq * 8;
                const bf16x8 v0 = *(const LAS bf16x8*)vp, v1 = *(const LAS bf16x8*)(vp + 32);
                acc[dvt] = MFMA16(v0, p0, acc[dvt]); acc[dvt] = MFMA16(v1, p1, acc[dvt]);
                const u32x4 s0 = spre[dvt][0], s1 = spre[dvt][1];
                float f0[8], f1[8]; unpack8(s0, f0); unpack8(s1, f1);
#pragma unroll
                for (int j = 0; j < 8; ++j) { f0[j] *= e0[j]; f1[j] *= e1[j]; }
                const u32x4 t0 = pack8(f0), t1 = pack8(f1);
                acc[dvt] = MFMA16(__builtin_bit_cast(bf16x8, t0), q0, acc[dvt]); acc[dvt] = MFMA16(__builtin_bit_cast(bf16x8, t1), q1, acc[dvt]);
                __builtin_amdgcn_sched_barrier(0);
            }
        }
        float ss = 0.f;
#pragma unroll
        for (int i = 0; i < 8; ++i) ss += (acc[i][0] * acc[i][0] + acc[i][1] * acc[i][1]) + (acc[i][2] * acc[i][2] + acc[i][3] * acc[i][3]);
        ss += __shfl_xor(ss, 16); ss += __shfl_xor(ss, 32);
        const float rstd = rsqrtf(ss * (1.f / 128.f) + EPSV);
        GAS bf16_t* rp = P + (size_t)(lt * 16 + fr) * LDP + C_RC + h * 128;
#pragma unroll
        for (int dvt = 0; dvt < 8; ++dvt) { const int dv = dvt * 16 + fq * 4; const u32x2 rw = *(const GAS u32x2*)(rp + dv); const f32x4 gn = *(const GAS f32x4*)(gnorm + dv);
            float rv[4] = {__uint_as_float(rw.x << 16), __uint_as_float(rw.x & 0xffff0000u), __uint_as_float(rw.y << 16), __uint_as_float(rw.y & 0xffff0000u)}; float o[4];
#pragma unroll
            for (int j = 0; j < 4; ++j) o[j] = acc[dvt][j] * rstd * gn[j] * (rv[j] * frcp(1.f + __expf(-rv[j])));
            u32x2 w; w.x = pk2(o[0], o[1]); w.y = pk2(o[2], o[3]); *DST((GAS u32x2*)(rp + dv)) = w; }
    }
    __syncthreads();
}

DI void gla_scan_item(const Args& a, int hf, int b, int d, int slice, bool dry) {
    GAS char* g_sink = (GAS char*)(AWS + WS_PART);
    const int tid = otid(); const int e = slice * 2048 + tid * 4; const int h = e >> 13, dk = e & 63;
    GAS bf16_t* KV = (GAS bf16_t*)(AWS + WS_KV); const GAS float* DEC = (const GAS float*)(AWS + WS_DEC); GAS float* CST = (GAS float*)(AWS + WS_CTXST) + (size_t)(b * 2 + d) * 32768 + e;
    f32x4 st;
    if (hf == 0) {
        { float z0 = 0.f; asm volatile("" : "+v"(z0)); st = (f32x4){z0, z0, z0, z0}; }
#pragma unroll
        for (int s = 0; s < 4; ++s) { const int cid = b * 4 + (d ? 3 - s : s);
            GAS bf16_t* kp = KV + (size_t)cid * 65536 + d * 32768 + e; const u32x2 kw = *(const GAS u32x2*)kp; const f32x4 dc = *(const GAS f32x4*)(DEC + cid * 512 + d * 256 + h * 64 + dk);
            u32x2 w; w.x = pk2(st.x, st.y); w.y = pk2(st.z, st.w); *DST((GAS u32x2*)kp) = w;
            const f32x4 kvv = (f32x4){__uint_as_float(kw.x << 16), __uint_as_float(kw.x & 0xffff0000u), __uint_as_float(kw.y << 16), __uint_as_float(kw.y & 0xffff0000u)};
            st = st * dc + kvv; }
        *DST((GAS f32x4*)CST) = st;
        if (b >= 4) return;
    } else { st = *(const GAS f32x4*)CST; }
    const int cbase = 32 + (b & 3) * 64;
    u32x2 kwn[4]; f32x4 dcn[4];
#pragma unroll
    for (int k = 0; k < 4; ++k) { const int cid = cbase + (d ? 63 - k : k);
        kwn[k] = *(const GAS u32x2*)(KV + (size_t)cid * 65536 + d * 32768 + e); dcn[k] = *(const GAS f32x4*)(DEC + cid * 512 + d * 256 + h * 64 + dk); }
    for (int s0 = 0; s0 < 64; s0 += 4) {
        u32x2 kw[4]; f32x4 dc[4]; GAS bf16_t* kp[4];
#pragma unroll
        for (int k = 0; k < 4; ++k) { const int s = s0 + k; const int cid = cbase + (d ? 63 - s : s); kp[k] = KV + (size_t)cid * 65536 + d * 32768 + e; kw[k] = kwn[k]; dc[k] = dcn[k]; }
        if (s0 + 4 < 64) {
#pragma unroll
            for (int k = 0; k < 4; ++k) { const int s = s0 + 4 + k; const int cid = cbase + (d ? 63 - s : s);
                kwn[k] = *(const GAS u32x2*)(KV + (size_t)cid * 65536 + d * 32768 + e); dcn[k] = *(const GAS f32x4*)(DEC + cid * 512 + d * 256 + h * 64 + dk); } }
#pragma unroll
        for (int k = 0; k < 4; ++k) { u32x2 w; w.x = pk2(st.x, st.y); w.y = pk2(st.z, st.w); *DST((GAS u32x2*)kp[k]) = w;
            const f32x4 kvv = (f32x4){__uint_as_float(kw[k].x << 16), __uint_as_float(kw[k].x & 0xffff0000u), __uint_as_float(kw[k].y << 16), __uint_as_float(kw[k].y & 0xffff0000u)};
            st = st * dc[k] + kvv; }
    }
}

DI void sgu_item(GAS bf16_t* P, int g, const GAS float* ws_l  , const GAS float* bs_l  , const GAS float* gn_l  , LAS unsigned char* lds, bool dry) {
    GAS char* g_sink = (GAS char*)*(volatile LAS unsigned long long*)(lds + 143376);
    const int tid = otid(), lane = tid & 63, wave = tid >> 6, fr = lane & 15, fq = lane >> 4;
    LAS bf16_t* VT = (LAS bf16_t*)lds;
    const float g0 = gn_l[g * 128 + lane], g1 = gn_l[g * 128 + 64 + lane];
    { unsigned short r0[16], r1[16];
#pragma unroll
      for (int i = 0; i < 16; ++i) { const GAS bf16_t* vp = P + (size_t)(wave + 8 * i) * LDP + C_VA + g * 128; r0[i] = vp[lane]; r1[i] = vp[64 + lane]; }
#pragma unroll
      for (int i = 0; i < 16; ++i) { const int q = wave + 8 * i;
        const float x0 = gelu_tanh(bf2f(r0[i])), x1 = gelu_tanh(bf2f(r1[i]));
        const float rstd = rsqrtf(wave_sum(x0 * x0 + x1 * x1) * (1.f / 128.f) + EPSV);
        VT[lane * 136 + q] = (bf16_t)f2bf(x0 * rstd * g0); VT[(64 + lane) * 136 + q] = (bf16_t)f2bf(x1 * rstd * g1); } }
    bf16x8 wf[4];
    { const GAS float* wp = ws_l + (size_t)(g * 128 + wave * 16 + fr) * 128 + fq * 8;
#pragma unroll
      for (int ks = 0; ks < 4; ++ks) { const f32x4 w0 = *(const GAS f32x4*)(wp + ks * 32), w1 = *(const GAS f32x4*)(wp + ks * 32 + 4);
          u32x4 t; t.x = pk2(w0.x, w0.y); t.y = pk2(w0.z, w0.w); t.z = pk2(w1.x, w1.y); t.w = pk2(w1.z, w1.w); wf[ks] = __builtin_bit_cast(bf16x8, t); } }
    __syncthreads();
    const int prow = wave * 16 + fr; const float bias = bs_l[g * 128 + prow];
    GAS bf16_t* up = P + (size_t)prow * LDP + C_U + g * 128;
#pragma unroll
    for (int dt = 0; dt < 8; ++dt) { f32x4 acc = (f32x4){0.f, 0.f, 0.f, 0.f};
#pragma unroll
        for (int ks = 0; ks < 4; ++ks) { const bf16x8 av = *(const LAS bf16x8*)(VT + (dt * 16 + fr) * 136 + ks * 32 + fq * 8); acc = MFMA16(av, wf[ks], acc); }
        const int dcol = dt * 16 + fq * 4; const u32x2 uw = *(const GAS u32x2*)(up + dcol);
        const float uv[4] = {__uint_as_float(uw.x << 16), __uint_as_float(uw.x & 0xffff0000u), __uint_as_float(uw.y << 16), __uint_as_float(uw.y & 0xffff0000u)}; float o[4];
#pragma unroll
        for (int j = 0; j < 4; ++j) o[j] = gelu_tanh(uv[j]) * (acc[j] + bias);
        u32x2 w; w.x = pk2(o[0], o[1]); w.y = pk2(o[2], o[3]); *DST((GAS u32x2*)(up + dcol)) = w; }
    __syncthreads();
}

DI void qkprep_item(GAS bf16_t* P, int t0, bool doq, const GAS float* qn, const GAS float* kn, const GAS float* rope, bool dry, LAS unsigned char* lds) {
    GAS char* g_sink = (GAS char*)*(volatile LAS unsigned long long*)(lds + 143376);
    const int tid = otid(), lane = tid & 63, wave = tid >> 6, sub = lane & 7;
    LAS float* rtab = (LAS float*)lds;
    LAS float* gtab = (LAS float*)(lds + 8192);
    *(LAS f32x4*)(rtab + 4 * tid) = *(const GAS f32x4*)(rope + 4 * tid);
    if (tid < 128) gtab[tid] = tid < 64 ? qn[tid] : kn[tid - 64];
    __syncthreads();
    u32x4 xpre[10];
#pragma unroll
    for (int ii = 0; ii < 10; ++ii) { const int pr = (wave + 8 * ii) * 8 + (lane >> 3); const int r = pr / 10, hh = pr - r * 10; const bool isq = hh < 8;
        xpre[ii] = *(const GAS u32x4*)(P + (size_t)r * LDP + (isq ? C_QB + hh * 64 : C_KB + (hh - 8) * 64) + sub * 8); }
#pragma unroll
    for (int ii = 0; ii < 10; ++ii) { const int it = wave + 8 * ii; const int pr = it * 8 + (lane >> 3); const int r = pr / 10, hh = pr - r * 10; const bool isq = hh < 8;
        if (isq && !doq) continue;
        GAS bf16_t* xp = P + (size_t)r * LDP + (isq ? C_QB + hh * 64 : C_KB + (hh - 8) * 64) + sub * 8;
        const u32x4 xw = xpre[ii]; float x[8]; unpack8(xw, x);
        float ss = 0.f;
#pragma unroll
        for (int j = 0; j < 8; ++j) ss += x[j] * x[j];
        ss += __shfl_xor(ss, 1); ss += __shfl_xor(ss, 2); ss += __shfl_xor(ss, 4);
        const float rstd = rsqrtf(ss * (1.f / 64.f) + EPSV);
        const LAS float* gp = gtab + (isq ? 0 : 64) + sub * 8;
#pragma unroll
        for (int j = 0; j < 8; ++j) x[j] = x[j] * rstd * gp[j];
        if (t0 >= 0) { const int t = t0 + r; const int pos = (sub < 4) ? (t >> 6) : (t & 63); const LAS float* tb = rtab + (pos * 16 + 8 * (sub & 1)) * 2;
#pragma unroll
            for (int j = 0; j < 8; ++j) { const float o = __shfl_xor(x[j], 2); const float cs = tb[2 * j], sn = tb[2 * j + 1]; x[j] = (sub & 2) ? (o * sn + x[j] * cs) : (x[j] * cs - o * sn); } }
        if (isq) {
#pragma unroll
            for (int j = 0; j < 8; ++j) x[j] *= 0.125f * LOG2E; }
        *DST((GAS u32x4*)xp) = pack8(x);
    }
    __syncthreads();
}

DI void attn_item(GAS bf16_t* Q, const GAS bf16_t* Klat, const GAS bf16_t* Vlat, int qb, const GAS bf16_t* Kctx, const GAS bf16_t* Vctx, const GAS float* sink4, LAS unsigned char* lds, bool dry) {
    GAS char* g_sink = (GAS char*)*(volatile LAS unsigned long long*)(lds + 143376);
    const int tid = otid(), lane = tid & 63, wave = tid >> 6, fr = lane & 15, fq = lane >> 4;
    const int g = wave & 3, half = wave >> 2;
    LAS bf16_t* Ks0 = (LAS bf16_t*)lds;
    LAS bf16_t* Vt0 = (LAS bf16_t*)(lds + 9216);
    bf16x8 qf[4][2];
#pragma unroll
    for (int rt = 0; rt < 4; ++rt) { const GAS bf16_t* qp = Q + (size_t)(half * 64 + rt * 16 + fr) * LDP + g * 64 + fq * 8;
        qf[rt][0] = *(const GAS bf16x8*)qp; qf[rt][1] = *(const GAS bf16x8*)(qp + 32); }
    const float snk = sink4[g] * LOG2E;
    float mrow[4], lrow[4]; f32x4 O[4][4];
#pragma unroll
    for (int rt = 0; rt < 4; ++rt) { mrow[rt] = snk; lrow[rt] = (fq == 0) ? 1.f : 0.f;
#pragma unroll
        for (int dt = 0; dt < 4; ++dt) O[dt][rt] = (f32x4){0.f, 0.f, 0.f, 0.f}; }
    const int ntl = Klat ? 6 : 0, ntile = ntl + 4;
    const int kr = tid >> 3, kc = tid & 7;
    const int vtp = tid & 31, vcg = (tid >> 5) & 7;
    u32x4 kreg, v0reg, v1reg; int jn = 0;
    auto tile_valid = [&](int j) -> bool { if (j >= ntl) return true; const int kp0 = qb * 128 - 128 + 64 * j; return kp0 >= 0 && kp0 < SEQ; };
    auto tile_k = [&](int j) -> const GAS bf16_t* { return j < ntl ? Klat + (size_t)(qb * 128 - 128 + 64 * j) * LDP : Kctx + (size_t)((j - ntl) * 64) * LDP; };
    auto tile_v = [&](int j) -> const GAS bf16_t* { return j < ntl ? Vlat + (size_t)(qb * 128 - 128 + 64 * j) * LDP : Vctx + (size_t)((j - ntl) * 64) * LDP; };
    while (jn < ntile && !tile_valid(jn)) ++jn;
    { const GAS bf16_t* kp = tile_k(jn); const GAS bf16_t* vp = tile_v(jn);
      kreg = *(const GAS u32x4*)(kp + (size_t)kr * LDP + kc * 8);
      if (tid < 256) { v0reg = *(const GAS u32x4*)(vp + (size_t)(2 * vtp) * LDP + vcg * 8); v1reg = *(const GAS u32x4*)(vp + (size_t)(2 * vtp + 1) * LDP + vcg * 8); } }
    int pp = 0;
    while (jn < ntile) {
        const int j = jn;
        LAS bf16_t* Ks = Ks0 + pp * 9216; LAS bf16_t* Vt = Vt0 + pp * 9216; pp ^= 1;
        *(LAS u32x4*)(Ks + kr * 72 + kc * 8) = kreg;
        if (tid < 256) { LAS unsigned* dp = (LAS unsigned*)(Vt + (8 * vcg) * 72 + 2 * vtp);
#pragma unroll
            for (int i = 0; i < 4; ++i) { dp[(2 * i) * 36] = (v0reg[i] & 0xffffu) | (v1reg[i] << 16); dp[(2 * i + 1) * 36] = (v0reg[i] >> 16) | (v1reg[i] & 0xffff0000u); } }
        __syncthreads();
        ++jn; while (jn < ntile && !tile_valid(jn)) ++jn;
        if (jn < ntile && !(dry && (ATT_DRY_MODE & 2))) { const GAS bf16_t* kp = tile_k(jn); const GAS bf16_t* vp = tile_v(jn);
            kreg = *(const GAS u32x4*)(kp + (size_t)kr * LDP + kc * 8);
            if (tid < 256) { v0reg = *(const GAS u32x4*)(vp + (size_t)(2 * vtp) * LDP + vcg * 8); v1reg = *(const GAS u32x4*)(vp + (size_t)(2 * vtp + 1) * LDP + vcg * 8); } }
        const bool local = j < ntl;
        if (local && ((half == 0 && j == 5) || (half == 1 && j == 0))) continue;
        f32x4 S[4][4];
#pragma unroll
        for (int kt = 0; kt < 4; ++kt) { const LAS bf16_t* kp = Ks + (kt * 16 + fr) * 72 + fq * 8; const bf16x8 k0 = *(const LAS bf16x8*)kp, k1 = *(const LAS bf16x8*)(kp + 32);
#pragma unroll
            for (int rt = 0; rt < 4; ++rt) { f32x4 sv = (f32x4){0.f, 0.f, 0.f, 0.f}; sv = MFMA16(k0, qf[rt][0], sv); sv = MFMA16(k1, qf[rt][1], sv); S[rt][kt] = sv; } }
        if (dry && (ATT_DRY_MODE & 1)) { O[0][0] += S[0][0] + S[1][1] + S[2][2] + S[3][3]; continue; }
        if (local && (64 * j - 64 * half == 0 || 64 * j - 64 * half == 256)) { const int kk0 = -128 + 64 * j;
#pragma unroll
            for (int rt = 0; rt < 4; ++rt) { const int qq = half * 64 + rt * 16 + fr;
#pragma unroll
                for (int kt = 0; kt < 4; ++kt)
#pragma unroll
                    for (int e = 0; e < 4; ++e) { const int df = kk0 + kt * 16 + fq * 4 + e - qq; if (df < -128 || df > 128) S[rt][kt][e] = -INFINITY; } } }
        bf16x8 pb[4][2];
#pragma unroll
        for (int rt = 0; rt < 4; ++rt) { float mx = -INFINITY;
#pragma unroll
            for (int kt = 0; kt < 4; ++kt) mx = fmaxf(mx, fmaxf(fmaxf(S[rt][kt][0], S[rt][kt][1]), fmaxf(S[rt][kt][2], S[rt][kt][3])));
            mx = fmaxf(mx, __shfl_xor(mx, 16)); mx = fmaxf(mx, __shfl_xor(mx, 32));
            const float mnew = fmaxf(mrow[rt], mx), alpha = __builtin_amdgcn_exp2f(mrow[rt] - mnew); mrow[rt] = mnew;
            float ps = 0.f;
#pragma unroll
            for (int kt = 0; kt < 4; ++kt)
#pragma unroll
                for (int e = 0; e < 4; ++e) { const float pv = __builtin_amdgcn_exp2f(S[rt][kt][e] - mnew); S[rt][kt][e] = pv; ps += pv; }
            lrow[rt] = lrow[rt] * alpha + ps;
#pragma unroll
            for (int dt = 0; dt < 4; ++dt) O[dt][rt] = O[dt][rt] * alpha;
#pragma unroll
            for (int sidx = 0; sidx < 2; ++sidx) { u32x4 t; t.x = pk2(S[rt][2 * sidx][0], S[rt][2 * sidx][1]); t.y = pk2(S[rt][2 * sidx][2], S[rt][2 * sidx][3]); t.z = pk2(S[rt][2 * sidx + 1][0], S[rt][2 * sidx + 1][1]); t.w = pk2(S[rt][2 * sidx + 1][2], S[rt][2 * sidx + 1][3]);
                pb[rt][sidx] = __builtin_bit_cast(bf16x8, t); } }
#pragma unroll
        for (int dt = 0; dt < 4; ++dt)
#pragma unroll
            for (int sidx = 0; sidx < 2; ++sidx) { const LAS bf16_t* vp = Vt + (dt * 16 + fr) * 72 + 32 * sidx + 4 * fq;
                const u32x2 lo = *(const LAS u32x2*)vp, hi = *(const LAS u32x2*)(vp + 16);
                const u32x4 t = (u32x4){lo.x, lo.y, hi.x, hi.y}; const bf16x8 av = __builtin_bit_cast(bf16x8, t);
#pragma unroll
                for (int rt = 0; rt < 4; ++rt) O[dt][rt] = MFMA16(av, pb[rt][sidx], O[dt][rt]); }
    }
#pragma unroll
    for (int rt = 0; rt < 4; ++rt) { float l = lrow[rt]; l += __shfl_xor(l, 16); l += __shfl_xor(l, 32); const float inv = 1.f / l;
        GAS bf16_t* op = Q + (size_t)(half * 64 + rt * 16 + fr) * LDP + g * 64;
#pragma unroll
        for (int dt = 0; dt < 4; ++dt) { const f32x4 o = O[dt][rt] * inv; u32x2 w; w.x = pk2(o[0], o[1]); w.y = pk2(o[2], o[3]); *DST((GAS u32x2*)(op + dt * 16 + fq * 4)) = w; } }
    __syncthreads();
}

DI int xcd_vb() { const int G = gridDim.x, bx = blockIdx.x; return (G % 8 == 0) ? (bx % 8) * (G / 8) + bx / 8 : bx; }
DI void phase_x1(const Args& a, int l, int hf, LAS unsigned char* lds, bool dry) {
    GAS bf16_t* PJ = (GAS bf16_t*)(AWS + WS_BIG);
    const int c0 = hf ? 32 : 0;
    const int nch = hf ? 256 : 288;
    const bool ctx_mix = (hf == 0 && l == 0);
    const int s0 = (hf == 0 && !ctx_mix) ? 16 : (hf ? 16 : 0);
    const int nsg = 144 - s0;
    const int n_sgu = nsg * 4, n_g1 = nch * 2, n_pp = nch;
    const GlaW gw{AIN(13) + l * 16 * 256, AIN(14) + l * 256, AIN(15) + l * 16 * 256, AIN(16) + l * 256};
    for (int it = xcd_vb(); it < n_sgu + n_g1 + n_pp; it += gridDim.x) {
        if (it < n_sgu) { const int ck = s0 + (it >> 2), g = it & 3;
            if (!dry || (DRYSEL & 1)) sgu_item(PJ + (size_t)ck * 128 * LDP, g, AIN(11) + (size_t)l * 4 * 128 * 128, AIN(12) + l * 512, AIN(10) + l * 512, lds, dry);
        } else if (it < n_sgu + n_g1) { const int r = it - n_sgu; const int cid = c0 + (r >> 1), hp = r & 1;
            if (!dry || (DRYSEL & 2)) gla_pass1_item(PJ + (size_t)cid * 64 * LDP, hp, (GAS bf16_t*)(AWS + WS_KV) + (size_t)cid * 65536, (GAS float*)(AWS + WS_DEC) + cid * 512, gw, lds, dry);
        } else { const int cid = c0 + (it - n_sgu - n_g1); const bool isctx = cid < 32;
            const int t0 = isctx ? -1 : (((cid - 32) * 64) & 4095);
            if (!dry || (DRYSEL & 4)) qkprep_item(PJ + (size_t)cid * 64 * LDP, t0, !isctx || l == 0, AIN(7) + l * 64, AIN(8) + l * 64, (const GAS float*)(AWS + WS_ROPE), dry, lds);
        }
    }
}

DI void phase_x2(const Args& a, int l, int hf, LAS unsigned char* lds, bool dry) {
    GAS bf16_t* PJ = (GAS bf16_t*)(AWS + WS_BIG);
    const int n_att_lat = 256, n_att_ctx = 0;
    const int n_scan = hf ? 128 : 256;
    const int n_att = n_att_lat + n_att_ctx;
    for (int it = xcd_vb(); it < n_att + n_scan; it += gridDim.x) {
        if (it < n_att_lat) { const int kh = it & 1, qb = (it >> 1) & 31, bl = it >> 6;
            const int b = hf * 4 + bl;
            GAS bf16_t* lat0 = PJ + (size_t)(NCTX + bl * SEQ) * LDP;
            const GAS bf16_t* cx0 = PJ + (size_t)(b * CTXL) * LDP;
            if (!dry || (DRYSEL & 1)) attn_item(lat0 + (size_t)(qb * 128) * LDP + C_QB + kh * 256, lat0 + C_KB + kh * 64, lat0 + C_VB + kh * 64, qb, cx0 + C_KB + kh * 64, cx0 + C_VB + kh * 64, AIN(9) + l * 8 + kh * 4, lds, dry);
        } else if (it < n_att) { const int r = it - n_att_lat; const int kh = r & 1, qb = (r >> 1) & 1, b = r >> 2;
            GAS bf16_t* cx0 = PJ + (size_t)(b * CTXL) * LDP;
            if (!dry || (DRYSEL & 1)) attn_item(cx0 + (size_t)(qb * 128) * LDP + C_QB + kh * 256, nullptr, nullptr, qb, cx0 + C_KB + kh * 64, cx0 + C_VB + kh * 64, AIN(9) + l * 8 + kh * 4, lds, dry);
        } else { const int r = it - n_att; const int slice = r & 15, d = (r >> 4) & 1, bb = r >> 5;
            if (!dry || (DRYSEL & 2)) gla_scan_item(a, hf, hf ? 4 + bb : bb, d, slice, dry);
        }
    }
}

DI void phase_x3(const Args& a, int l, int hf, LAS unsigned char* lds, bool dry) {
    GAS bf16_t* PJ = (GAS bf16_t*)(AWS + WS_BIG);
    const int c0 = (hf == 0 && l == 0) ? 0 : 32;
    const int nch = 288 - c0;
    const GlaW gw{AIN(13) + l * 16 * 256, AIN(14) + l * 256, AIN(15) + l * 16 * 256, AIN(16) + l * 256};
    for (int it = xcd_vb(); it < nch * 2; it += gridDim.x) { const int cid = c0 + (it >> 1), hp = it & 1;
        gla_pass3_item(PJ + (size_t)cid * 64 * LDP, hp, (const GAS bf16_t*)(AWS + WS_KV) + (size_t)cid * 65536, gw, AIN(17) + l * 128, lds, dry); }
    if (hf == 0 && l == 0 && xcd_vb() >= (int)gridDim.x - 32) {
        const int r = xcd_vb() - ((int)gridDim.x - 32); const int kh = r & 1, qb = (r >> 1) & 1, b = r >> 2;
        GAS bf16_t* cx0 = PJ + (size_t)(b * CTXL) * LDP;
        attn_item(cx0 + (size_t)(qb * 128) * LDP + C_QB + kh * 256, nullptr, nullptr, qb, cx0 + C_KB + kh * 64, cx0 + C_VB + kh * 64, AIN(9) + l * 8 + kh * 4, lds, dry); }
}


#define XB_TMO      128
#define XB_XCNT(j)  (256  + 64 * (j))
#define XB_XSUB(j)  (1280 + 64 * (j))
#define XB_XGEN(j)  (2304 + 64 * (j))
#define XB_TOP      3328
#define XB_TOPGEN   3392
#define XCD_BAR_WORDS 3456
#define XB_SPIN_CAP (1u << 18)
DI unsigned xb_ld(unsigned* p)              { return __hip_atomic_load(p, __ATOMIC_RELAXED, __HIP_MEMORY_SCOPE_AGENT); }
DI unsigned xb_add(unsigned* p, unsigned v) { return __hip_atomic_fetch_add(p, v, __ATOMIC_RELAXED, __HIP_MEMORY_SCOPE_AGENT); }
DI unsigned xb_xcc_id() { return (unsigned)__builtin_amdgcn_s_getreg((3 << 11) | 20) & 0xFu; }
#define XB_SPIN(cond, bar) do { unsigned _sp = 0; while (cond) { __builtin_amdgcn_s_sleep(1); \
    if ((++_sp & 255u) == 0u) { if (xb_ld(&(bar)[XB_TMO])) break; if (_sp > XB_SPIN_CAP) { atomicAdd(&(bar)[XB_TMO], 1u); break; } } } } while (0)
struct XcdBarrier { unsigned* bar; unsigned x; volatile LAS unsigned* st; };
DI XcdBarrier xcd_barrier_post(unsigned* bar, volatile LAS unsigned* st) {
    XcdBarrier b; b.bar = bar; b.x = xb_xcc_id(); b.st = st;
    if (threadIdx.x == 0) (void)xb_add(&bar[XB_XCNT(b.x)], 1u);
    return b;
}
DI void xcd_barrier_complete(unsigned* bar, unsigned x, unsigned& nloc, unsigned& nx) {
    const unsigned G = gridDim.x * gridDim.y * gridDim.z;
    unsigned sum, cnt, mine, sp = 0u;
    for (;;) {
        sum = 0u; cnt = 0u; mine = 0u;
#pragma unroll
        for (unsigned j = 0; j < 16; ++j) { const unsigned c = xb_ld(&bar[XB_XCNT(j)]); sum += c; cnt += (c > 0u) ? 1u : 0u; mine = (j == x) ? c : mine; }
        if (sum == G) break;
        __builtin_amdgcn_s_sleep(1);
        if ((++sp & 255u) == 0u) { if (xb_ld(&bar[XB_TMO])) break; if (sp > XB_SPIN_CAP) { atomicAdd(&bar[XB_TMO], 1u); break; } }
    }
    nloc = mine > 0u ? mine : 1u; nx = cnt > 0u ? cnt : 1u;
}
template <int NOFENCE = 0> DI void xcd_barrier(const XcdBarrier& b) {
    asm volatile("s_waitcnt vmcnt(0)" ::: "memory");
    __syncthreads();
    if (threadIdx.x == 0) {
        unsigned* bar = b.bar;
        __builtin_amdgcn_s_waitcnt(0);
        unsigned nloc = b.st[0], nx = b.st[1]; const unsigned round = b.st[2];
        if (nloc == 0u) { xcd_barrier_complete(bar, b.x, nloc, nx); b.st[0] = nloc; b.st[1] = nx; }
        b.st[2] = round + 1u;
        const unsigned old = xb_add(&bar[XB_XSUB(b.x)], 1u);
        if (old + 1u == (round + 1u) * nloc) {
            __builtin_amdgcn_fence(__ATOMIC_RELEASE, "agent");
            asm volatile("s_waitcnt vmcnt(0)" ::: "memory");
            const unsigned og = xb_add(&bar[XB_TOP], 1u);
            if (og + 1u == (round + 1u) * nx) xb_add(&bar[XB_TOPGEN], 1u);
        }
        XB_SPIN(xb_ld(&bar[XB_TOPGEN]) == round, bar);
        __builtin_amdgcn_fence(__ATOMIC_ACQUIRE, "agent");
        asm volatile("s_waitcnt vmcnt(0)" ::: "memory");
    }
    __syncthreads();
}

constexpr int NPHASE = 31;
#ifndef DBG_N
#define DBG_N NPHASE
#endif
#ifndef DBG_NELEM
#define DBG_NELEM 0
#endif
#ifndef DBG_OFF
#define DBG_OFF 0
#endif
#ifndef DBG_F32
#define DBG_F32 0
#endif
#ifndef DBG_NELEM2
#define DBG_NELEM2 0
#endif
#ifndef DBG_OFF2
#define DBG_OFF2 0
#endif
#ifndef PHM
#define PHM 0xFFFF
#endif

DI void run_phase(const Args& a, int ph, LAS unsigned char* lds, bool dry) {
    if (ph == 0) { if (PHM & 1) phase_prologue(a, lds); return; }
    const int l = (ph - 1) / 15, q = (ph - 1) % 15;
    GAS GAS unsigned char* wt = AWS + WS_WT + (size_t)l * WT_LAYER;
    const int G = gridDim.x, cidx = blockIdx.x;
    const GAS float* MOD = (const GAS float*)(AWS + WS_MOD);
    if (q == 0) { if (PHM & 2) phase_modulate(a, l, 0, 0); return; }
    if (q >= 1 && q <= 10) {
        const int hf = (q - 1) / 5, k = (q - 1) % 5;
        const int rowshift = hf ? HALF_ROWS : 0;
        if (k == 0) { if (PHM & 4) {
            pg8::Gemm g{(const GAS char*)(AWS + WS_H) + (size_t)rowshift * DM * 2, (const GAS char*)(wt + WT_IN), DM, DM, DM, 0, 0, 0, 0};
            pg8::Order S; S.init(hf ? 8 : 0, hf ? 64 : 72, NPAD / 256, 1, G, cidx);
            pg8::EpiProj E{(GAS bf16_t*)(AWS + WS_BIG), 0};
            pg8::gemm_phase<pg8::EpiProj>(lds, g, S, E);
            if (l == 0) {
                const int nwg = (hf ? 64 : 72) * (NPAD / 256), busy = nwg % G;
                if (busy != 0 && cidx >= busy) { const int tid_ = otid(), wave = tid_ >> 6, lane = tid_ & 63;
                    const int worker = (cidx - busy) * 8 + wave, nworker = (G - busy) * 8;
                    const int lo = hf ? 4980 : 0, hi = hf ? PER_L_ITEMS : 4980;
                    for (int it = lo + worker; it < hi; it += nworker) transpose_item_of_layer(a, 1, it, (LAS float*)(lds + wave * 16384), lane); } } }
        } else if (k == 1) { if (PHM & 8) phase_x1(a, l, hf, lds, dry); }
        else if (k == 2) { if (PHM & 16) phase_x2(a, l, hf, lds, dry); }
        else if (k == 3) { if (PHM & 32) phase_x3(a, l, hf, lds, dry); }
        else if (PHM & 64) {
            const bool withctx = (hf == 0 && l == 0);
            pg8::Gemm g{(const GAS char*)(AWS + WS_BIG), (const GAS char*)(wt + WT_BR), LDP, 512, 512, C_U * 2, (C_QB - C_U) * 2, (C_RC - 2 * C_QB + C_U) * 2, 1024 * 512 * 2};
            pg8::Order S; S.init(withctx ? 0 : 8, withctx ? 72 : 64, 4, 3, G, cidx);
            pg8::EpiMerge E{(const GAS bf16_t*)(AWS + WS_BIG), 0, (GAS bf16_t*)(AWS + WS_H) + (size_t)rowshift * DM};
            pg8::gemm_phase<pg8::EpiMerge>(lds, g, S, E);
        }
        return;
    }
    const int pm0 = (l == 0) ? 0 : 8, nM = 136 - pm0;
    if (q == 11) { if (PHM & 128) {
        pg8::Gemm g{(const GAS char*)(AWS + WS_H), (const GAS char*)(wt + WT_O), DM, DM, DM, 0, 0, 0, 0};
        pg8::Order S; S.init(pm0, nM, 4, 1, G, cidx);
        pg8::EpiResid E{l == 0 ? AIN(2) : (const GAS float*)(AWS + WS_CTXBUF), l == 0 ? AIN(0) : (const GAS float*)AOUT, (GAS float*)(AWS + WS_CTXBUF), AOUT, MOD + (size_t)(l * 9) * 6144 + 2 * 1024};
        pg8::gemm_phase<pg8::EpiResid>(lds, g, S, E); }
    } else if (q == 12) { if (PHM & 2) phase_modulate(a, l, 1, pm0 * 256);
    } else if (q == 13) { if (PHM & 256) {
        pg8::Gemm g{(const GAS char*)(AWS + WS_H), (const GAS char*)(wt + WT_F1), DM, DM, DM, 0, 0, 0, 0};
        pg8::Order S; S.init(pm0, nM, 16, 1, G, cidx);
        pg8::EpiFF1 E{(GAS bf16_t*)(AWS + WS_BIG)};
        pg8::gemm_phase<pg8::EpiFF1>(lds, g, S, E); }
    } else if (PHM & 512) {
        { pg8::Gemm g{(const GAS char*)(AWS + WS_BIG), (const GAS char*)(wt + WT_F2), FF, FF, FF, 0, 0, 0, 0};
          pg8::Order S; S.init(8, 128, 4, 1, G, cidx);
          pg8::EpiResid E{(const GAS float*)(AWS + WS_CTXBUF), (const GAS float*)AOUT, (GAS float*)(AWS + WS_CTXBUF), AOUT, MOD + (size_t)(l * 9) * 6144 + 5 * 1024};
          pg8::gemm_phase<pg8::EpiResid>(lds, g, S, E); }
        if (l == 0) {
          pg8::Gemm g{(const GAS char*)(AWS + WS_BIG), (const GAS char*)(wt + WT_F2), FF, FF, 1024, 0, 2048, 0, 2048};
          pg8::Order S; S.init(0, 8, 4, 4, G, cidx, 1);
          pg8::EpiPartial E{(GAS float*)(AWS + WS_PART), MOD + (size_t)(l * 9) * 6144 + 5 * 1024};
          pg8::gemm_phase<pg8::EpiPartial>(lds, g, S, E); }
    }
}

__global__ void __launch_bounds__(512, 2) mega_fwd(Args a) {
    extern __shared__ __attribute__((aligned(16))) unsigned char lds_raw[];
    LAS unsigned char* lds = (LAS unsigned char*)lds_raw;
    cg::grid_group grid = cg::this_grid();
    volatile LAS unsigned* misc = (volatile LAS unsigned*)(lds + 143360);
    if (threadIdx.x < 4) misc[threadIdx.x] = 0u;
    if (threadIdx.x == 0) *(volatile LAS unsigned long long*)(lds + 143376) = (unsigned long long)(AWS + WS_PART);
    __syncthreads();
    XcdBarrier bar = xcd_barrier_post((unsigned*)AWS + 4096, misc);
    if (a.ph_lo < 0) grid.sync();
    for (int ph = a.ph_lo; ph < a.ph_hi; ++ph) {
        Args b = a; int phv = ph;
        asm volatile("" : "+s"(b.ws), "+s"(b.out), "+s"(phv));
        int nrep = 1, drymatch = 0;
        if (DRYMASK && phv > 0) { const int q_ = (phv - 1) % 15; const int k_ = (q_ >= 1 && q_ <= 10) ? (q_ - 1) % 5 : 0;
            if (k_ >= 1 && k_ <= 3 && ((DRYMASK >> (k_ - 1)) & 1)) { nrep = 2; drymatch = 1; } }
        if (DUPMASK) { const int q_ = (phv - 1) % 15; bool dup = false;
            if (phv > 0) { if ((DUPMASK & 1) && (q_ == 1 || q_ == 6)) dup = true; if ((DUPMASK & 2) && q_ == 13) dup = true; if ((DUPMASK & 4) && (q_ == 0 || q_ == 12)) dup = true; if ((DUPMASK & 8) && (q_ == 5 || q_ == 10)) dup = true; }
            else if (DUPMASK & 16) dup = true;
            if (dup) nrep = 2; }
        nrep = __builtin_amdgcn_readfirstlane(nrep); drymatch = __builtin_amdgcn_readfirstlane(drymatch);
        for (int rep = 0; rep < nrep; ++rep) {
            run_phase(b, phv, lds, drymatch != 0 && rep == 0);
            if (rep + 1 < nrep) xcd_barrier(bar);
        }
        if (ph + 1 < a.ph_hi) { xcd_barrier(bar); if (DBL_BAR) xcd_barrier(bar); }
    }
    if (DBG_NELEM > 0) {
        xcd_barrier(bar);
        for (size_t i = (size_t)blockIdx.x * 512 + threadIdx.x; i < (size_t)NLAT * DM; i += (size_t)gridDim.x * 512) {
            float v = DBG_F32 ? ((const GAS float*)(AWS + (size_t)DBG_OFF))[i % (size_t)DBG_NELEM] : bf2f(((const GAS bf16_t*)(AWS + (size_t)DBG_OFF))[i % (size_t)DBG_NELEM]);
            if (DBG_NELEM2 > 0) v += bf2f(((const GAS bf16_t*)(AWS + (size_t)DBG_OFF2))[i % (size_t)DBG_NELEM2]);
            AOUT[i] = v; }
    }
}

extern "C" void kernel_launch(void* const* d_in, const int* in_sizes, int n_in, void* d_out, int out_size, void* d_ws, size_t ws_size, hipStream_t stream) {
    static int grid = 0;
    if (grid == 0) {
        int dev = 0, cus = 0, per_cu = 0;
        hipGetDevice(&dev);
        hipDeviceGetAttribute(&cus, hipDeviceAttributeMultiprocessorCount, dev);
        hipFuncSetAttribute((const void*)mega_fwd, hipFuncAttributeMaxDynamicSharedMemorySize, LDS_BYTES);
        hipOccupancyMaxActiveBlocksPerMultiprocessor(&per_cu, (const void*)mega_fwd, 512, LDS_BYTES);
        (void)hipGetLastError();
        if (per_cu < 1) per_cu = 1;
        grid = cus * 1;
        if (ws_size < WS_END) fprintf(stderr, "kernel_launch: workspace too small: %zu < %zu\n", ws_size, (size_t)WS_END);
        if (n_in != 22) fprintf(stderr, "kernel_launch: expected 22 inputs, got %d\n", n_in);
    }
    if (hipMemsetAsync(d_ws, 0, 65536, stream) != hipSuccess) fprintf(stderr, "kernel_launch: memset failed\n");
    Args a{};
    for (int i = 0; i < 22; ++i) a.in[i] = (const float*)d_in[i];
    a.out = (float*)d_out; a.ws = (unsigned char*)d_ws; a.ph_lo = 0; a.ph_hi = DBG_N;
    void* args[] = {&a};
    hipError_t e = hipLaunchCooperativeKernel((const void*)mega_fwd, dim3(grid), dim3(512), args, LDS_BYTES, stream);
    if (e != hipSuccess) fprintf(stderr, "cooperative launch failed: %s (grid %d)\n", hipGetErrorString(e), grid);
}
```

```cpp
#include <hip/hip_runtime.h>
#include <hip/hip_cooperative_groups.h>
#include <cstdio>
#include <cstdint>
namespace cg = cooperative_groups;

#define DI __device__ __forceinline__
#define LAS __attribute__((address_space(3)))
#define GAS __attribute__((address_space(1)))
#define AIN(k) ((const GAS float*)a.in[k])
#define AOUT ((GAS float*)a.out)
#define AWS ((GAS unsigned char*)a.ws)
typedef unsigned short bf16_t;
typedef short bf16x8 __attribute__((ext_vector_type(8)));
typedef float f32x4 __attribute__((ext_vector_type(4)));
typedef unsigned u32x4 __attribute__((ext_vector_type(4)));
typedef unsigned u32x2 __attribute__((ext_vector_type(2)));

#define DST(p) (dry ? (decltype(p))(g_sink + ((size_t)(p) & 0xFFFFF0u)) : (p))
#ifndef DBL_BAR
#define DBL_BAR 0
#endif
#ifndef DRY_NOFENCE
#define DRY_NOFENCE 0
#endif
#ifndef P1_DRY_MODE
#define P1_DRY_MODE 0
#endif
#ifndef ATT_DRY_MODE
#define ATT_DRY_MODE 0
#endif
#ifndef DRYSEL
#define DRYSEL 7
#endif
#ifndef DRYMASK
#define DRYMASK 0
#endif
#ifndef DUPMASK
#define DUPMASK 0
#endif
#ifndef X1MASK
#define X1MASK 7
#endif
constexpr int DM = 1024, NB = 8, SEQ = 4096, CTXL = 256;
constexpr int NCTX = NB * CTXL;
constexpr int NLAT = NB * SEQ;
constexpr int NROW = NCTX + NLAT;
constexpr int LDP = 6432;
constexpr int NPAD = 6656;
constexpr int FF = 4096;
constexpr int C_U = 0, C_VA = 512, C_QB = 1024, C_KB = 1536, C_VB = 1664, C_QC = 1792, C_KC = 2048, C_VC = 2304, C_RC = 2816, C_ZF = 3328, C_ZB = 3344, C_G = 3360;
constexpr int HALF_ROWS = 16384;
constexpr float EPSV = 1e-6f;
constexpr float LOG2E = 1.4426950408889634f;

constexpr size_t MiB = 1u << 20;
constexpr size_t WS_ROPE = 1 * MiB;
constexpr size_t WS_MOD = 1 * MiB + 65536;
constexpr size_t WS_CTXST = 2 * MiB;
constexpr size_t WS_DEC = 4 * MiB;
constexpr size_t WS_WT = 8 * MiB;
constexpr size_t WT_LAYER = 34 * MiB;
constexpr size_t WT_IN = 0;
constexpr size_t WT_BR = (size_t)NPAD * 1024 * 2;
constexpr size_t WT_O = WT_BR + 3u * 1024 * 512 * 2;
constexpr size_t WT_F1 = WT_O + 1024u * 1024 * 2;
constexpr size_t WT_F2 = WT_F1 + 4096u * 1024 * 2;
constexpr size_t WS_CTXBUF = 76 * MiB;
constexpr size_t WS_H = 84 * MiB;
constexpr size_t WS_KV = 152 * MiB;
constexpr size_t WS_BIG = 188 * MiB;
constexpr size_t WS_PART = 460 * MiB;
constexpr size_t WS_END = 492 * MiB;
static_assert(WT_F2 + 1024u * 4096 * 2 <= WT_LAYER, "wt");

constexpr int LDS_BYTES = 147456;

struct Args { const float* in[22]; float* out; unsigned char* ws; int ph_lo, ph_hi; };

DI int otid() { int t = threadIdx.x; asm volatile("" : "+v"(t)); return t; }
DI int obid() { int t = blockIdx.x; asm volatile("" : "+s"(t)); return t; }
DI float bf2f(unsigned short h) { return __uint_as_float((unsigned)h << 16); }
DI unsigned f2bf(float f) { unsigned u = __float_as_uint(f); return (u + 0x7fffu + ((u >> 16) & 1u)) >> 16; }
typedef __bf16 bf16x2_t __attribute__((ext_vector_type(2)));
typedef float f32x2_t __attribute__((ext_vector_type(2)));
DI unsigned pk2(float lo, float hi) { f32x2_t v = {lo, hi}; bf16x2_t b = __builtin_convertvector(v, bf16x2_t); return __builtin_bit_cast(unsigned, b); }
DI void unpack8(const u32x4 w, float* f) {
#pragma unroll
    for (int i = 0; i < 4; ++i) { f[2 * i] = __uint_as_float(w[i] << 16); f[2 * i + 1] = __uint_as_float(w[i] & 0xffff0000u); }
}
DI u32x4 pack8(const float* f) { u32x4 w; w.x = pk2(f[0], f[1]); w.y = pk2(f[2], f[3]); w.z = pk2(f[4], f[5]); w.w = pk2(f[6], f[7]); return w; }
template <int CTRL, int RM> DI float dpp_f(float x) { return __builtin_bit_cast(float, __builtin_amdgcn_update_dpp(0, __builtin_bit_cast(int, x), CTRL, RM, 0xF, false)); }
DI float wave_sum(float v) {
#pragma unroll
    for (int o = 1; o < 64; o <<= 1) v += __shfl_xor(v, o);
    return v;
}
DI float sum8(float v) {
    v += dpp_f<0xB1, 0xF>(v); v += dpp_f<0x4E, 0xF>(v); v += dpp_f<0x141, 0xF>(v); return v;
}
DI float frcp(float x) { return __builtin_amdgcn_rcpf(x); }
DI float gelu_tanh(float x) { const float y = 0.7978845608028654f * (x + 0.044715f * x * x * x); return x * (1.f - frcp(1.f + __expf(2.f * y))); }
DI float log_sigmoid(float x) { return fminf(x, 0.f) - 0.6931471805599453f * __builtin_amdgcn_logf(1.f + __builtin_amdgcn_exp2f(-1.4426950408889634f * fabsf(x))); }
#define MFMA16(a, b, c) __builtin_amdgcn_mfma_f32_16x16x32_bf16((a), (b), (c), 0, 0, 0)

namespace pg8 {
constexpr int BM = 256, BK = 64, HALF = 128, HTB = HALF * BK * 2, STAGE_BYTES = 8 * HTB, NXCD = 8, WGM = 8;
DI int lds_byte(int r, int c) { const int st = (r >> 4) * 2 + (c >> 5), rr = r & 15, cc = c & 31, ob = rr * 64 + cc * 2; return st * 1024 + (ob ^ (((ob >> 9) & 1) << 5)); }
DI void stage_rc(int b, int& R, int& C) { const int st = b / 1024, sb = b % 1024, swz = sb ^ (((sb >> 9) & 1) << 5); R = (st >> 1) * 16 + swz / 64; C = (st & 1) * 32 + (swz % 64) / 2; }
DI int perm32(int rho) { const int n = rho >> 4, i = rho & 15; return 8 * (i >> 2) + 4 * n + (i & 3); }

struct Unit { int pm, pn, z; };
struct Gemm { const GAS char* A; const GAS char* Bt; int lda, ldb, K; int zA0, dA1, dA2, dB;
    DI size_t za(int z) const { return (size_t)(zA0 + z * dA1 + (z >> 1) * dA2); }
    DI size_t zb(int z) const { return (size_t)z * (size_t)dB; } };

struct Order {
    int pm0, nM, nN, nwg, G, c, nz, spread;
    DI void init(int pm0_, int nM_, int nN_, int nz_, int G_, int c_, int spread_ = 0) { pm0 = pm0_; nM = nM_; nN = nN_; nwg = nM * nN; G = G_; c = c_; nz = nz_; spread = spread_; }
    DI bool next(int i, Unit& u) const {
        if (spread) {
            const long L = (long)i * G + c; if (L >= (long)nwg * nz) return false;
            const int t = (int)(L / nz); u.z = (int)(L - (long)t * nz); u.pm = pm0 + t / nN; u.pn = t % nN; return true; }
        const int ti = i / nz; const int z = i - ti * nz;
        const long L = (long)ti * G + c; if (L >= nwg) return false;
        int wgid = (int)L; { const int q = nwg / NXCD, r = nwg % NXCD, xcd = wgid % NXCD, off = wgid / NXCD; wgid = (xcd < r ? xcd * (q + 1) : r * (q + 1) + (xcd - r) * q) + off; }
        const int nig = WGM * nN, gid = wgid / nig, fm = gid * WGM, gsz = (nM - fm) < WGM ? (nM - fm) : WGM;
        u.pm = pm0 + fm + ((wgid % nig) % gsz); u.pn = (wgid % nig) / gsz; u.z = z; return true;
    }
};

template <class Epi>
DI void gemm_phase(LAS unsigned char* lds, const Gemm g, const Order& S, const Epi& E) {
    const int tid = otid(), wid = __builtin_amdgcn_readfirstlane(tid >> 6), lane = tid & 63, wr = wid >> 2, wc = wid & 3, fr = lane & 15, fq = lane >> 4;
    const int nt = g.K / BK;
    unsigned voffA[2], voffB[2];
#pragma unroll
    for (int i = 0; i < 2; ++i) { int R, C; stage_rc(tid * 16 + i * 8192, R, C); const int Rb = (R & ~31) + perm32(R & 31);
        voffA[i] = (unsigned)(R * g.lda + C) * 2u; voffB[i] = (unsigned)(Rb * g.ldb + C) * 2u; }
    const size_t kstep = (size_t)(BK * 2);
    const size_t hstepA = (size_t)HALF * g.lda * 2, hstepB = (size_t)HALF * g.ldb * 2;
    const size_t tstepA = 2 * hstepA, tstepB = 2 * hstepB;
    const unsigned ldsw = (unsigned)wid * 1024u;
    const int aoff = lds_byte(wr * 64 + fr, fq * 8), boff = lds_byte(wc * 32 + fr, fq * 8);
#define PG8_SA(b, h) (((b) * 2 + (h)) * HTB)
#define PG8_SB(b, h) ((4 + (b) * 2 + (h)) * HTB)
#define PG8_STAGE(bufoff, gbase, voff) do { _Pragma("unroll") for (int _i = 0; _i < 2; ++_i) \
        __builtin_amdgcn_global_load_lds((const unsigned*)((const GAS char*)(gbase) + (voff)[_i]), (LAS unsigned*)(lds + (bufoff) + ldsw + _i * 8192), 16, 0, 0); } while (0)
#define PG8_LDA(dst, b, h) do { _Pragma("unroll") for (int m = 0; m < 4; ++m) _Pragma("unroll") for (int k = 0; k < 2; ++k) dst[m][k] = *(const LAS bf16x8*)(lds + PG8_SA(b, h) + aoff + m * 2048 + k * 1024); } while (0)
#define PG8_LDB(dst, b, h) do { _Pragma("unroll") for (int n = 0; n < 2; ++n) _Pragma("unroll") for (int k = 0; k < 2; ++k) dst[n][k] = *(const LAS bf16x8*)(lds + PG8_SB(b, h) + boff + n * 2048 + k * 1024); } while (0)
#define PG8_MMA(ai, bj, At, Bt) do { __builtin_amdgcn_s_setprio(1); _Pragma("unroll") for (int m = 0; m < 4; ++m) _Pragma("unroll") for (int n = 0; n < 2; ++n) _Pragma("unroll") for (int k = 0; k < 2; ++k) \
        acc[ai][bj][m][n] = __builtin_amdgcn_mfma_f32_16x16x32_bf16(Bt[n][k], At[m][k], acc[ai][bj][m][n], 0, 0, 0); __builtin_amdgcn_s_setprio(0); } while (0)
#define PG8_WAIT_V(n) asm volatile("s_waitcnt vmcnt(" #n ")" ::: "memory")
#define PG8_WAIT_L(n) asm volatile("s_waitcnt lgkmcnt(" #n ")" ::: "memory")
#define PG8_BAR __builtin_amdgcn_s_barrier()
#define PG8_SCHED __builtin_amdgcn_sched_barrier(0)
    Unit cur, nxt; int ui = 0;
    if (!S.next(0, cur)) return;
    f32x4 acc[2][2][4][2];
#pragma unroll
    for (int a = 0; a < 2; ++a)
#pragma unroll
        for (int b = 0; b < 2; ++b)
#pragma unroll
            for (int m = 0; m < 4; ++m)
#pragma unroll
                for (int n = 0; n < 2; ++n) acc[a][b][m][n] = (f32x4){0.f, 0.f, 0.f, 0.f};
    bf16x8 At[4][2], B0[2][2], B1[2][2];
    const GAS char* cA = g.A + (size_t)cur.pm * tstepA + g.za(cur.z); const GAS char* cB = g.Bt + (size_t)cur.pn * tstepB + g.zb(cur.z);
    PG8_STAGE(PG8_SB(0, 0), cB, voffB); PG8_STAGE(PG8_SB(0, 1), cB + hstepB, voffB); PG8_STAGE(PG8_SA(0, 0), cA, voffA); PG8_STAGE(PG8_SA(0, 1), cA + hstepA, voffA);
    if (wr == 1) PG8_BAR;
    PG8_WAIT_V(2); PG8_BAR;
    PG8_STAGE(PG8_SB(1, 0), cB + kstep, voffB); PG8_STAGE(PG8_SA(1, 0), cA + kstep, voffA); PG8_STAGE(PG8_SB(1, 1), cB + hstepB + kstep, voffB);
    PG8_WAIT_V(6); PG8_BAR;
    for (;;) {
        const bool has_next = S.next(ui + 1, nxt);
        const GAS char* nA = has_next ? g.A + (size_t)nxt.pm * tstepA + g.za(nxt.z) : cA; const GAS char* nB = has_next ? g.Bt + (size_t)nxt.pn * tstepB + g.zb(nxt.z) : cB;
        for (int t = 0; t < nt; t += 2) {
            const bool last = (t == nt - 2);
            const GAS char* a1 = cA + (size_t)(t + 1) * kstep;
            const GAS char* a2 = last ? nA : cA + (size_t)(t + 2) * kstep; const GAS char* b2 = last ? nB : cB + (size_t)(t + 2) * kstep;
            const GAS char* a3 = a2 + kstep; const GAS char* b3 = b2 + kstep;
            PG8_LDB(B0, 0, 0); PG8_LDB(B1, 0, 1); PG8_SCHED; PG8_LDA(At, 0, 0); PG8_STAGE(PG8_SA(1, 1), a1 + hstepA, voffA);
            PG8_WAIT_V(8); PG8_WAIT_L(0); PG8_BAR; PG8_MMA(0, 0, At, B0); PG8_MMA(0, 1, At, B1); PG8_BAR; PG8_SCHED;
            PG8_LDA(At, 0, 1); PG8_STAGE(PG8_SB(0, 0), b2, voffB); PG8_STAGE(PG8_SB(0, 1), b2 + hstepB, voffB); PG8_STAGE(PG8_SA(0, 0), a2, voffA);
            PG8_WAIT_V(8); PG8_WAIT_L(0); PG8_BAR; PG8_MMA(1, 0, At, B0); PG8_MMA(1, 1, At, B1); PG8_BAR; PG8_SCHED;
            PG8_LDB(B0, 1, 0); PG8_LDB(B1, 1, 1); PG8_SCHED; PG8_LDA(At, 1, 0); PG8_STAGE(PG8_SA(0, 1), a2 + hstepA, voffA);
            PG8_WAIT_V(8); PG8_WAIT_L(0); PG8_BAR; PG8_MMA(0, 0, At, B0); PG8_MMA(0, 1, At, B1); PG8_BAR; PG8_SCHED;
            PG8_LDA(At, 1, 1); PG8_STAGE(PG8_SB(1, 0), b3, voffB); PG8_STAGE(PG8_SB(1, 1), b3 + hstepB, voffB); PG8_STAGE(PG8_SA(1, 0), a3, voffA);
            PG8_WAIT_V(8); PG8_WAIT_L(0); PG8_BAR; PG8_MMA(1, 0, At, B0); PG8_MMA(1, 1, At, B1); PG8_BAR; PG8_SCHED;
        }
        if (wr == 0) PG8_BAR;
        E(acc, cur, wr, wc, fr, fq);
        if (!has_next) break;
#pragma unroll
        for (int a = 0; a < 2; ++a)
#pragma unroll
            for (int b = 0; b < 2; ++b)
#pragma unroll
                for (int m = 0; m < 4; ++m)
#pragma unroll
                    for (int n = 0; n < 2; ++n) acc[a][b][m][n] = (f32x4){0.f, 0.f, 0.f, 0.f};
        cur = nxt; cA = nA; cB = nB; ++ui;
        if (wr == 1) PG8_BAR;
    }
    PG8_WAIT_V(0);
    PG8_BAR;
#undef PG8_SA
#undef PG8_SB
#undef PG8_STAGE
#undef PG8_LDA
#undef PG8_LDB
#undef PG8_MMA
#undef PG8_WAIT_V
#undef PG8_WAIT_L
#undef PG8_BAR
#undef PG8_SCHED
}

struct EpiProj {
    GAS bf16_t* O; int rowshift;
    DI void operator()(const f32x4 (&acc)[2][2][4][2], const Unit& u, int wr, int wc, int fr, int fq) const {
        const int row0 = u.pm * BM + wr * 64 + fr - rowshift, col0 = u.pn * BM + wc * 32 + 8 * fq;
#pragma unroll
        for (int ai = 0; ai < 2; ++ai)
#pragma unroll
            for (int m = 0; m < 4; ++m) { GAS bf16_t* rowp = O + (size_t)(row0 + ai * HALF + m * 16) * LDP + col0;
#pragma unroll
                for (int bj = 0; bj < 2; ++bj) { if (col0 + bj * HALF < LDP) { const f32x4 v0 = acc[ai][bj][m][0], v1 = acc[ai][bj][m][1];
                    u32x4 w; w.x = pk2(v0[0], v0[1]); w.y = pk2(v0[2], v0[3]); w.z = pk2(v1[0], v1[1]); w.w = pk2(v1[2], v1[3]);
                    *(GAS u32x4*)(rowp + bj * HALF) = w; } } }
    }
};
struct EpiFF1 {
    GAS bf16_t* O;
    DI void operator()(const f32x4 (&acc)[2][2][4][2], const Unit& u, int wr, int wc, int fr, int fq) const {
        const int row0 = u.pm * BM + wr * 64 + fr, col0 = u.pn * BM + wc * 32 + 8 * fq;
#pragma unroll
        for (int ai = 0; ai < 2; ++ai)
#pragma unroll
            for (int m = 0; m < 4; ++m) { GAS bf16_t* rowp = O + (size_t)(row0 + ai * HALF + m * 16) * FF + col0;
#pragma unroll
                for (int bj = 0; bj < 2; ++bj) { f32x4 v0 = acc[ai][bj][m][0], v1 = acc[ai][bj][m][1];
#pragma unroll
                    for (int e = 0; e < 4; ++e) { const float a = fmaxf(v0[e], 0.f), b = fmaxf(v1[e], 0.f); v0[e] = a * a; v1[e] = b * b; }
                    u32x4 w; w.x = pk2(v0[0], v0[1]); w.y = pk2(v0[2], v0[3]); w.z = pk2(v1[0], v1[1]); w.w = pk2(v1[2], v1[3]);
                    *(GAS u32x4*)(rowp + bj * HALF) = w; } }
    }
};
struct EpiMerge {
    const GAS bf16_t* P; int rowshift; GAS bf16_t* Mg;
    DI void operator()(const f32x4 (&acc)[2][2][4][2], const Unit& u, int wr, int wc, int fr, int fq) const {
        const int row0 = u.pm * BM + wr * 64 + fr, col0 = u.pn * BM + wc * 32 + 8 * fq;
#pragma unroll
        for (int ai = 0; ai < 2; ++ai)
#pragma unroll
            for (int m = 0; m < 4; ++m) { const int row = row0 + ai * HALF + m * 16;
                const GAS bf16_t* gp = P + (size_t)(row - rowshift) * LDP + C_G + u.z * 1024 + col0; GAS bf16_t* op = Mg + (size_t)row * DM + col0;
#pragma unroll
                for (int bj = 0; bj < 2; ++bj) { const u32x4 gw = *(const GAS u32x4*)(gp + bj * HALF); float gv[8]; unpack8(gw, gv); float r[8];
#pragma unroll
                    for (int e = 0; e < 4; ++e) { r[e] = acc[ai][bj][m][0][e] * frcp(1.f + __expf(-gv[e])); r[4 + e] = acc[ai][bj][m][1][e] * frcp(1.f + __expf(-gv[4 + e])); }
                    if (u.z > 0) { const u32x4 ow = *(const GAS u32x4*)(op + bj * HALF); float ov[8]; unpack8(ow, ov);
#pragma unroll
                        for (int e = 0; e < 8; ++e) r[e] += ov[e]; }
                    *(GAS u32x4*)(op + bj * HALF) = pack8(r); } }
    }
};
struct EpiResid {
    const GAS float* base_ctx; const GAS float* base_lat; GAS float* out_ctx; GAS float* out_lat; const GAS float* gate;
    DI void operator()(const f32x4 (&acc)[2][2][4][2], const Unit& u, int wr, int wc, int fr, int fq) const {
        const int u0 = u.pm * BM; const bool isctx = u0 < NCTX; const int mi = isctx ? 8 : ((u0 - NCTX) >> 12);
        const GAS float* bp = isctx ? base_ctx + (size_t)u0 * DM : base_lat + (size_t)(u0 - NCTX) * DM;
        GAS float* op = isctx ? out_ctx + (size_t)u0 * DM : out_lat + (size_t)(u0 - NCTX) * DM;
        const int r0 = wr * 64 + fr, col0 = u.pn * BM + wc * 32 + 8 * fq;
        const GAS float* gp = gate + (size_t)mi * 6144 + col0;
        f32x4 gv[2][2];
#pragma unroll
        for (int bj = 0; bj < 2; ++bj)
#pragma unroll
            for (int n = 0; n < 2; ++n) gv[bj][n] = *(const GAS f32x4*)(gp + bj * HALF + 4 * n);
#pragma unroll
        for (int ai = 0; ai < 2; ++ai)
#pragma unroll
            for (int m = 0; m < 4; ++m) { const size_t off = (size_t)(r0 + ai * HALF + m * 16) * DM + col0;
#pragma unroll
                for (int bj = 0; bj < 2; ++bj)
#pragma unroll
                    for (int n = 0; n < 2; ++n) { const f32x4 b = *(const GAS f32x4*)(bp + off + bj * HALF + 4 * n);
                        *(GAS f32x4*)(op + off + bj * HALF + 4 * n) = b + gv[bj][n] * acc[ai][bj][m][n]; } }
    }
};
struct EpiPartial {
    GAS float* part; const GAS float* gate;
    DI void operator()(const f32x4 (&acc)[2][2][4][2], const Unit& u, int wr, int wc, int fr, int fq) const {
        GAS float* op = part + ((size_t)u.z * NCTX + (size_t)(u.pm * BM)) * DM;
        const int r0 = wr * 64 + fr, col0 = u.pn * BM + wc * 32 + 8 * fq;
        const GAS float* gp = gate + (size_t)8 * 6144 + col0;
        f32x4 gv[2][2];
#pragma unroll
        for (int bj = 0; bj < 2; ++bj)
#pragma unroll
            for (int n = 0; n < 2; ++n) gv[bj][n] = *(const GAS f32x4*)(gp + bj * HALF + 4 * n);
#pragma unroll
        for (int ai = 0; ai < 2; ++ai)
#pragma unroll
            for (int m = 0; m < 4; ++m) { const size_t off = (size_t)(r0 + ai * HALF + m * 16) * DM + col0;
#pragma unroll
                for (int bj = 0; bj < 2; ++bj)
#pragma unroll
                    for (int n = 0; n < 2; ++n) *(GAS f32x4*)(op + off + bj * HALF + 4 * n) = gv[bj][n] * acc[ai][bj][m][n]; }
    }
};
}

DI void p0_transpose_item(const GAS float* W, int K, int N, GAS bf16_t* WT, LAS float* scr, int item, int lane) {
    const int nblk = N / 32, kb = item / nblk, nb = item % nblk, k0 = 64 * kb, n0 = 32 * nb;
#pragma unroll 8
    for (int i = 0; i < 32; ++i) { const int kk = 2 * i + (lane >> 5); scr[kk * 33 + (lane & 31)] = W[(size_t)(k0 + kk) * N + n0 + (lane & 31)]; }
    asm volatile("s_waitcnt lgkmcnt(0)" ::: "memory");
    const int c = lane & 7;
#pragma unroll
    for (int j = 0; j < 4; ++j) { const int n = (lane >> 3) + 8 * j; const LAS float* s = scr + (8 * c) * 33 + n;
        u32x4 o; o.x = pk2(s[0 * 33], s[1 * 33]); o.y = pk2(s[2 * 33], s[3 * 33]); o.z = pk2(s[4 * 33], s[5 * 33]); o.w = pk2(s[6 * 33], s[7 * 33]);
        *(GAS u32x4*)(WT + (size_t)(n0 + n) * K + k0 + 8 * c) = o; }
    asm volatile("s_waitcnt lgkmcnt(0)" ::: "memory");
}

DI void phase_prologue(const Args& a, LAS unsigned char* lds) {
    const int tid = otid(), lane = tid & 63, wave = tid >> 6;
    GAS float* MOD = (GAS float*)(AWS + WS_MOD);
    if (blockIdx.x < 192) {
        LAS float* sc = (LAS float*)lds;
        LAS float* red = (LAS float*)(lds + 36864);
        for (int i = tid; i < 9 * 1024; i += 512) { const int mi = i >> 10, k = i & 1023; const float v = mi < 8 ? AIN(1)[mi * 1024 + k] : AIN(3)[k]; sc[i] = v / (1.f + __expf(-v)); }
        __syncthreads();
        const int l = blockIdx.x / 96, cgp = blockIdx.x % 96, col = cgp * 64 + lane;
        const GAS float* W = AIN(4) + (size_t)l * 1024 * 6144;
        float acc[9];
#pragma unroll
        for (int mi = 0; mi < 9; ++mi) acc[mi] = 0.f;
#pragma unroll 8
        for (int k = wave * 128; k < wave * 128 + 128; ++k) { const float w = W[(size_t)k * 6144 + col];
#pragma unroll
            for (int mi = 0; mi < 9; ++mi) acc[mi] += sc[mi * 1024 + k] * w; }
#pragma unroll
        for (int mi = 0; mi < 9; ++mi) red[(wave * 9 + mi) * 64 + lane] = acc[mi];
        __syncthreads();
        for (int idx = tid; idx < 576; idx += 512) { const int mi = idx >> 6, ln = idx & 63; float s = 0.f;
            for (int w = 0; w < 8; ++w) s += red[(w * 9 + mi) * 64 + ln];
            MOD[(size_t)(l * 9 + mi) * 6144 + cgp * 64 + ln] = s + AIN(5)[l * 6144 + cgp * 64 + ln]; }
        __syncthreads();
    }
    if (blockIdx.x == gridDim.x - 1) {
        GAS float* rope = (GAS float*)(AWS + WS_ROPE);
        for (int i = tid; i < 1024; i += 512) { const int pos = i >> 4, f = i & 15; const float freq = powf(10000.0f, -(float)f / 16.0f); const float ang = (float)pos * freq;
            rope[2 * i] = cosf(ang); rope[2 * i + 1] = sinf(ang); }
    }
    LAS float* scr = (LAS float*)(lds + wave * 16384);
    const int gw = blockIdx.x * 8 + wave, NGW = gridDim.x * 8;
    constexpr int I_IN = 16 * 201, I_BR = 8 * 32, I_O = 16 * 32, I_1 = 16 * 128, I_2 = 64 * 32;
    constexpr int PER_L = I_IN + 3 * I_BR + I_O + I_1 + I_2;
    for (int it = gw; it < 2 * PER_L; it += NGW) {
        const int l = it / PER_L; int r = it % PER_L;
        GAS GAS unsigned char* wt = AWS + WS_WT + (size_t)l * WT_LAYER;
        if (r < I_IN) { p0_transpose_item(AIN(6) + (size_t)l * 1024 * LDP, 1024, LDP, (GAS bf16_t*)(wt + WT_IN), scr, r, lane); continue; } r -= I_IN;
        if (r < 3 * I_BR) { const int k = r / I_BR; p0_transpose_item(AIN(18) + (size_t)(l * 3 + k) * 512 * 1024, 512, 1024, (GAS bf16_t*)(wt + WT_BR) + (size_t)k * 1024 * 512, scr, r % I_BR, lane); continue; } r -= 3 * I_BR;
        if (r < I_O) { p0_transpose_item(AIN(19) + (size_t)l * 1024 * 1024, 1024, 1024, (GAS bf16_t*)(wt + WT_O), scr, r, lane); continue; } r -= I_O;
        if (r < I_1) { p0_transpose_item(AIN(20) + (size_t)l * 1024 * 4096, 1024, 4096, (GAS bf16_t*)(wt + WT_F1), scr, r, lane); continue; } r -= I_1;
        p0_transpose_item(AIN(21) + (size_t)l * 4096 * 1024, 4096, 1024, (GAS bf16_t*)(wt + WT_F2), scr, r, lane);
    }
    for (int l = 0; l < 2; ++l) { GAS u32x4* z = (GAS u32x4*)(AWS + WS_WT + (size_t)l * WT_LAYER + WT_IN + (size_t)LDP * 1024 * 2);
        const int n16 = (NPAD - LDP) * 1024 * 2 / 16;
        for (int i = blockIdx.x * 512 + tid; i < n16; i += gridDim.x * 512) z[i] = (u32x4){0u, 0u, 0u, 0u}; }
}

DI void phase_modulate(const Args& a, int l, int which, int u_lo) {
    const int tid_ = otid(); const int lane = tid_ & 63, wave = tid_ >> 6;
    const GAS float* MOD = (const GAS float*)(AWS + WS_MOD);
    GAS bf16_t* H = (GAS bf16_t*)(AWS + WS_H);
    const bool from_in = (l == 0 && which == 0);
    const GAS float* xc = from_in ? AIN(2) : (const GAS float*)(AWS + WS_CTXBUF);
    const GAS float* xl = from_in ? AIN(0) : AOUT;
    const int gw = blockIdx.x * 8 + wave, NGW = gridDim.x * 8;
    for (int u = u_lo + gw; u < NROW; u += NGW) {
        const GAS float* xr = u < NCTX ? xc + (size_t)u * DM : xl + (size_t)(u - NCTX) * DM;
        const int mi = u < NCTX ? 8 : ((u - NCTX) >> 12);
        const GAS float* shift = MOD + (size_t)(l * 9 + mi) * 6144 + (which ? 3 : 0) * 1024;
        const GAS float* scale = shift + 1024;
        f32x4 v[4]; float ss = 0.f;
        const bool addpart = (l == 1 && which == 0 && u < NCTX);
#pragma unroll
        for (int j = 0; j < 4; ++j) { v[j] = *(const GAS f32x4*)(xr + 4 * lane + 256 * j);
            if (addpart) { const GAS float* pp = (const GAS float*)(AWS + WS_PART) + (size_t)u * DM + 4 * lane + 256 * j;
#pragma unroll
                for (int z = 0; z < 4; ++z) v[j] += *(const GAS f32x4*)(pp + (size_t)z * NCTX * DM); }
            ss += (v[j].x * v[j].x + v[j].y * v[j].y) + (v[j].z * v[j].z + v[j].w * v[j].w); }
        const float rstd = rsqrtf(wave_sum(ss) * (1.f / DM) + EPSV);
#pragma unroll
        for (int j = 0; j < 4; ++j) { const f32x4 sh = *(const GAS f32x4*)(shift + 4 * lane + 256 * j), sc = *(const GAS f32x4*)(scale + 4 * lane + 256 * j);
            const f32x4 o = v[j] * rstd * (sc + 1.f) + sh; u32x2 w; w.x = pk2(o.x, o.y); w.y = pk2(o.z, o.w);
            *(GAS u32x2*)(H + (size_t)u * DM + 4 * lane + 256 * j) = w; }
    }
}

DI void stage_T(LAS bf16_t* dst, const GAS bf16_t* src, int ncols, int tid) {
    const int ntask = (ncols >> 3) * 32;
    for (int task = tid; task < ntask; task += 512) { const int tp = task & 31, cgp = task >> 5;
        const u32x4 v0 = *(const GAS u32x4*)(src + (size_t)(2 * tp) * LDP + 8 * cgp), v1 = *(const GAS u32x4*)(src + (size_t)(2 * tp + 1) * LDP + 8 * cgp);
        LAS unsigned* d = (LAS unsigned*)(dst + (8 * cgp) * 72 + 2 * tp);
#pragma unroll
        for (int i = 0; i < 4; ++i) { d[(2 * i) * 36] = (v0[i] & 0xffffu) | (v1[i] << 16); d[(2 * i + 1) * 36] = (v0[i] >> 16) | (v1[i] & 0xffff0000u); } }
}

struct GlaW { const GAS float *wf, *bf, *wb, *bb; };

#define GLA_SWEEP() \
    const int d = tid >> 8, p = (tid >> 7) & 1, c = tid & 127, C = hp * 128 + c; \
    float bl[32]; { const GAS float* wg = d ? gw.wb : gw.wf; float w2[16]; _Pragma("unroll") for (int r = 0; r < 16; ++r) w2[r] = wg[r * 256 + C]; \
      const float bias = (d ? gw.bb : gw.bf)[C]; float cum = 0.f; \
      _Pragma("unroll") for (int i = 0; i < 32; ++i) { const int s = 32 * p + i, t = d ? 63 - s : s; float lg = bias, lg1 = 0.f, lg2 = 0.f, lg3 = 0.f; \
          _Pragma("unroll") for (int r = 0; r < 16; r += 4) { lg += zs[t * 32 + d * 16 + r] * w2[r]; lg1 += zs[t * 32 + d * 16 + r + 1] * w2[r + 1]; lg2 += zs[t * 32 + d * 16 + r + 2] * w2[r + 2]; lg3 += zs[t * 32 + d * 16 + r + 3] * w2[r + 3]; } \
          lg = (lg + lg1) + (lg2 + lg3); \
          cum += log_sigmoid(lg) * (1.f / 16.f); bl[i] = cum; if ((i & 3) == 3) __builtin_amdgcn_sched_barrier(0); } \
      xt[(d * 2 + p) * 128 + c] = cum; if (p) xt[512 + d * 128 + c] = bl[0]; }

DI void gla_pass1_item(const GAS bf16_t* P, int hp, GAS bf16_t* kv, GAS float* dec, const GlaW& gw, LAS unsigned char* lds, bool dry) {
    GAS char* g_sink = (GAS char*)*(volatile LAS unsigned long long*)(lds + 143376);
    const int tid = otid(), lane = tid & 63, wave = tid >> 6, fr = lane & 15, fq = lane >> 4;
    LAS float* zs = (LAS float*)lds; LAS float* xt = (LAS float*)(lds + 8192);
    LAS bf16_t* KO = (LAS bf16_t*)(lds + 16384);
    LAS bf16_t* VT = (LAS bf16_t*)(lds + 53248);
    if (!(dry && (P1_DRY_MODE & 8))) {
    if (tid < 256) { const int r = tid >> 2, cc = tid & 3; const u32x4 v = *(const GAS u32x4*)(P + (size_t)r * LDP + C_ZF + cc * 8); float f[8]; unpack8(v, f);
#pragma unroll
        for (int j = 0; j < 8; ++j) zs[r * 32 + cc * 8 + j] = f[j]; }
    stage_T(VT, P + C_VC + hp * 256, 256, tid); }
    unsigned short kpre[32];
    { const int d_ = tid >> 8, p_ = (tid >> 7) & 1, C_ = hp * 128 + (tid & 127);
#pragma unroll
      for (int i = 0; i < 32; ++i) { const int s = 32 * p_ + i, t = d_ ? 63 - s : s; kpre[i] = (dry && (P1_DRY_MODE & 16)) ? (unsigned short)i : P[(size_t)t * LDP + C_KC + C_]; } }
    __syncthreads();
    GLA_SWEEP();
    __syncthreads();
    if (!(dry && (P1_DRY_MODE & 2)))
    { const float off = p ? xt[(d * 2) * 128 + c] : 0.f; const float btot = xt[(d * 2) * 128 + c] + xt[(d * 2 + 1) * 128 + c];
#pragma unroll
      for (int i = 0; i < 32; ++i) { const int s = 32 * p + i, t = d ? 63 - s : s; const float kvv = bf2f(kpre[i]);
          KO[(d * 128 + c) * 72 + t] = (bf16_t)f2bf(kvv * __expf(btot - (bl[i] + off))); if ((i & 7) == 7) __builtin_amdgcn_sched_barrier(0); }
      if (p == 0) *DST(dec + d * 256 + C) = __expf(btot); }
    __syncthreads();
    if (!(dry && (P1_DRY_MODE & 1)))
    { const int dd = wave >> 2, h2 = (wave >> 1) & 1, dvh = wave & 1;
#pragma unroll
      for (int dkt = 0; dkt < 4; ++dkt) {
          const LAS bf16_t* ap = KO + (dd * 128 + h2 * 64 + dkt * 16 + fr) * 72 + fq * 8;
          const bf16x8 a0 = *(const LAS bf16x8*)ap, a1 = *(const LAS bf16x8*)(ap + 32);
#pragma unroll
          for (int dvt = 0; dvt < 4; ++dvt) { const int dv = (dvh * 4 + dvt) * 16 + fr;
              const LAS bf16_t* bp = VT + (h2 * 128 + dv) * 72 + fq * 8;
              const bf16x8 b0 = *(const LAS bf16x8*)bp, b1 = *(const LAS bf16x8*)(bp + 32);
              f32x4 acc = (f32x4){0.f, 0.f, 0.f, 0.f}; acc = MFMA16(a0, b0, acc); acc = MFMA16(a1, b1, acc);
              u32x2 w; w.x = pk2(acc[0], acc[1]); w.y = pk2(acc[2], acc[3]);
              *DST((GAS u32x2*)(kv + (size_t)((dd * 4 + hp * 2 + h2) * 128 + dv) * 64 + dkt * 16 + fq * 4)) = w; } } }
    __syncthreads();
}

DI void gla_pass3_item(GAS bf16_t* P, int hp, const GAS bf16_t* sin, const GlaW& gw, const GAS float* gnorm, LAS unsigned char* lds, bool dry) {
    GAS char* g_sink = (GAS char*)*(volatile LAS unsigned long long*)(lds + 143376);
    const int tid = otid(), lane = tid & 63, wave = tid >> 6, fr = lane & 15, fq = lane >> 4;
    LAS float* zs = (LAS float*)lds; LAS float* xt = (LAS float*)(lds + 8192);
    LAS bf16_t* QS = (LAS bf16_t*)(lds + 16384);
    LAS bf16_t* KS = (LAS bf16_t*)(lds + 53248);
    LAS bf16_t* VT = (LAS bf16_t*)(lds + 90112);
    if (tid < 256) { const int r = tid >> 2, cc = tid & 3; const u32x4 v = *(const GAS u32x4*)(P + (size_t)r * LDP + C_ZF + cc * 8); float f[8]; unpack8(v, f);
#pragma unroll
        for (int j = 0; j < 8; ++j) zs[r * 32 + cc * 8 + j] = f[j]; }
    stage_T(VT, P + C_VC + hp * 256, 256, tid);
    unsigned short kpre[32], qpre[32];
    { const int d_ = tid >> 8, p_ = (tid >> 7) & 1, C_ = hp * 128 + (tid & 127);
#pragma unroll
      for (int i = 0; i < 32; ++i) { const int s = 32 * p_ + i, t = d_ ? 63 - s : s; kpre[i] = P[(size_t)t * LDP + C_KC + C_]; qpre[i] = P[(size_t)t * LDP + C_QC + C_]; } }
    __syncthreads();
    GLA_SWEEP();
    __syncthreads();
    { const float off = p ? xt[(d * 2) * 128 + c] : 0.f; const float bref = xt[(d * 2) * 128 + c] + xt[512 + d * 128 + c];
      const int h2 = c >> 6, dk = c & 63;
#pragma unroll
      for (int i = 0; i < 32; ++i) { const int s = 32 * p + i, t = d ? 63 - s : s; const float bt = bl[i] + off;
          const float qv = bf2f(qpre[i]), kvv = bf2f(kpre[i]);
          QS[((d * 2 + h2) * 64 + t) * 72 + dk] = (bf16_t)f2bf(qv * 0.125f * __expf(bt - bref));
          KS[((d * 2 + h2) * 64 + t) * 72 + dk] = (bf16_t)f2bf(kvv * __expf(bref - bt)); if ((i & 7) == 7) __builtin_amdgcn_sched_barrier(0); }
      if (p == 0) xt[768 + d * 128 + c] = __expf(bref); }
    __syncthreads();
    {
        const int dd = wave >> 2, h2 = (wave >> 1) & 1, lh = wave & 1;
        f32x4 sc[2][4];
#pragma unroll
        for (int li = 0; li < 2; ++li) { const LAS bf16_t* qp = QS + ((dd * 2 + h2) * 64 + (2 * lh + li) * 16 + fr) * 72 + fq * 8;
            const bf16x8 q0 = *(const LAS bf16x8*)qp, q1 = *(const LAS bf16x8*)(qp + 32);
#pragma unroll
            for (int mt = 0; mt < 4; ++mt) { const LAS bf16_t* kp = KS + ((dd * 2 + h2) * 64 + mt * 16 + fr) * 72 + fq * 8;
                const bf16x8 k0 = *(const LAS bf16x8*)kp, k1 = *(const LAS bf16x8*)(kp + 32);
                f32x4 s = (f32x4){0.f, 0.f, 0.f, 0.f}; s = MFMA16(k0, q0, s); s = MFMA16(k1, q1, s); sc[li][mt] = s; } }
        __syncthreads();
#pragma unroll
        for (int li = 0; li < 2; ++li) { const int lrow = (2 * lh + li) * 16 + fr;
#pragma unroll
            for (int mt = 0; mt < 4; ++mt) { float v[4];
#pragma unroll
                for (int j = 0; j < 4; ++j) { const int mcol = mt * 16 + fq * 4 + j; const bool keep = dd ? (mcol >= lrow) : (mcol <= lrow); v[j] = keep ? sc[li][mt][j] : 0.f; }
                u32x2 w; w.x = pk2(v[0], v[1]); w.y = pk2(v[2], v[3]);
                *(LAS u32x2*)(KS + ((dd * 2 + h2) * 64 + lrow) * 72 + mt * 16 + fq * 4) = w; } }
    }
    __syncthreads();
    {
        const int h2 = wave >> 2, lt = wave & 3; const int h = hp * 2 + h2;
        f32x4 acc[8];
#pragma unroll
        for (int i = 0; i < 8; ++i) acc[i] = (f32x4){0.f, 0.f, 0.f, 0.f};
#pragma unroll 1
        for (int dd = 0; dd < 2; ++dd) {
            const LAS bf16_t* pp = KS + ((dd * 2 + h2) * 64 + lt * 16 + fr) * 72 + fq * 8;
            const LAS bf16_t* qp = QS + ((dd * 2 + h2) * 64 + lt * 16 + fr) * 72 + fq * 8;
            const bf16x8 p0 = *(const LAS bf16x8*)pp, p1 = *(const LAS bf16x8*)(pp + 32), q0 = *(const LAS bf16x8*)qp, q1 = *(const LAS bf16x8*)(qp + 32);
            float e0[8], e1[8];
#pragma unroll
            for (int j = 0; j < 8; ++j) { e0[j] = xt[768 + dd * 128 + h2 * 64 + fq * 8 + j]; e1[j] = xt[768 + dd * 128 + h2 * 64 + 32 + fq * 8 + j]; }
            u32x4 spre[8][2];
#pragma unroll
            for (int dvt = 0; dvt < 8; ++dvt) { const GAS bf16_t* sp = sin + (size_t)((dd * 4 + h) * 128 + dvt * 16 + fr) * 64 + fq * 8; spre[dvt][0] = *(const GAS u32x4*)sp; spre[dvt][1] = *(const GAS u32x4*)(sp + 32); }
#pragma unroll
            for (int dvt = 0; dvt < 8; ++dvt) {
                const LAS bf16_t* vp = VT + (h2 * 128 + dvt * 16 + fr) * 72 + fq * 8;
                const bf16x8 v0 = *(const LAS bf16x8*)vp, v1 = *(const LAS bf16x8*)(vp + 32);
                acc[dvt] = MFMA16(v0, p0, acc[dvt]); acc[dvt] = MFMA16(v1, p1, acc[dvt]);
                const u32x4 s0 = spre[dvt][0], s1 = spre[dvt][1];
                float f0[8], f1[8]; unpack8(s0, f0); unpack8(s1, f1);
#pragma unroll
                for (int j = 0; j < 8; ++j) { f0[j] *= e0[j]; f1[j] *= e1[j]; }
                const u32x4 t0 = pack8(f0), t1 = pack8(f1);
                acc[dvt] = MFMA16(__builtin_bit_cast(bf16x8, t0), q0, acc[dvt]); acc[dvt] = MFMA16(__builtin_bit_cast(bf16x8, t1), q1, acc[dvt]);
                __builtin_amdgcn_sched_barrier(0);
            }
        }
        float ss = 0.f;
#pragma unroll
        for (int i = 0; i < 8; ++i) ss += (acc[i][0] * acc[i][0] + acc[i][1] * acc[i][1]) + (acc[i][2] * acc[i][2] + acc[i][3] * acc[i][3]);
        ss += __shfl_xor(ss, 16); ss += __shfl_xor(ss, 32);
        const float rstd = rsqrtf(ss * (1.f / 128.f) + EPSV);
        GAS bf16_t* rp = P + (size_t)(lt * 16 + fr) * LDP + C_RC + h * 128;
#pragma unroll
        for (int dvt = 0; dvt < 8; ++dvt) { const int dv = dvt * 16 + fq * 4; const u32x2 rw = *(const GAS u32x2*)(rp + dv); const f32x4 gn = *(const GAS f32x4*)(gnorm + dv);
            float rv[4] = {__uint_as_float(rw.x << 16), __uint_as_float(rw.x & 0xffff0000u), __uint_as_float(rw.y << 16), __uint_as_float(rw.y & 0xffff0000u)}; float o[4];
#pragma unroll
            for (int j = 0; j < 4; ++j) o[j] = acc[dvt][j] * rstd * gn[j] * (rv[j] * frcp(1.f + __expf(-rv[j])));
            u32x2 w; w.x = pk2(o[0], o[1]); w.y = pk2(o[2], o[3]); *DST((GAS u32x2*)(rp + dv)) = w; }
    }
    __syncthreads();
}

DI void gla_scan_item(const Args& a, int hf, int b, int d, int slice, bool dry) {
    GAS char* g_sink = (GAS char*)(AWS + WS_PART);
    const int tid = otid(); const int e = slice * 2048 + tid * 4; const int h = e >> 13, dk = e & 63;
    GAS bf16_t* KV = (GAS bf16_t*)(AWS + WS_KV); const GAS float* DEC = (const GAS float*)(AWS + WS_DEC); GAS float* CST = (GAS float*)(AWS + WS_CTXST) + (size_t)(b * 2 + d) * 32768 + e;
    f32x4 st;
    if (hf == 0) {
        { float z0 = 0.f; asm volatile("" : "+v"(z0)); st = (f32x4){z0, z0, z0, z0}; }
#pragma unroll
        for (int s = 0; s < 4; ++s) { const int cid = b * 4 + (d ? 3 - s : s);
            GAS bf16_t* kp = KV + (size_t)cid * 65536 + d * 32768 + e; const u32x2 kw = *(const GAS u32x2*)kp; const f32x4 dc = *(const GAS f32x4*)(DEC + cid * 512 + d * 256 + h * 64 + dk);
            u32x2 w; w.x = pk2(st.x, st.y); w.y = pk2(st.z, st.w); *DST((GAS u32x2*)kp) = w;
            const f32x4 kvv = (f32x4){__uint_as_float(kw.x << 16), __uint_as_float(kw.x & 0xffff0000u), __uint_as_float(kw.y << 16), __uint_as_float(kw.y & 0xffff0000u)};
            st = st * dc + kvv; }
        *DST((GAS f32x4*)CST) = st;
        if (b >= 4) return;
    } else { st = *(const GAS f32x4*)CST; }
    const int cbase = 32 + (b & 3) * 64;
    u32x2 kwn[4]; f32x4 dcn[4];
#pragma unroll
    for (int k = 0; k < 4; ++k) { const int cid = cbase + (d ? 63 - k : k);
        kwn[k] = *(const GAS u32x2*)(KV + (size_t)cid * 65536 + d * 32768 + e); dcn[k] = *(const GAS f32x4*)(DEC + cid * 512 + d * 256 + h * 64 + dk); }
    for (int s0 = 0; s0 < 64; s0 += 4) {
        u32x2 kw[4]; f32x4 dc[4]; GAS bf16_t* kp[4];
#pragma unroll
        for (int k = 0; k < 4; ++k) { const int s = s0 + k; const int cid = cbase + (d ? 63 - s : s); kp[k] = KV + (size_t)cid * 65536 + d * 32768 + e; kw[k] = kwn[k]; dc[k] = dcn[k]; }
        if (s0 + 4 < 64) {
#pragma unroll
            for (int k = 0; k < 4; ++k) { const int s = s0 + 4 + k; const int cid = cbase + (d ? 63 - s : s);
                kwn[k] = *(const GAS u32x2*)(KV + (size_t)cid * 65536 + d * 32768 + e); dcn[k] = *(const GAS f32x4*)(DEC + cid * 512 + d * 256 + h * 64 + dk); } }
#pragma unroll
        for (int k = 0; k < 4; ++k) { u32x2 w; w.x = pk2(st.x, st.y); w.y = pk2(st.z, st.w); *DST((GAS u32x2*)kp[k]) = w;
            const f32x4 kvv = (f32x4){__uint_as_float(kw[k].x << 16), __uint_as_float(kw[k].x & 0xffff0000u), __uint_as_float(kw[k].y << 16), __uint_as_float(kw[k].y & 0xffff0000u)};
            st = st * dc[k] + kvv; }
    }
}

DI void sgu_item(GAS bf16_t* P, int g, const GAS float* ws_l  , const GAS float* bs_l  , const GAS float* gn_l  , LAS unsigned char* lds, bool dry) {
    GAS char* g_sink = (GAS char*)*(volatile LAS unsigned long long*)(lds + 143376);
    const int tid = otid(), lane = tid & 63, wave = tid >> 6, fr = lane & 15, fq = lane >> 4;
    LAS bf16_t* VT = (LAS bf16_t*)lds;
    const float g0 = gn_l[g * 128 + lane], g1 = gn_l[g * 128 + 64 + lane];
    { unsigned short r0[16], r1[16];
#pragma unroll
      for (int i = 0; i < 16; ++i) { const GAS bf16_t* vp = P + (size_t)(wave + 8 * i) * LDP + C_VA + g * 128; r0[i] = vp[lane]; r1[i] = vp[64 + lane]; }
#pragma unroll
      for (int i = 0; i < 16; ++i) { const int q = wave + 8 * i;
        const float x0 = gelu_tanh(bf2f(r0[i])), x1 = gelu_tanh(bf2f(r1[i]));
        const float rstd = rsqrtf(wave_sum(x0 * x0 + x1 * x1) * (1.f / 128.f) + EPSV);
        VT[lane * 136 + q] = (bf16_t)f2bf(x0 * rstd * g0); VT[(64 + lane) * 136 + q] = (bf16_t)f2bf(x1 * rstd * g1); } }
    bf16x8 wf[4];
    { const GAS float* wp = ws_l + (size_t)(g * 128 + wave * 16 + fr) * 128 + fq * 8;
#pragma unroll
      for (int ks = 0; ks < 4; ++ks) { const f32x4 w0 = *(const GAS f32x4*)(wp + ks * 32), w1 = *(const GAS f32x4*)(wp + ks * 32 + 4);
          u32x4 t; t.x = pk2(w0.x, w0.y); t.y = pk2(w0.z, w0.w); t.z = pk2(w1.x, w1.y); t.w = pk2(w1.z, w1.w); wf[ks] = __builtin_bit_cast(bf16x8, t); } }
    __syncthreads();
    const int prow = wave * 16 + fr; const float bias = bs_l[g * 128 + prow];
    GAS bf16_t* up = P + (size_t)prow * LDP + C_U + g * 128;
#pragma unroll
    for (int dt = 0; dt < 8; ++dt) { f32x4 acc = (f32x4){0.f, 0.f, 0.f, 0.f};
#pragma unroll
        for (int ks = 0; ks < 4; ++ks) { const bf16x8 av = *(const LAS bf16x8*)(VT + (dt * 16 + fr) * 136 + ks * 32 + fq * 8); acc = MFMA16(av, wf[ks], acc); }
        const int dcol = dt * 16 + fq * 4; const u32x2 uw = *(const GAS u32x2*)(up + dcol);
        const float uv[4] = {__uint_as_float(uw.x << 16), __uint_as_float(uw.x & 0xffff0000u), __uint_as_float(uw.y << 16), __uint_as_float(uw.y & 0xffff0000u)}; float o[4];
#pragma unroll
        for (int j = 0; j < 4; ++j) o[j] = gelu_tanh(uv[j]) * (acc[j] + bias);
        u32x2 w; w.x = pk2(o[0], o[1]); w.y = pk2(o[2], o[3]); *DST((GAS u32x2*)(up + dcol)) = w; }
    __syncthreads();
}

DI void qkprep_item(GAS bf16_t* P, int t0, bool doq, const GAS float* qn, const GAS float* kn, const GAS float* rope, bool dry, LAS unsigned char* lds) {
    GAS char* g_sink = (GAS char*)*(volatile LAS unsigned long long*)(lds + 143376);
    const int tid = otid(), lane = tid & 63, wave = tid >> 6, sub = lane & 7;
    LAS float* rtab = (LAS float*)lds;
    LAS float* gtab = (LAS float*)(lds + 8192);
    *(LAS f32x4*)(rtab + 4 * tid) = *(const GAS f32x4*)(rope + 4 * tid);
    if (tid < 128) gtab[tid] = tid < 64 ? qn[tid] : kn[tid - 64];
    __syncthreads();
    u32x4 xpre[10];
#pragma unroll
    for (int ii = 0; ii < 10; ++ii) { const int pr = (wave + 8 * ii) * 8 + (lane >> 3); const int r = pr / 10, hh = pr - r * 10; const bool isq = hh < 8;
        xpre[ii] = *(const GAS u32x4*)(P + (size_t)r * LDP + (isq ? C_QB + hh * 64 : C_KB + (hh - 8) * 64) + sub * 8); }
#pragma unroll
    for (int ii = 0; ii < 10; ++ii) { const int it = wave + 8 * ii; const int pr = it * 8 + (lane >> 3); const int r = pr / 10, hh = pr - r * 10; const bool isq = hh < 8;
        if (isq && !doq) continue;
        GAS bf16_t* xp = P + (size_t)r * LDP + (isq ? C_QB + hh * 64 : C_KB + (hh - 8) * 64) + sub * 8;
        const u32x4 xw = xpre[ii]; float x[8]; unpack8(xw, x);
        float ss = 0.f;
#pragma unroll
        for (int j = 0; j < 8; ++j) ss += x[j] * x[j];
        ss += __shfl_xor(ss, 1); ss += __shfl_xor(ss, 2); ss += __shfl_xor(ss, 4);
        const float rstd = rsqrtf(ss * (1.f / 64.f) + EPSV);
        const LAS float* gp = gtab + (isq ? 0 : 64) + sub * 8;
#pragma unroll
        for (int j = 0; j < 8; ++j) x[j] = x[j] * rstd * gp[j];
        if (t0 >= 0) { const int t = t0 + r; const int pos = (sub < 4) ? (t >> 6) : (t & 63); const LAS float* tb = rtab + (pos * 16 + 8 * (sub & 1)) * 2;
#pragma unroll
            for (int j = 0; j < 8; ++j) { const float o = __shfl_xor(x[j], 2); const float cs = tb[2 * j], sn = tb[2 * j + 1]; x[j] = (sub & 2) ? (o * sn + x[j] * cs) : (x[j] * cs - o * sn); } }
        if (isq) {
#pragma unroll
            for (int j = 0; j < 8; ++j) x[j] *= 0.125f * LOG2E; }
        *DST((GAS u32x4*)xp) = pack8(x);
    }
    __syncthreads();
}

DI void attn_item(GAS bf16_t* Q, const GAS bf16_t* Klat, const GAS bf16_t* Vlat, int qb, const GAS bf16_t* Kctx, const GAS bf16_t* Vctx, const GAS float* sink4, LAS unsigned char* lds, bool dry, const GAS float* qn, const GAS float* kn, const GAS float* rope, int t0) {
    GAS char* g_sink = (GAS char*)*(volatile LAS unsigned long long*)(lds + 143376);
    const int tid = otid(), lane = tid & 63, wave = tid >> 6, fr = lane & 15, fq = lane >> 4;
    const int g = wave & 3, half = wave >> 2;
    LAS bf16_t* Ks0 = (LAS bf16_t*)lds;
    LAS bf16_t* Vt0 = (LAS bf16_t*)(lds + 9216);
    LAS float* rtab = (LAS float*)(lds + 36864);
    LAS float* gtab = (LAS float*)(lds + 45056);
    *(LAS f32x4*)(rtab + 4 * tid) = *(const GAS f32x4*)(rope + 4 * tid);
    if (tid < 128) gtab[tid] = tid < 64 ? qn[tid] : kn[tid - 64];
    u32x4 qraw[4][2];
#pragma unroll
    for (int rt = 0; rt < 4; ++rt) { const GAS bf16_t* qp = Q + (size_t)(half * 64 + rt * 16 + fr) * LDP + g * 64 + fq * 8;
        qraw[rt][0] = *(const GAS u32x4*)qp; qraw[rt][1] = *(const GAS u32x4*)(qp + 32); }
    __syncthreads();
    bf16x8 qf[4][2];
#pragma unroll
    for (int rt = 0; rt < 4; ++rt) {
        float xa[8], xb[8]; unpack8(qraw[rt][0], xa); unpack8(qraw[rt][1], xb);
        float ss = 0.f;
#pragma unroll
        for (int j = 0; j < 8; ++j) ss += xa[j] * xa[j] + xb[j] * xb[j];
        ss += __shfl_xor(ss, 16); ss += __shfl_xor(ss, 32);
        const float rstd = rsqrtf(ss * (1.f / 64.f) + EPSV);
#pragma unroll
        for (int j = 0; j < 8; ++j) { xa[j] *= rstd * gtab[fq * 8 + j]; xb[j] *= rstd * gtab[32 + fq * 8 + j]; }
        if (t0 >= 0) { const int t = t0 + half * 64 + rt * 16 + fr; const LAS float* ta = rtab + ((t >> 6) * 16 + 8 * (fq & 1)) * 2; const LAS float* tb = rtab + ((t & 63) * 16 + 8 * (fq & 1)) * 2;
#pragma unroll
            for (int j = 0; j < 8; ++j) { const float oa = __shfl_xor(xa[j], 32), ob = __shfl_xor(xb[j], 32);
                xa[j] = (fq & 2) ? (oa * ta[2 * j + 1] + xa[j] * ta[2 * j]) : (xa[j] * ta[2 * j] - oa * ta[2 * j + 1]);
                xb[j] = (fq & 2) ? (ob * tb[2 * j + 1] + xb[j] * tb[2 * j]) : (xb[j] * tb[2 * j] - ob * tb[2 * j + 1]); } }
#pragma unroll
        for (int j = 0; j < 8; ++j) { xa[j] *= 0.125f * LOG2E; xb[j] *= 0.125f * LOG2E; }
        const u32x4 pa = pack8(xa), pb_ = pack8(xb);
        qf[rt][0] = __builtin_bit_cast(bf16x8, pa); qf[rt][1] = __builtin_bit_cast(bf16x8, pb_); }
    const float snk = sink4[g] * LOG2E;
    float mrow[4], lrow[4]; f32x4 O[4][4];
#pragma unroll
    for (int rt = 0; rt < 4; ++rt) { mrow[rt] = snk; lrow[rt] = (fq == 0) ? 1.f : 0.f;
#pragma unroll
        for (int dt = 0; dt < 4; ++dt) O[dt][rt] = (f32x4){0.f, 0.f, 0.f, 0.f}; }
    const int ntl = Klat ? 6 : 0, ntile = ntl + 4;
    const int kr = tid >> 3, kc = tid & 7;
    const int vtp = tid & 31, vcg = (tid >> 5) & 7;
    u32x4 kreg, v0reg, v1reg; int jn = 0;
    auto tile_valid = [&](int j) -> bool { if (j >= ntl) return true; const int kp0 = qb * 128 - 128 + 64 * j; return kp0 >= 0 && kp0 < SEQ; };
    auto tile_k = [&](int j) -> const GAS bf16_t* { return j < ntl ? Klat + (size_t)(qb * 128 - 128 + 64 * j) * LDP : Kctx + (size_t)((j - ntl) * 64) * LDP; };
    auto tile_v = [&](int j) -> const GAS bf16_t* { return j < ntl ? Vlat + (size_t)(qb * 128 - 128 + 64 * j) * LDP : Vctx + (size_t)((j - ntl) * 64) * LDP; };
    while (jn < ntile && !tile_valid(jn)) ++jn;
    { const GAS bf16_t* kp = tile_k(jn); const GAS bf16_t* vp = tile_v(jn);
      kreg = *(const GAS u32x4*)(kp + (size_t)kr * LDP + kc * 8);
      if (tid < 256) { v0reg = *(const GAS u32x4*)(vp + (size_t)(2 * vtp) * LDP + vcg * 8); v1reg = *(const GAS u32x4*)(vp + (size_t)(2 * vtp + 1) * LDP + vcg * 8); } }
    int pp = 0;
    while (jn < ntile) {
        const int j = jn;
        LAS bf16_t* Ks = Ks0 + pp * 9216; LAS bf16_t* Vt = Vt0 + pp * 9216; pp ^= 1;
        {
            float x[8]; unpack8(kreg, x); float ss = 0.f;
#pragma unroll
            for (int e = 0; e < 8; ++e) ss += x[e] * x[e];
            ss += __shfl_xor(ss, 1); ss += __shfl_xor(ss, 2); ss += __shfl_xor(ss, 4);
            const float rstd = rsqrtf(ss * (1.f / 64.f) + EPSV);
#pragma unroll
            for (int e = 0; e < 8; ++e) x[e] *= rstd * gtab[64 + kc * 8 + e];
            if (j < ntl) { const int kpos = qb * 128 - 128 + 64 * j + kr; const int pos = (kc < 4) ? (kpos >> 6) : (kpos & 63); const LAS float* tb = rtab + (pos * 16 + 8 * (kc & 1)) * 2;
#pragma unroll
                for (int e = 0; e < 8; ++e) { const float o = __shfl_xor(x[e], 2); x[e] = (kc & 2) ? (o * tb[2 * e + 1] + x[e] * tb[2 * e]) : (x[e] * tb[2 * e] - o * tb[2 * e + 1]); } }
            *(LAS u32x4*)(Ks + kr * 72 + kc * 8) = pack8(x); }
        if (tid < 256) { LAS unsigned* dp = (LAS unsigned*)(Vt + (8 * vcg) * 72 + 2 * vtp);
#pragma unroll
            for (int i = 0; i < 4; ++i) { dp[(2 * i) * 36] = (v0reg[i] & 0xffffu) | (v1reg[i] << 16); dp[(2 * i + 1) * 36] = (v0reg[i] >> 16) | (v1reg[i] & 0xffff0000u); } }
        __syncthreads();
        ++jn; while (jn < ntile && !tile_valid(jn)) ++jn;
        if (jn < ntile && !(dry && (ATT_DRY_MODE & 2))) { const GAS bf16_t* kp = tile_k(jn); const GAS bf16_t* vp = tile_v(jn);
            kreg = *(const GAS u32x4*)(kp + (size_t)kr * LDP + kc * 8);
            if (tid < 256) { v0reg = *(const GAS u32x4*)(vp + (size_t)(2 * vtp) * LDP + vcg * 8); v1reg = *(const GAS u32x4*)(vp + (size_t)(2 * vtp + 1) * LDP + vcg * 8); } }
        const bool local = j < ntl;
        if (local && ((half == 0 && j == 5) || (half == 1 && j == 0))) continue;
        f32x4 S[4][4];
#pragma unroll
        for (int kt = 0; kt < 4; ++kt) { const LAS bf16_t* kp = Ks + (kt * 16 + fr) * 72 + fq * 8; const bf16x8 k0 = *(const LAS bf16x8*)kp, k1 = *(const LAS bf16x8*)(kp + 32);
#pragma unroll
            for (int rt = 0; rt < 4; ++rt) { f32x4 sv = (f32x4){0.f, 0.f, 0.f, 0.f}; sv = MFMA16(k0, qf[rt][0], sv); sv = MFMA16(k1, qf[rt][1], sv); S[rt][kt] = sv; } }
        if (dry && (ATT_DRY_MODE & 1)) { O[0][0] += S[0][0] + S[1][1] + S[2][2] + S[3][3]; continue; }
        if (local && (64 * j - 64 * half == 0 || 64 * j - 64 * half == 256)) { const int kk0 = -128 + 64 * j;
#pragma unroll
            for (int rt = 0; rt < 4; ++rt) { const int qq = half * 64 + rt * 16 + fr;
#pragma unroll
                for (int kt = 0; kt < 4; ++kt)
#pragma unroll
                    for (int e = 0; e < 4; ++e) { const int df = kk0 + kt * 16 + fq * 4 + e - qq; if (df < -128 || df > 128) S[rt][kt][e] = -INFINITY; } } }
        bf16x8 pb[4][2];
#pragma unroll
        for (int rt = 0; rt < 4; ++rt) { float mx = -INFINITY;
#pragma unroll
            for (int kt = 0; kt < 4; ++kt) mx = fmaxf(mx, fmaxf(fmaxf(S[rt][kt][0], S[rt][kt][1]), fmaxf(S[rt][kt][2], S[rt][kt][3])));
            mx = fmaxf(mx, __shfl_xor(mx, 16)); mx = fmaxf(mx, __shfl_xor(mx, 32));
            const float mnew = fmaxf(mrow[rt], mx), alpha = __builtin_amdgcn_exp2f(mrow[rt] - mnew); mrow[rt] = mnew;
            float ps = 0.f;
#pragma unroll
            for (int kt = 0; kt < 4; ++kt)
#pragma unroll
                for (int e = 0; e < 4; ++e) { const float pv = __builtin_amdgcn_exp2f(S[rt][kt][e] - mnew); S[rt][kt][e] = pv; ps += pv; }
            lrow[rt] = lrow[rt] * alpha + ps;
#pragma unroll
            for (int dt = 0; dt < 4; ++dt) O[dt][rt] = O[dt][rt] * alpha;
#pragma unroll
            for (int sidx = 0; sidx < 2; ++sidx) { u32x4 t; t.x = pk2(S[rt][2 * sidx][0], S[rt][2 * sidx][1]); t.y = pk2(S[rt][2 * sidx][2], S[rt][2 * sidx][3]); t.z = pk2(S[rt][2 * sidx + 1][0], S[rt][2 * sidx + 1][1]); t.w = pk2(S[rt][2 * sidx + 1][2], S[rt][2 * sidx + 1][3]);
                pb[rt][sidx] = __builtin_bit_cast(bf16x8, t); } }
#pragma unroll
        for (int dt = 0; dt < 4; ++dt)
#pragma unroll
            for (int sidx = 0; sidx < 2; ++sidx) { const LAS bf16_t* vp = Vt + (dt * 16 + fr) * 72 + 32 * sidx + 4 * fq;
                const u32x2 lo = *(const LAS u32x2*)vp, hi = *(const LAS u32x2*)(vp + 16);
                const u32x4 t = (u32x4){lo.x, lo.y, hi.x, hi.y}; const bf16x8 av = __builtin_bit_cast(bf16x8, t);
#pragma unroll
                for (int rt = 0; rt < 4; ++rt) O[dt][rt] = MFMA16(av, pb[rt][sidx], O[dt][rt]); }
    }
#pragma unroll
    for (int rt = 0; rt < 4; ++rt) { float l = lrow[rt]; l += __shfl_xor(l, 16); l += __shfl_xor(l, 32); const float inv = 1.f / l;
        GAS bf16_t* op = Q + (size_t)(half * 64 + rt * 16 + fr) * LDP + g * 64;
#pragma unroll
        for (int dt = 0; dt < 4; ++dt) { const f32x4 o = O[dt][rt] * inv; u32x2 w; w.x = pk2(o[0], o[1]); w.y = pk2(o[2], o[3]); *DST((GAS u32x2*)(op + dt * 16 + fq * 4)) = w; } }
    __syncthreads();
}

DI void phase_x1(const Args& a, int l, int hf, LAS unsigned char* lds, bool dry) {
    GAS bf16_t* PJ = (GAS bf16_t*)(AWS + WS_BIG);
    const int c0 = hf ? 32 : 0;
    const int nch = hf ? 256 : 288;
    const bool ctx_mix = (hf == 0 && l == 0);
    const int s0 = (hf == 0 && !ctx_mix) ? 16 : (hf ? 16 : 0);
    const int nsg = 144 - s0;
    const int n_sgu = nsg * 4, n_g1 = nch * 2, n_pp = 0;
    const GlaW gw{AIN(13) + l * 16 * 256, AIN(14) + l * 256, AIN(15) + l * 16 * 256, AIN(16) + l * 256};
    for (int it = blockIdx.x; it < n_sgu + n_g1 + n_pp; it += gridDim.x) {
        if (it < n_sgu) { const int ck = s0 + (it >> 2), g = it & 3;
            if (!dry || (DRYSEL & 1)) sgu_item(PJ + (size_t)ck * 128 * LDP, g, AIN(11) + (size_t)l * 4 * 128 * 128, AIN(12) + l * 512, AIN(10) + l * 512, lds, dry);
        } else if (it < n_sgu + n_g1) { const int r = it - n_sgu; const int cid = c0 + (r >> 1), hp = r & 1;
            if (!dry || (DRYSEL & 2)) gla_pass1_item(PJ + (size_t)cid * 64 * LDP, hp, (GAS bf16_t*)(AWS + WS_KV) + (size_t)cid * 65536, (GAS float*)(AWS + WS_DEC) + cid * 512, gw, lds, dry);
        } else { const int cid = c0 + (it - n_sgu - n_g1); const bool isctx = cid < 32;
            const int t0 = isctx ? -1 : (((cid - 32) * 64) & 4095);
            if (!dry || (DRYSEL & 4)) qkprep_item(PJ + (size_t)cid * 64 * LDP, t0, !isctx || l == 0, AIN(7) + l * 64, AIN(8) + l * 64, (const GAS float*)(AWS + WS_ROPE), dry, lds);
        }
    }
}

DI void phase_x2(const Args& a, int l, int hf, LAS unsigned char* lds, bool dry) {
    GAS bf16_t* PJ = (GAS bf16_t*)(AWS + WS_BIG);
    const int n_att_lat = 256, n_att_ctx = 0;
    const int n_scan = hf ? 128 : 256;
    const int n_att = n_att_lat + n_att_ctx;
    for (int it = blockIdx.x; it < n_att + n_scan; it += gridDim.x) {
        if (it < n_att_lat) { const int kh = it & 1, qb = (it >> 1) & 31, bl = it >> 6;
            const int b = hf * 4 + bl;
            GAS bf16_t* lat0 = PJ + (size_t)(NCTX + bl * SEQ) * LDP;
            const GAS bf16_t* cx0 = PJ + (size_t)(b * CTXL) * LDP;
            if (!dry || (DRYSEL & 1)) attn_item(lat0 + (size_t)(qb * 128) * LDP + C_QB + kh * 256, lat0 + C_KB + kh * 64, lat0 + C_VB + kh * 64, qb, cx0 + C_KB + kh * 64, cx0 + C_VB + kh * 64, AIN(9) + l * 8 + kh * 4, lds, dry, AIN(7) + l * 64, AIN(8) + l * 64, (const GAS float*)(AWS + WS_ROPE), qb * 128);
        } else if (it < n_att) { const int r = it - n_att_lat; const int kh = r & 1, qb = (r >> 1) & 1, b = r >> 2;
            GAS bf16_t* cx0 = PJ + (size_t)(b * CTXL) * LDP;
            if (!dry || (DRYSEL & 1)) attn_item(cx0 + (size_t)(qb * 128) * LDP + C_QB + kh * 256, nullptr, nullptr, qb, cx0 + C_KB + kh * 64, cx0 + C_VB + kh * 64, AIN(9) + l * 8 + kh * 4, lds, dry, AIN(7) + l * 64, AIN(8) + l * 64, (const GAS float*)(AWS + WS_ROPE), -1);
        } else { const int r = it - n_att; const int slice = r & 15, d = (r >> 4) & 1, bb = r >> 5;
            if (!dry || (DRYSEL & 2)) gla_scan_item(a, hf, hf ? 4 + bb : bb, d, slice, dry);
        }
    }
}

DI void phase_x3(const Args& a, int l, int hf, LAS unsigned char* lds, bool dry) {
    GAS bf16_t* PJ = (GAS bf16_t*)(AWS + WS_BIG);
    const int c0 = (hf == 0 && l == 0) ? 0 : 32;
    const int nch = 288 - c0;
    const GlaW gw{AIN(13) + l * 16 * 256, AIN(14) + l * 256, AIN(15) + l * 16 * 256, AIN(16) + l * 256};
    for (int it = blockIdx.x; it < nch * 2; it += gridDim.x) { const int cid = c0 + (it >> 1), hp = it & 1;
        gla_pass3_item(PJ + (size_t)cid * 64 * LDP, hp, (const GAS bf16_t*)(AWS + WS_KV) + (size_t)cid * 65536, gw, AIN(17) + l * 128, lds, dry); }
    if (hf == 0 && l == 0 && (int)blockIdx.x >= (int)gridDim.x - 32) {
        const int r = (int)blockIdx.x - ((int)gridDim.x - 32); const int kh = r & 1, qb = (r >> 1) & 1, b = r >> 2;
        GAS bf16_t* cx0 = PJ + (size_t)(b * CTXL) * LDP;
        attn_item(cx0 + (size_t)(qb * 128) * LDP + C_QB + kh * 256, nullptr, nullptr, qb, cx0 + C_KB + kh * 64, cx0 + C_VB + kh * 64, AIN(9) + l * 8 + kh * 4, lds, dry, AIN(7) + l * 64, AIN(8) + l * 64, (const GAS float*)(AWS + WS_ROPE), -1); }
}


#define XB_TMO      128
#define XB_XCNT(j)  (256  + 64 * (j))
#define XB_XSUB(j)  (1280 + 64 * (j))
#define XB_XGEN(j)  (2304 + 64 * (j))
#define XB_TOP      3328
#define XB_TOPGEN   3392
#define XCD_BAR_WORDS 3456
#define XB_SPIN_CAP (1u << 18)
DI unsigned xb_ld(unsigned* p)              { return __hip_atomic_load(p, __ATOMIC_RELAXED, __HIP_MEMORY_SCOPE_AGENT); }
DI unsigned xb_add(unsigned* p, unsigned v) { return __hip_atomic_fetch_add(p, v, __ATOMIC_RELAXED, __HIP_MEMORY_SCOPE_AGENT); }
DI unsigned xb_xcc_id() { return (unsigned)__builtin_amdgcn_s_getreg((3 << 11) | 20) & 0xFu; }
#define XB_SPIN(cond, bar) do { unsigned _sp = 0; while (cond) { __builtin_amdgcn_s_sleep(1); \
    if ((++_sp & 255u) == 0u) { if (xb_ld(&(bar)[XB_TMO])) break; if (_sp > XB_SPIN_CAP) { atomicAdd(&(bar)[XB_TMO], 1u); break; } } } } while (0)
struct XcdBarrier { unsigned* bar; unsigned x; volatile LAS unsigned* st; };
DI XcdBarrier xcd_barrier_post(unsigned* bar, volatile LAS unsigned* st) {
    XcdBarrier b; b.bar = bar; b.x = xb_xcc_id(); b.st = st;
    if (threadIdx.x == 0) (void)xb_add(&bar[XB_XCNT(b.x)], 1u);
    return b;
}
DI void xcd_barrier_complete(unsigned* bar, unsigned x, unsigned& nloc, unsigned& nx) {
    const unsigned G = gridDim.x * gridDim.y * gridDim.z;
    unsigned sum, cnt, mine, sp = 0u;
    for (;;) {
        sum = 0u; cnt = 0u; mine = 0u;
#pragma unroll
        for (unsigned j = 0; j < 16; ++j) { const unsigned c = xb_ld(&bar[XB_XCNT(j)]); sum += c; cnt += (c > 0u) ? 1u : 0u; mine = (j == x) ? c : mine; }
        if (sum == G) break;
        __builtin_amdgcn_s_sleep(1);
        if ((++sp & 255u) == 0u) { if (xb_ld(&bar[XB_TMO])) break; if (sp > XB_SPIN_CAP) { atomicAdd(&bar[XB_TMO], 1u); break; } }
    }
    nloc = mine > 0u ? mine : 1u; nx = cnt > 0u ? cnt : 1u;
}
template <int NOFENCE = 0> DI void xcd_barrier(const XcdBarrier& b) {
    asm volatile("s_waitcnt vmcnt(0)" ::: "memory");
    __syncthreads();
    if (threadIdx.x == 0) {
        unsigned* bar = b.bar;
        __builtin_amdgcn_s_waitcnt(0);
        unsigned nloc = b.st[0], nx = b.st[1]; const unsigned round = b.st[2];
        if (nloc == 0u) { xcd_barrier_complete(bar, b.x, nloc, nx); b.st[0] = nloc; b.st[1] = nx; }
        b.st[2] = round + 1u;
        const unsigned old = xb_add(&bar[XB_XSUB(b.x)], 1u);
        if (old + 1u == (round + 1u) * nloc) {
            __builtin_amdgcn_fence(__ATOMIC_RELEASE, "agent");
            asm volatile("s_waitcnt vmcnt(0)" ::: "memory");
            const unsigned og = xb_add(&bar[XB_TOP], 1u);
            if (og + 1u == (round + 1u) * nx) xb_add(&bar[XB_TOPGEN], 1u);
        }
        XB_SPIN(xb_ld(&bar[XB_TOPGEN]) == round, bar);
        __builtin_amdgcn_fence(__ATOMIC_ACQUIRE, "agent");
        asm volatile("s_waitcnt vmcnt(0)" ::: "memory");
    }
    __syncthreads();
}

constexpr int NPHASE = 31;
#ifndef DBG_N
#define DBG_N NPHASE
#endif
#ifndef DBG_NELEM
#define DBG_NELEM 0
#endif
#ifndef DBG_OFF
#define DBG_OFF 0
#endif
#ifndef DBG_F32
#define DBG_F32 0
#endif
#ifndef DBG_NELEM2
#define DBG_NELEM2 0
#endif
#ifndef DBG_OFF2
#define DBG_OFF2 0
#endif
#ifndef PHM
#define PHM 0xFFFF
#endif

DI void run_phase(const Args& a, int ph, LAS unsigned char* lds, bool dry) {
    if (ph == 0) { if (PHM & 1) phase_prologue(a, lds); return; }
    const int l = (ph - 1) / 15, q = (ph - 1) % 15;
    GAS GAS unsigned char* wt = AWS + WS_WT + (size_t)l * WT_LAYER;
    const int G = gridDim.x, cidx = blockIdx.x;
    const GAS float* MOD = (const GAS float*)(AWS + WS_MOD);
    if (q == 0) { if (PHM & 2) phase_modulate(a, l, 0, 0); return; }
    if (q >= 1 && q <= 10) {
        const int hf = (q - 1) / 5, k = (q - 1) % 5;
        const int rowshift = hf ? HALF_ROWS : 0;
        if (k == 0) { if (PHM & 4) {
            pg8::Gemm g{(const GAS char*)(AWS + WS_H) + (size_t)rowshift * DM * 2, (const GAS char*)(wt + WT_IN), DM, DM, DM, 0, 0, 0, 0};
            pg8::Order S; S.init(hf ? 8 : 0, hf ? 64 : 72, NPAD / 256, 1, G, cidx);
            pg8::EpiProj E{(GAS bf16_t*)(AWS + WS_BIG), 0};
            pg8::gemm_phase<pg8::EpiProj>(lds, g, S, E); }
        } else if (k == 1) { if (PHM & 8) phase_x1(a, l, hf, lds, dry); }
        else if (k == 2) { if (PHM & 16) phase_x2(a, l, hf, lds, dry); }
        else if (k == 3) { if (PHM & 32) phase_x3(a, l, hf, lds, dry); }
        else if (PHM & 64) {
            const bool withctx = (hf == 0 && l == 0);
            pg8::Gemm g{(const GAS char*)(AWS + WS_BIG), (const GAS char*)(wt + WT_BR), LDP, 512, 512, C_U * 2, (C_QB - C_U) * 2, (C_RC - 2 * C_QB + C_U) * 2, 1024 * 512 * 2};
            pg8::Order S; S.init(withctx ? 0 : 8, withctx ? 72 : 64, 4, 3, G, cidx);
            pg8::EpiMerge E{(const GAS bf16_t*)(AWS + WS_BIG), 0, (GAS bf16_t*)(AWS + WS_H) + (size_t)rowshift * DM};
            pg8::gemm_phase<pg8::EpiMerge>(lds, g, S, E);
        }
        return;
    }
    const int pm0 = (l == 0) ? 0 : 8, nM = 136 - pm0;
    if (q == 11) { if (PHM & 128) {
        pg8::Gemm g{(const GAS char*)(AWS + WS_H), (const GAS char*)(wt + WT_O), DM, DM, DM, 0, 0, 0, 0};
        pg8::Order S; S.init(pm0, nM, 4, 1, G, cidx);
        pg8::EpiResid E{l == 0 ? AIN(2) : (const GAS float*)(AWS + WS_CTXBUF), l == 0 ? AIN(0) : (const GAS float*)AOUT, (GAS float*)(AWS + WS_CTXBUF), AOUT, MOD + (size_t)(l * 9) * 6144 + 2 * 1024};
        pg8::gemm_phase<pg8::EpiResid>(lds, g, S, E); }
    } else if (q == 12) { if (PHM & 2) phase_modulate(a, l, 1, pm0 * 256);
    } else if (q == 13) { if (PHM & 256) {
        pg8::Gemm g{(const GAS char*)(AWS + WS_H), (const GAS char*)(wt + WT_F1), DM, DM, DM, 0, 0, 0, 0};
        pg8::Order S; S.init(pm0, nM, 16, 1, G, cidx);
        pg8::EpiFF1 E{(GAS bf16_t*)(AWS + WS_BIG)};
        pg8::gemm_phase<pg8::EpiFF1>(lds, g, S, E); }
    } else if (PHM & 512) {
        { pg8::Gemm g{(const GAS char*)(AWS + WS_BIG), (const GAS char*)(wt + WT_F2), FF, FF, FF, 0, 0, 0, 0};
          pg8::Order S; S.init(8, 128, 4, 1, G, cidx);
          pg8::EpiResid E{(const GAS float*)(AWS + WS_CTXBUF), (const GAS float*)AOUT, (GAS float*)(AWS + WS_CTXBUF), AOUT, MOD + (size_t)(l * 9) * 6144 + 5 * 1024};
          pg8::gemm_phase<pg8::EpiResid>(lds, g, S, E); }
        if (l == 0) {
          pg8::Gemm g{(const GAS char*)(AWS + WS_BIG), (const GAS char*)(wt + WT_F2), FF, FF, 1024, 0, 2048, 0, 2048};
          pg8::Order S; S.init(0, 8, 4, 4, G, cidx, 1);
          pg8::EpiPartial E{(GAS float*)(AWS + WS_PART), MOD + (size_t)(l * 9) * 6144 + 5 * 1024};
          pg8::gemm_phase<pg8::EpiPartial>(lds, g, S, E); }
    }
}

__global__ void __launch_bounds__(512, 2) mega_fwd(Args a) {
    extern __shared__ __attribute__((aligned(16))) unsigned char lds_raw[];
    LAS unsigned char* lds = (LAS unsigned char*)lds_raw;
    cg::grid_group grid = cg::this_grid();
    volatile LAS unsigned* misc = (volatile LAS unsigned*)(lds + 143360);
    if (threadIdx.x < 4) misc[threadIdx.x] = 0u;
    if (threadIdx.x == 0) *(volatile LAS unsigned long long*)(lds + 143376) = (unsigned long long)(AWS + WS_PART);
    __syncthreads();
    XcdBarrier bar = xcd_barrier_post((unsigned*)AWS + 4096, misc);
    if (a.ph_lo < 0) grid.sync();
    for (int ph = a.ph_lo; ph < a.ph_hi; ++ph) {
        Args b = a; int phv = ph;
        asm volatile("" : "+s"(b.ws), "+s"(b.out), "+s"(phv));
        int nrep = 1, drymatch = 0;
        if (DRYMASK && phv > 0) { const int q_ = (phv - 1) % 15; const int k_ = (q_ >= 1 && q_ <= 10) ? (q_ - 1) % 5 : 0;
            if (k_ >= 1 && k_ <= 3 && ((DRYMASK >> (k_ - 1)) & 1)) { nrep = 2; drymatch = 1; } }
        if (DUPMASK) { const int q_ = (phv - 1) % 15; bool dup = false;
            if (phv > 0) { if ((DUPMASK & 1) && (q_ == 1 || q_ == 6)) dup = true; if ((DUPMASK & 2) && q_ == 13) dup = true; if ((DUPMASK & 4) && (q_ == 0 || q_ == 12)) dup = true; if ((DUPMASK & 8) && (q_ == 5 || q_ == 10)) dup = true; }
            else if (DUPMASK & 16) dup = true;
            if (dup) nrep = 2; }
        nrep = __builtin_amdgcn_readfirstlane(nrep); drymatch = __builtin_amdgcn_readfirstlane(drymatch);
        for (int rep = 0; rep < nrep; ++rep) {
            run_phase(b, phv, lds, drymatch != 0 && rep == 0);
            if (rep + 1 < nrep) xcd_barrier(bar);
        }
        if (ph + 1 < a.ph_hi) { xcd_barrier(bar); if (DBL_BAR) xcd_barrier(bar); }
    }
    if (DBG_NELEM > 0) {
        xcd_barrier(bar);
        for (size_t i = (size_t)blockIdx.x * 512 + threadIdx.x; i < (size_t)NLAT * DM; i += (size_t)gridDim.x * 512) {
            float v = DBG_F32 ? ((const GAS float*)(AWS + (size_t)DBG_OFF))[i % (size_t)DBG_NELEM] : bf2f(((const GAS bf16_t*)(AWS + (size_t)DBG_OFF))[i % (size_t)DBG_NELEM]);
            if (DBG_NELEM2 > 0) v += bf2f(((const GAS bf16_t*)(AWS + (size_t)DBG_OFF2))[i % (size_t)DBG_NELEM2]);
            AOUT[i] = v; }
    }
}

extern "C" void kernel_launch(void* const* d_in, const int* in_sizes, int n_in, void* d_out, int out_size, void* d_ws, size_t ws_size, hipStream_t stream) {
    static int grid = 0;
    if (grid == 0) {
        int dev = 0, cus = 0, per_cu = 0;
        hipGetDevice(&dev);
        hipDeviceGetAttribute(&cus, hipDeviceAttributeMultiprocessorCount, dev);
        hipFuncSetAttribute((const void*)mega_fwd, hipFuncAttributeMaxDynamicSharedMemorySize, LDS_BYTES);
        hipOccupancyMaxActiveBlocksPerMultiprocessor(&per_cu, (const void*)mega_fwd, 512, LDS_BYTES);
        (void)hipGetLastError();
        if (per_cu < 1) per_cu = 1;
        grid = cus * 1;
        if (ws_size < WS_END) fprintf(stderr, "kernel_launch: workspace too small: %zu < %zu\n", ws_size, (size_t)WS_END);
        if (n_in != 22) fprintf(stderr, "kernel_launch: expected 22 inputs, got %d\n", n_in);
    }
    if (hipMemsetAsync(d_ws, 0, 65536, stream) != hipSuccess) fprintf(stderr, "kernel_launch: memset failed\n");
    Args a{};
    for (int i = 0; i < 22; ++i) a.in[i] = (const float*)d_in[i];
    a.out = (float*)d_out; a.ws = (unsigned char*)d_ws; a.ph_lo = 0; a.ph_hi = DBG_N;
    void* args[] = {&a};
    hipError_t e = hipLaunchCooperativeKernel((const void*)mega_fwd, dim3(grid), dim3(512), args, LDS_BYTES, stream);
    if (e != hipSuccess) fprintf(stderr, "cooperative launch failed: %s (grid %d)\n", hipGetErrorString(e), grid);
}
```

```cpp
#include <hip/hip_runtime.h>
#include <hip/hip_cooperative_groups.h>
#include <cstdio>
#include <cstdint>
namespace cg = cooperative_groups;

#define DI __device__ __forceinline__
#define LAS __attribute__((address_space(3)))
#define GAS __attribute__((address_space(1)))
#define AIN(k) ((const GAS float*)a.in[k])
#define AOUT ((GAS float*)a.out)
#define AWS ((GAS unsigned char*)a.ws)
typedef unsigned short bf16_t;
typedef short bf16x8 __attribute__((ext_vector_type(8)));
typedef float f32x4 __attribute__((ext_vector_type(4)));
typedef unsigned u32x4 __attribute__((ext_vector_type(4)));
typedef unsigned u32x2 __attribute__((ext_vector_type(2)));

#define DST(p) (dry ? (decltype(p))(g_sink + ((size_t)(p) & 0xFFFFF0u)) : (p))
#ifndef DBL_BAR
#define DBL_BAR 0
#endif
#ifndef DRY_NOFENCE
#define DRY_NOFENCE 0
#endif
#ifndef P1_DRY_MODE
#define P1_DRY_MODE 0
#endif
#ifndef ATT_DRY_MODE
#define ATT_DRY_MODE 0
#endif
#ifndef DRYSEL
#define DRYSEL 7
#endif
#ifndef DRYMASK
#define DRYMASK 0
#endif
#ifndef DUPMASK
#define DUPMASK 0
#endif
#ifndef X1MASK
#define X1MASK 7
#endif
constexpr int DM = 1024, NB = 8, SEQ = 4096, CTXL = 256;
constexpr int NCTX = NB * CTXL;
constexpr int NLAT = NB * SEQ;
constexpr int NROW = NCTX + NLAT;
constexpr int LDP = 6432;
constexpr int NPAD = 6656;
constexpr int FF = 4096;
constexpr int C_U = 0, C_VA = 512, C_QB = 1024, C_KB = 1536, C_VB = 1664, C_QC = 1792, C_KC = 2048, C_VC = 2304, C_RC = 2816, C_ZF = 3328, C_ZB = 3344, C_G = 3360;
constexpr int HALF_ROWS = 16384;
constexpr float EPSV = 1e-6f;
constexpr float LOG2E = 1.4426950408889634f;

constexpr size_t MiB = 1u << 20;
constexpr size_t WS_ROPE = 1 * MiB;
constexpr size_t WS_MOD = 1 * MiB + 65536;
constexpr size_t WS_CTXST = 2 * MiB;
constexpr size_t WS_DEC = 4 * MiB;
constexpr size_t WS_WT = 8 * MiB;
constexpr size_t WT_LAYER = 34 * MiB;
constexpr size_t WT_IN = 0;
constexpr size_t WT_BR = (size_t)NPAD * 1024 * 2;
constexpr size_t WT_O = WT_BR + 3u * 1024 * 512 * 2;
constexpr size_t WT_F1 = WT_O + 1024u * 1024 * 2;
constexpr size_t WT_F2 = WT_F1 + 4096u * 1024 * 2;
constexpr size_t WS_CTXBUF = 76 * MiB;
constexpr size_t WS_H = 84 * MiB;
constexpr size_t WS_KV = 152 * MiB;
constexpr size_t WS_BIG = 188 * MiB;
constexpr size_t WS_PART = 460 * MiB;
constexpr size_t WS_END = 492 * MiB;
static_assert(WT_F2 + 1024u * 4096 * 2 <= WT_LAYER, "wt");

constexpr int LDS_BYTES = 147456;

struct Args { const float* in[22]; float* out; unsigned char* ws; int ph_lo, ph_hi; };

DI int otid() { int t = threadIdx.x; asm volatile("" : "+v"(t)); return t; }
DI int obid() { int t = blockIdx.x; asm volatile("" : "+s"(t)); return t; }
DI float bf2f(unsigned short h) { return __uint_as_float((unsigned)h << 16); }
DI unsigned f2bf(float f) { unsigned u = __float_as_uint(f); return (u + 0x7fffu + ((u >> 16) & 1u)) >> 16; }
typedef __bf16 bf16x2_t __attribute__((ext_vector_type(2)));
typedef float f32x2_t __attribute__((ext_vector_type(2)));
DI unsigned pk2(float lo, float hi) { f32x2_t v = {lo, hi}; bf16x2_t b = __builtin_convertvector(v, bf16x2_t); return __builtin_bit_cast(unsigned, b); }
DI void unpack8(const u32x4 w, float* f) {
#pragma unroll
    for (int i = 0; i < 4; ++i) { f[2 * i] = __uint_as_float(w[i] << 16); f[2 * i + 1] = __uint_as_float(w[i] & 0xffff0000u); }
}
DI u32x4 pack8(const float* f) { u32x4 w; w.x = pk2(f[0], f[1]); w.y = pk2(f[2], f[3]); w.z = pk2(f[4], f[5]); w.w = pk2(f[6], f[7]); return w; }
template <int CTRL, int RM> DI float dpp_f(float x) { return __builtin_bit_cast(float, __builtin_amdgcn_update_dpp(0, __builtin_bit_cast(int, x), CTRL, RM, 0xF, false)); }
DI float wave_sum(float v) {
#pragma unroll
    for (int o = 1; o < 64; o <<= 1) v += __shfl_xor(v, o);
    return v;
}
DI float sum8(float v) {
    v += dpp_f<0xB1, 0xF>(v); v += dpp_f<0x4E, 0xF>(v); v += dpp_f<0x141, 0xF>(v); return v;
}
DI float frcp(float x) { return __builtin_amdgcn_rcpf(x); }
DI float gelu_tanh(float x) { const float y = 0.7978845608028654f * (x + 0.044715f * x * x * x); return x * (1.f - frcp(1.f + __expf(2.f * y))); }
DI float log_sigmoid(float x) { return fminf(x, 0.f) - 0.6931471805599453f * __builtin_amdgcn_logf(1.f + __builtin_amdgcn_exp2f(-1.4426950408889634f * fabsf(x))); }
#define MFMA16(a, b, c) __builtin_amdgcn_mfma_f32_16x16x32_bf16((a), (b), (c), 0, 0, 0)

namespace pg8 {
constexpr int BM = 256, BK = 64, HALF = 128, HTB = HALF * BK * 2, STAGE_BYTES = 8 * HTB, NXCD = 8, WGM = 8;
DI int lds_byte(int r, int c) { const int st = (r >> 4) * 2 + (c >> 5), rr = r & 15, cc = c & 31, ob = rr * 64 + cc * 2; return st * 1024 + (ob ^ (((ob >> 9) & 1) << 5)); }
DI void stage_rc(int b, int& R, int& C) { const int st = b / 1024, sb = b % 1024, swz = sb ^ (((sb >> 9) & 1) << 5); R = (st >> 1) * 16 + swz / 64; C = (st & 1) * 32 + (swz % 64) / 2; }
DI int perm32(int rho) { const int n = rho >> 4, i = rho & 15; return 8 * (i >> 2) + 4 * n + (i & 3); }

struct Unit { int pm, pn, z; };
struct Gemm { const GAS char* A; const GAS char* Bt; int lda, ldb, K; int zA0, dA1, dA2, dB;
    DI size_t za(int z) const { return (size_t)(zA0 + z * dA1 + (z >> 1) * dA2); }
    DI size_t zb(int z) const { return (size_t)z * (size_t)dB; } };

struct Order {
    int pm0, nM, nN, nwg, G, c, nz, spread;
    DI void init(int pm0_, int nM_, int nN_, int nz_, int G_, int c_, int spread_ = 0) { pm0 = pm0_; nM = nM_; nN = nN_; nwg = nM * nN; G = G_; c = c_; nz = nz_; spread = spread_; }
    DI bool next(int i, Unit& u) const {
        if (spread == 2) {
            const int cc = c - 128; if (cc < 0) return false;
            const long L = (long)i * G + cc; if (L >= 40) return false;
            const int t = (int)L, k = t % 5; u.pm = t / 5; u.pn = 6 + k + (k > 0 ? 1 : 0) + (k == 4 ? 2 : 0); u.z = 0; return true; }
        if (spread) {
            const long L = (long)i * G + c; if (L >= (long)nwg * nz) return false;
            const int t = (int)(L / nz); u.z = (int)(L - (long)t * nz); u.pm = pm0 + t / nN; u.pn = t % nN; return true; }
        const int ti = i / nz; const int z = i - ti * nz;
        const long L = (long)ti * G + c; if (L >= nwg) return false;
        int wgid = (int)L; { const int q = nwg / NXCD, r = nwg % NXCD, xcd = wgid % NXCD, off = wgid / NXCD; wgid = (xcd < r ? xcd * (q + 1) : r * (q + 1) + (xcd - r) * q) + off; }
        const int nig = WGM * nN, gid = wgid / nig, fm = gid * WGM, gsz = (nM - fm) < WGM ? (nM - fm) : WGM;
        u.pm = pm0 + fm + ((wgid % nig) % gsz); u.pn = (wgid % nig) / gsz; u.z = z; return true;
    }
};

template <class Epi>
DI void gemm_phase(LAS unsigned char* lds, const Gemm g, const Order& S, const Epi& E) {
    const int tid = otid(), wid = __builtin_amdgcn_readfirstlane(tid >> 6), lane = tid & 63, wr = wid >> 2, wc = wid & 3, fr = lane & 15, fq = lane >> 4;
    const int nt = g.K / BK;
    unsigned voffA[2], voffB[2];
#pragma unroll
    for (int i = 0; i < 2; ++i) { int R, C; stage_rc(tid * 16 + i * 8192, R, C); const int Rb = (R & ~31) + perm32(R & 31);
        voffA[i] = (unsigned)(R * g.lda + C) * 2u; voffB[i] = (unsigned)(Rb * g.ldb + C) * 2u; }
    const size_t kstep = (size_t)(BK * 2);
    const size_t hstepA = (size_t)HALF * g.lda * 2, hstepB = (size_t)HALF * g.ldb * 2;
    const size_t tstepA = 2 * hstepA, tstepB = 2 * hstepB;
    const unsigned ldsw = (unsigned)wid * 1024u;
    const int aoff = lds_byte(wr * 64 + fr, fq * 8), boff = lds_byte(wc * 32 + fr, fq * 8);
#define PG8_SA(b, h) (((b) * 2 + (h)) * HTB)
#define PG8_SB(b, h) ((4 + (b) * 2 + (h)) * HTB)
#define PG8_STAGE(bufoff, gbase, voff) do { _Pragma("unroll") for (int _i = 0; _i < 2; ++_i) \
        __builtin_amdgcn_global_load_lds((const unsigned*)((const GAS char*)(gbase) + (voff)[_i]), (LAS unsigned*)(lds + (bufoff) + ldsw + _i * 8192), 16, 0, 0); } while (0)
#define PG8_LDA(dst, b, h) do { _Pragma("unroll") for (int m = 0; m < 4; ++m) _Pragma("unroll") for (int k = 0; k < 2; ++k) dst[m][k] = *(const LAS bf16x8*)(lds + PG8_SA(b, h) + aoff + m * 2048 + k * 1024); } while (0)
#define PG8_LDB(dst, b, h) do { _Pragma("unroll") for (int n = 0; n < 2; ++n) _Pragma("unroll") for (int k = 0; k < 2; ++k) dst[n][k] = *(const LAS bf16x8*)(lds + PG8_SB(b, h) + boff + n * 2048 + k * 1024); } while (0)
#define PG8_MMA(ai, bj, At, Bt) do { __builtin_amdgcn_s_setprio(1); _Pragma("unroll") for (int m = 0; m < 4; ++m) _Pragma("unroll") for (int n = 0; n < 2; ++n) _Pragma("unroll") for (int k = 0; k < 2; ++k) \
        acc[ai][bj][m][n] = __builtin_amdgcn_mfma_f32_16x16x32_bf16(Bt[n][k], At[m][k], acc[ai][bj][m][n], 0, 0, 0); __builtin_amdgcn_s_setprio(0); } while (0)
#define PG8_WAIT_V(n) asm volatile("s_waitcnt vmcnt(" #n ")" ::: "memory")
#define PG8_WAIT_L(n) asm volatile("s_waitcnt lgkmcnt(" #n ")" ::: "memory")
#define PG8_BAR __builtin_amdgcn_s_barrier()
#define PG8_SCHED __builtin_amdgcn_sched_barrier(0)
    Unit cur, nxt; int ui = 0;
    if (!S.next(0, cur)) return;
    f32x4 acc[2][2][4][2];
#pragma unroll
    for (int a = 0; a < 2; ++a)
#pragma unroll
        for (int b = 0; b < 2; ++b)
#pragma unroll
            for (int m = 0; m < 4; ++m)
#pragma unroll
                for (int n = 0; n < 2; ++n) acc[a][b][m][n] = (f32x4){0.f, 0.f, 0.f, 0.f};
    bf16x8 At[4][2], B0[2][2], B1[2][2];
    const GAS char* cA = g.A + (size_t)cur.pm * tstepA + g.za(cur.z); const GAS char* cB = g.Bt + (size_t)cur.pn * tstepB + g.zb(cur.z);
    PG8_STAGE(PG8_SB(0, 0), cB, voffB); PG8_STAGE(PG8_SB(0, 1), cB + hstepB, voffB); PG8_STAGE(PG8_SA(0, 0), cA, voffA); PG8_STAGE(PG8_SA(0, 1), cA + hstepA, voffA);
    if (wr == 1) PG8_BAR;
    PG8_WAIT_V(2); PG8_BAR;
    PG8_STAGE(PG8_SB(1, 0), cB + kstep, voffB); PG8_STAGE(PG8_SA(1, 0), cA + kstep, voffA); PG8_STAGE(PG8_SB(1, 1), cB + hstepB + kstep, voffB);
    PG8_WAIT_V(6); PG8_BAR;
    for (;;) {
        const bool has_next = S.next(ui + 1, nxt);
        const GAS char* nA = has_next ? g.A + (size_t)nxt.pm * tstepA + g.za(nxt.z) : cA; const GAS char* nB = has_next ? g.Bt + (size_t)nxt.pn * tstepB + g.zb(nxt.z) : cB;
        for (int t = 0; t < nt; t += 2) {
            const bool last = (t == nt - 2);
            const GAS char* a1 = cA + (size_t)(t + 1) * kstep;
            const GAS char* a2 = last ? nA : cA + (size_t)(t + 2) * kstep; const GAS char* b2 = last ? nB : cB + (size_t)(t + 2) * kstep;
            const GAS char* a3 = a2 + kstep; const GAS char* b3 = b2 + kstep;
            PG8_LDB(B0, 0, 0); PG8_LDB(B1, 0, 1); PG8_SCHED; PG8_LDA(At, 0, 0); PG8_STAGE(PG8_SA(1, 1), a1 + hstepA, voffA);
            PG8_WAIT_V(8); PG8_WAIT_L(0); PG8_BAR; PG8_MMA(0, 0, At, B0); PG8_MMA(0, 1, At, B1); PG8_BAR; PG8_SCHED;
            PG8_LDA(At, 0, 1); PG8_STAGE(PG8_SB(0, 0), b2, voffB); PG8_STAGE(PG8_SB(0, 1), b2 + hstepB, voffB); PG8_STAGE(PG8_SA(0, 0), a2, voffA);
            PG8_WAIT_V(8); PG8_WAIT_L(0); PG8_BAR; PG8_MMA(1, 0, At, B0); PG8_MMA(1, 1, At, B1); PG8_BAR; PG8_SCHED;
            PG8_LDB(B0, 1, 0); PG8_LDB(B1, 1, 1); PG8_SCHED; PG8_LDA(At, 1, 0); PG8_STAGE(PG8_SA(0, 1), a2 + hstepA, voffA);
            PG8_WAIT_V(8); PG8_WAIT_L(0); PG8_BAR; PG8_MMA(0, 0, At, B0); PG8_MMA(0, 1, At, B1); PG8_BAR; PG8_SCHED;
            PG8_LDA(At, 1, 1); PG8_STAGE(PG8_SB(1, 0), b3, voffB); PG8_STAGE(PG8_SB(1, 1), b3 + hstepB, voffB); PG8_STAGE(PG8_SA(1, 0), a3, voffA);
            PG8_WAIT_V(8); PG8_WAIT_L(0); PG8_BAR; PG8_MMA(1, 0, At, B0); PG8_MMA(1, 1, At, B1); PG8_BAR; PG8_SCHED;
        }
        if (wr == 0) PG8_BAR;
        E(acc, cur, wr, wc, fr, fq);
        if (!has_next) break;
#pragma unroll
        for (int a = 0; a < 2; ++a)
#pragma unroll
            for (int b = 0; b < 2; ++b)
#pragma unroll
                for (int m = 0; m < 4; ++m)
#pragma unroll
                    for (int n = 0; n < 2; ++n) acc[a][b][m][n] = (f32x4){0.f, 0.f, 0.f, 0.f};
        cur = nxt; cA = nA; cB = nB; ++ui;
        if (wr == 1) PG8_BAR;
    }
    PG8_WAIT_V(0);
    PG8_BAR;
#undef PG8_SA
#undef PG8_SB
#undef PG8_STAGE
#undef PG8_LDA
#undef PG8_LDB
#undef PG8_MMA
#undef PG8_WAIT_V
#undef PG8_WAIT_L
#undef PG8_BAR
#undef PG8_SCHED
}

struct EpiProj {
    GAS bf16_t* O; int rowshift;
    DI void operator()(const f32x4 (&acc)[2][2][4][2], const Unit& u, int wr, int wc, int fr, int fq) const {
        const int row0 = u.pm * BM + wr * 64 + fr - rowshift, col0 = u.pn * BM + wc * 32 + 8 * fq;
#pragma unroll
        for (int ai = 0; ai < 2; ++ai)
#pragma unroll
            for (int m = 0; m < 4; ++m) { GAS bf16_t* rowp = O + (size_t)(row0 + ai * HALF + m * 16) * LDP + col0;
#pragma unroll
                for (int bj = 0; bj < 2; ++bj) { if (col0 + bj * HALF < LDP) { const f32x4 v0 = acc[ai][bj][m][0], v1 = acc[ai][bj][m][1];
                    u32x4 w; w.x = pk2(v0[0], v0[1]); w.y = pk2(v0[2], v0[3]); w.z = pk2(v1[0], v1[1]); w.w = pk2(v1[2], v1[3]);
                    *(GAS u32x4*)(rowp + bj * HALF) = w; } } }
    }
};
struct EpiFF1 {
    GAS bf16_t* O;
    DI void operator()(const f32x4 (&acc)[2][2][4][2], const Unit& u, int wr, int wc, int fr, int fq) const {
        const int row0 = u.pm * BM + wr * 64 + fr, col0 = u.pn * BM + wc * 32 + 8 * fq;
#pragma unroll
        for (int ai = 0; ai < 2; ++ai)
#pragma unroll
            for (int m = 0; m < 4; ++m) { GAS bf16_t* rowp = O + (size_t)(row0 + ai * HALF + m * 16) * FF + col0;
#pragma unroll
                for (int bj = 0; bj < 2; ++bj) { f32x4 v0 = acc[ai][bj][m][0], v1 = acc[ai][bj][m][1];
#pragma unroll
                    for (int e = 0; e < 4; ++e) { const float a = fmaxf(v0[e], 0.f), b = fmaxf(v1[e], 0.f); v0[e] = a * a; v1[e] = b * b; }
                    u32x4 w; w.x = pk2(v0[0], v0[1]); w.y = pk2(v0[2], v0[3]); w.z = pk2(v1[0], v1[1]); w.w = pk2(v1[2], v1[3]);
                    *(GAS u32x4*)(rowp + bj * HALF) = w; } }
    }
};
struct EpiMerge {
    const GAS bf16_t* P; int rowshift; GAS bf16_t* Mg;
    DI void operator()(const f32x4 (&acc)[2][2][4][2], const Unit& u, int wr, int wc, int fr, int fq) const {
        const int row0 = u.pm * BM + wr * 64 + fr, col0 = u.pn * BM + wc * 32 + 8 * fq;
#pragma unroll
        for (int ai = 0; ai < 2; ++ai)
#pragma unroll
            for (int m = 0; m < 4; ++m) { const int row = row0 + ai * HALF + m * 16;
                const GAS bf16_t* gp = P + (size_t)(row - rowshift) * LDP + C_G + u.z * 1024 + col0; GAS bf16_t* op = Mg + (size_t)row * DM + col0;
#pragma unroll
                for (int bj = 0; bj < 2; ++bj) { const u32x4 gw = *(const GAS u32x4*)(gp + bj * HALF); float gv[8]; unpack8(gw, gv); float r[8];
#pragma unroll
                    for (int e = 0; e < 4; ++e) { r[e] = acc[ai][bj][m][0][e] * frcp(1.f + __expf(-gv[e])); r[4 + e] = acc[ai][bj][m][1][e] * frcp(1.f + __expf(-gv[4 + e])); }
                    if (u.z > 0) { const u32x4 ow = *(const GAS u32x4*)(op + bj * HALF); float ov[8]; unpack8(ow, ov);
#pragma unroll
                        for (int e = 0; e < 8; ++e) r[e] += ov[e]; }
                    *(GAS u32x4*)(op + bj * HALF) = pack8(r); } }
    }
};
struct EpiResid {
    const GAS float* base_ctx; const GAS float* base_lat; GAS float* out_ctx; GAS float* out_lat; const GAS float* gate;
    DI void operator()(const f32x4 (&acc)[2][2][4][2], const Unit& u, int wr, int wc, int fr, int fq) const {
        const int u0 = u.pm * BM; const bool isctx = u0 < NCTX; const int mi = isctx ? 8 : ((u0 - NCTX) >> 12);
        const GAS float* bp = isctx ? base_ctx + (size_t)u0 * DM : base_lat + (size_t)(u0 - NCTX) * DM;
        GAS float* op = isctx ? out_ctx + (size_t)u0 * DM : out_lat + (size_t)(u0 - NCTX) * DM;
        const int r0 = wr * 64 + fr, col0 = u.pn * BM + wc * 32 + 8 * fq;
        const GAS float* gp = gate + (size_t)mi * 6144 + col0;
        f32x4 gv[2][2];
#pragma unroll
        for (int bj = 0; bj < 2; ++bj)
#pragma unroll
            for (int n = 0; n < 2; ++n) gv[bj][n] = *(const GAS f32x4*)(gp + bj * HALF + 4 * n);
#pragma unroll
        for (int ai = 0; ai < 2; ++ai)
#pragma unroll
            for (int m = 0; m < 4; ++m) { const size_t off = (size_t)(r0 + ai * HALF + m * 16) * DM + col0;
#pragma unroll
                for (int bj = 0; bj < 2; ++bj)
#pragma unroll
                    for (int n = 0; n < 2; ++n) { const f32x4 b = *(const GAS f32x4*)(bp + off + bj * HALF + 4 * n);
                        *(GAS f32x4*)(op + off + bj * HALF + 4 * n) = b + gv[bj][n] * acc[ai][bj][m][n]; } }
    }
};
struct EpiPartial {
    GAS float* part; const GAS float* gate;
    DI void operator()(const f32x4 (&acc)[2][2][4][2], const Unit& u, int wr, int wc, int fr, int fq) const {
        GAS float* op = part + ((size_t)u.z * NCTX + (size_t)(u.pm * BM)) * DM;
        const int r0 = wr * 64 + fr, col0 = u.pn * BM + wc * 32 + 8 * fq;
        const GAS float* gp = gate + (size_t)8 * 6144 + col0;
        f32x4 gv[2][2];
#pragma unroll
        for (int bj = 0; bj < 2; ++bj)
#pragma unroll
            for (int n = 0; n < 2; ++n) gv[bj][n] = *(const GAS f32x4*)(gp + bj * HALF + 4 * n);
#pragma unroll
        for (int ai = 0; ai < 2; ++ai)
#pragma unroll
            for (int m = 0; m < 4; ++m) { const size_t off = (size_t)(r0 + ai * HALF + m * 16) * DM + col0;
#pragma unroll
                for (int bj = 0; bj < 2; ++bj)
#pragma unroll
                    for (int n = 0; n < 2; ++n) *(GAS f32x4*)(op + off + bj * HALF + 4 * n) = gv[bj][n] * acc[ai][bj][m][n]; }
    }
};
}

DI void p0_transpose_item(const GAS float* W, int K, int N, GAS bf16_t* WT, LAS float* scr, int item, int lane) {
    const int nblk = N / 32, kb = item / nblk, nb = item % nblk, k0 = 64 * kb, n0 = 32 * nb;
#pragma unroll 8
    for (int i = 0; i < 32; ++i) { const int kk = 2 * i + (lane >> 5); scr[kk * 33 + (lane & 31)] = W[(size_t)(k0 + kk) * N + n0 + (lane & 31)]; }
    asm volatile("s_waitcnt lgkmcnt(0)" ::: "memory");
    const int c = lane & 7;
#pragma unroll
    for (int j = 0; j < 4; ++j) { const int n = (lane >> 3) + 8 * j; const LAS float* s = scr + (8 * c) * 33 + n;
        u32x4 o; o.x = pk2(s[0 * 33], s[1 * 33]); o.y = pk2(s[2 * 33], s[3 * 33]); o.z = pk2(s[4 * 33], s[5 * 33]); o.w = pk2(s[6 * 33], s[7 * 33]);
        *(GAS u32x4*)(WT + (size_t)(n0 + n) * K + k0 + 8 * c) = o; }
    asm volatile("s_waitcnt lgkmcnt(0)" ::: "memory");
}

DI void phase_prologue(const Args& a, LAS unsigned char* lds) {
    const int tid = otid(), lane = tid & 63, wave = tid >> 6;
    GAS float* MOD = (GAS float*)(AWS + WS_MOD);
    if (blockIdx.x < 192) {
        LAS float* sc = (LAS float*)lds;
        LAS float* red = (LAS float*)(lds + 36864);
        for (int i = tid; i < 9 * 1024; i += 512) { const int mi = i >> 10, k = i & 1023; const float v = mi < 8 ? AIN(1)[mi * 1024 + k] : AIN(3)[k]; sc[i] = v / (1.f + __expf(-v)); }
        __syncthreads();
        const int l = blockIdx.x / 96, cgp = blockIdx.x % 96, col = cgp * 64 + lane;
        const GAS float* W = AIN(4) + (size_t)l * 1024 * 6144;
        float acc[9];
#pragma unroll
        for (int mi = 0; mi < 9; ++mi) acc[mi] = 0.f;
#pragma unroll 8
        for (int k = wave * 128; k < wave * 128 + 128; ++k) { const float w = W[(size_t)k * 6144 + col];
#pragma unroll
            for (int mi = 0; mi < 9; ++mi) acc[mi] += sc[mi * 1024 + k] * w; }
#pragma unroll
        for (int mi = 0; mi < 9; ++mi) red[(wave * 9 + mi) * 64 + lane] = acc[mi];
        __syncthreads();
        for (int idx = tid; idx < 576; idx += 512) { const int mi = idx >> 6, ln = idx & 63; float s = 0.f;
            for (int w = 0; w < 8; ++w) s += red[(w * 9 + mi) * 64 + ln];
            MOD[(size_t)(l * 9 + mi) * 6144 + cgp * 64 + ln] = s + AIN(5)[l * 6144 + cgp * 64 + ln]; }
        __syncthreads();
    }
    if (blockIdx.x == gridDim.x - 1) {
        GAS float* rope = (GAS float*)(AWS + WS_ROPE);
        for (int i = tid; i < 1024; i += 512) { const int pos = i >> 4, f = i & 15; const float freq = powf(10000.0f, -(float)f / 16.0f); const float ang = (float)pos * freq;
            rope[2 * i] = cosf(ang); rope[2 * i + 1] = sinf(ang); }
    }
    LAS float* scr = (LAS float*)(lds + wave * 16384);
    const int gw = blockIdx.x * 8 + wave, NGW = gridDim.x * 8;
    constexpr int I_IN = 16 * 201, I_BR = 8 * 32, I_O = 16 * 32, I_1 = 16 * 128, I_2 = 64 * 32;
    constexpr int PER_L = I_IN + 3 * I_BR + I_O + I_1 + I_2;
    for (int it = gw; it < 2 * PER_L; it += NGW) {
        const int l = it / PER_L; int r = it % PER_L;
        GAS GAS unsigned char* wt = AWS + WS_WT + (size_t)l * WT_LAYER;
        if (r < I_IN) { p0_transpose_item(AIN(6) + (size_t)l * 1024 * LDP, 1024, LDP, (GAS bf16_t*)(wt + WT_IN), scr, r, lane); continue; } r -= I_IN;
        if (r < 3 * I_BR) { const int k = r / I_BR; p0_transpose_item(AIN(18) + (size_t)(l * 3 + k) * 512 * 1024, 512, 1024, (GAS bf16_t*)(wt + WT_BR) + (size_t)k * 1024 * 512, scr, r % I_BR, lane); continue; } r -= 3 * I_BR;
        if (r < I_O) { p0_transpose_item(AIN(19) + (size_t)l * 1024 * 1024, 1024, 1024, (GAS bf16_t*)(wt + WT_O), scr, r, lane); continue; } r -= I_O;
        if (r < I_1) { p0_transpose_item(AIN(20) + (size_t)l * 1024 * 4096, 1024, 4096, (GAS bf16_t*)(wt + WT_F1), scr, r, lane); continue; } r -= I_1;
        p0_transpose_item(AIN(21) + (size_t)l * 4096 * 1024, 4096, 1024, (GAS bf16_t*)(wt + WT_F2), scr, r, lane);
    }
    for (int l = 0; l < 2; ++l) { GAS u32x4* z = (GAS u32x4*)(AWS + WS_WT + (size_t)l * WT_LAYER + WT_IN + (size_t)LDP * 1024 * 2);
        const int n16 = (NPAD - LDP) * 1024 * 2 / 16;
        for (int i = blockIdx.x * 512 + tid; i < n16; i += gridDim.x * 512) z[i] = (u32x4){0u, 0u, 0u, 0u}; }
}

DI void phase_modulate(const Args& a, int l, int which, int u_lo) {
    const int tid_ = otid(); const int lane = tid_ & 63, wave = tid_ >> 6;
    const GAS float* MOD = (const GAS float*)(AWS + WS_MOD);
    GAS bf16_t* H = (GAS bf16_t*)(AWS + WS_H);
    const bool from_in = (l == 0 && which == 0);
    const GAS float* xc = from_in ? AIN(2) : (const GAS float*)(AWS + WS_CTXBUF);
    const GAS float* xl = from_in ? AIN(0) : AOUT;
    const int gw = blockIdx.x * 8 + wave, NGW = gridDim.x * 8;
    for (int u = u_lo + gw; u < NROW; u += NGW) {
        const GAS float* xr = u < NCTX ? xc + (size_t)u * DM : xl + (size_t)(u - NCTX) * DM;
        const int mi = u < NCTX ? 8 : ((u - NCTX) >> 12);
        const GAS float* shift = MOD + (size_t)(l * 9 + mi) * 6144 + (which ? 3 : 0) * 1024;
        const GAS float* scale = shift + 1024;
        f32x4 v[4]; float ss = 0.f;
        const bool addpart = (l == 1 && which == 0 && u < NCTX);
#pragma unroll
        for (int j = 0; j < 4; ++j) { v[j] = *(const GAS f32x4*)(xr + 4 * lane + 256 * j);
            if (addpart) { const GAS float* pp = (const GAS float*)(AWS + WS_PART) + (size_t)u * DM + 4 * lane + 256 * j;
#pragma unroll
                for (int z = 0; z < 4; ++z) v[j] += *(const GAS f32x4*)(pp + (size_t)z * NCTX * DM); }
            ss += (v[j].x * v[j].x + v[j].y * v[j].y) + (v[j].z * v[j].z + v[j].w * v[j].w); }
        const float rstd = rsqrtf(wave_sum(ss) * (1.f / DM) + EPSV);
#pragma unroll
        for (int j = 0; j < 4; ++j) { const f32x4 sh = *(const GAS f32x4*)(shift + 4 * lane + 256 * j), sc = *(const GAS f32x4*)(scale + 4 * lane + 256 * j);
            const f32x4 o = v[j] * rstd * (sc + 1.f) + sh; u32x2 w; w.x = pk2(o.x, o.y); w.y = pk2(o.z, o.w);
            *(GAS u32x2*)(H + (size_t)u * DM + 4 * lane + 256 * j) = w; }
    }
}

DI void stage_T(LAS bf16_t* dst, const GAS bf16_t* src, int ncols, int tid) {
    const int ntask = (ncols >> 3) * 32;
    for (int task = tid; task < ntask; task += 512) { const int tp = task & 31, cgp = task >> 5;
        const u32x4 v0 = *(const GAS u32x4*)(src + (size_t)(2 * tp) * LDP + 8 * cgp), v1 = *(const GAS u32x4*)(src + (size_t)(2 * tp + 1) * LDP + 8 * cgp);
        LAS unsigned* d = (LAS unsigned*)(dst + (8 * cgp) * 72 + 2 * tp);
#pragma unroll
        for (int i = 0; i < 4; ++i) { d[(2 * i) * 36] = (v0[i] & 0xffffu) | (v1[i] << 16); d[(2 * i + 1) * 36] = (v0[i] >> 16) | (v1[i] & 0xffff0000u); } }
}

struct GlaW { const GAS float *wf, *bf, *wb, *bb; };

#define GLA_SWEEP() \
    const int d = tid >> 8, p = (tid >> 7) & 1, c = tid & 127, C = hp * 128 + c; \
    float bl[32]; { const GAS float* wg = d ? gw.wb : gw.wf; float w2[16]; _Pragma("unroll") for (int r = 0; r < 16; ++r) w2[r] = wg[r * 256 + C]; \
      const float bias = (d ? gw.bb : gw.bf)[C]; float cum = 0.f; \
      _Pragma("unroll") for (int i = 0; i < 32; ++i) { const int s = 32 * p + i, t = d ? 63 - s : s; float lg = bias, lg1 = 0.f, lg2 = 0.f, lg3 = 0.f; \
          _Pragma("unroll") for (int r = 0; r < 16; r += 4) { lg += zs[t * 32 + d * 16 + r] * w2[r]; lg1 += zs[t * 32 + d * 16 + r + 1] * w2[r + 1]; lg2 += zs[t * 32 + d * 16 + r + 2] * w2[r + 2]; lg3 += zs[t * 32 + d * 16 + r + 3] * w2[r + 3]; } \
          lg = (lg + lg1) + (lg2 + lg3); \
          cum += log_sigmoid(lg) * (1.f / 16.f); bl[i] = cum; if ((i & 3) == 3) __builtin_amdgcn_sched_barrier(0); } \
      xt[(d * 2 + p) * 128 + c] = cum; if (p) xt[512 + d * 128 + c] = bl[0]; }

DI void gla_pass1_item(const GAS bf16_t* P, int hp, GAS bf16_t* kv, GAS float* dec, const GlaW& gw, LAS unsigned char* lds, bool dry) {
    GAS char* g_sink = (GAS char*)*(volatile LAS unsigned long long*)(lds + 143376);
    const int tid = otid(), lane = tid & 63, wave = tid >> 6, fr = lane & 15, fq = lane >> 4;
    LAS float* zs = (LAS float*)lds; LAS float* xt = (LAS float*)(lds + 8192);
    LAS bf16_t* KO = (LAS bf16_t*)(lds + 16384);
    LAS bf16_t* VT = (LAS bf16_t*)(lds + 53248);
    if (!(dry && (P1_DRY_MODE & 8))) {
    if (tid < 256) { const int r = tid >> 2, cc = tid & 3; const u32x4 v = *(const GAS u32x4*)(P + (size_t)r * LDP + C_ZF + cc * 8); float f[8]; unpack8(v, f);
#pragma unroll
        for (int j = 0; j < 8; ++j) zs[r * 32 + cc * 8 + j] = f[j]; }
    stage_T(VT, P + C_VC + hp * 256, 256, tid); }
    unsigned short kpre[32];
    { const int d_ = tid >> 8, p_ = (tid >> 7) & 1, C_ = hp * 128 + (tid & 127);
#pragma unroll
      for (int i = 0; i < 32; ++i) { const int s = 32 * p_ + i, t = d_ ? 63 - s : s; kpre[i] = (dry && (P1_DRY_MODE & 16)) ? (unsigned short)i : P[(size_t)t * LDP + C_KC + C_]; } }
    __syncthreads();
    GLA_SWEEP();
    __syncthreads();
    if (!(dry && (P1_DRY_MODE & 2)))
    { const float off = p ? xt[(d * 2) * 128 + c] : 0.f; const float btot = xt[(d * 2) * 128 + c] + xt[(d * 2 + 1) * 128 + c];
#pragma unroll
      for (int i = 0; i < 32; ++i) { const int s = 32 * p + i, t = d ? 63 - s : s; const float kvv = bf2f(kpre[i]);
          KO[(d * 128 + c) * 72 + t] = (bf16_t)f2bf(kvv * __expf(btot - (bl[i] + off))); if ((i & 7) == 7) __builtin_amdgcn_sched_barrier(0); }
      if (p == 0) *DST(dec + d * 256 + C) = __expf(btot); }
    __syncthreads();
    if (!(dry && (P1_DRY_MODE & 1)))
    { const int dd = wave >> 2, h2 = (wave >> 1) & 1, dvh = wave & 1;
#pragma unroll
      for (int dkt = 0; dkt < 4; ++dkt) {
          const LAS bf16_t* ap = KO + (dd * 128 + h2 * 64 + dkt * 16 + fr) * 72 + fq * 8;
          const bf16x8 a0 = *(const LAS bf16x8*)ap, a1 = *(const LAS bf16x8*)(ap + 32);
#pragma unroll
          for (int dvt = 0; dvt < 4; ++dvt) { const int dv = (dvh * 4 + dvt) * 16 + fr;
              const LAS bf16_t* bp = VT + (h2 * 128 + dv) * 72 + fq * 8;
              const bf16x8 b0 = *(const LAS bf16x8*)bp, b1 = *(const LAS bf16x8*)(bp + 32);
              f32x4 acc = (f32x4){0.f, 0.f, 0.f, 0.f}; acc = MFMA16(a0, b0, acc); acc = MFMA16(a1, b1, acc);
              u32x2 w; w.x = pk2(acc[0], acc[1]); w.y = pk2(acc[2], acc[3]);
              *DST((GAS u32x2*)(kv + (size_t)((dd * 4 + hp * 2 + h2) * 128 + dv) * 64 + dkt * 16 + fq * 4)) = w; } } }
    __syncthreads();
}

DI void gla_pass3_item(GAS bf16_t* P, int hp, const GAS bf16_t* sin, const GlaW& gw, const GAS float* gnorm, LAS unsigned char* lds, bool dry) {
    GAS char* g_sink = (GAS char*)*(volatile LAS unsigned long long*)(lds + 143376);
    const int tid = otid(), lane = tid & 63, wave = tid >> 6, fr = lane & 15, fq = lane >> 4;
    LAS float* zs = (LAS float*)lds; LAS float* xt = (LAS float*)(lds + 8192);
    LAS bf16_t* QS = (LAS bf16_t*)(lds + 16384);
    LAS bf16_t* KS = (LAS bf16_t*)(lds + 53248);
    LAS bf16_t* VT = (LAS bf16_t*)(lds + 90112);
    if (tid < 256) { const int r = tid >> 2, cc = tid & 3; const u32x4 v = *(const GAS u32x4*)(P + (size_t)r * LDP + C_ZF + cc * 8); float f[8]; unpack8(v, f);
#pragma unroll
        for (int j = 0; j < 8; ++j) zs[r * 32 + cc * 8 + j] = f[j]; }
    stage_T(VT, P + C_VC + hp * 256, 256, tid);
    unsigned short kpre[32], qpre[32];
    { const int d_ = tid >> 8, p_ = (tid >> 7) & 1, C_ = hp * 128 + (tid & 127);
#pragma unroll
      for (int i = 0; i < 32; ++i) { const int s = 32 * p_ + i, t = d_ ? 63 - s : s; kpre[i] = P[(size_t)t * LDP + C_KC + C_]; qpre[i] = P[(size_t)t * LDP + C_QC + C_]; } }
    __syncthreads();
    GLA_SWEEP();
    __syncthreads();
    { const float off = p ? xt[(d * 2) * 128 + c] : 0.f; const float bref = xt[(d * 2) * 128 + c] + xt[512 + d * 128 + c];
      const int h2 = c >> 6, dk = c & 63;
#pragma unroll
      for (int i = 0; i < 32; ++i) { const int s = 32 * p + i, t = d ? 63 - s : s; const float bt = bl[i] + off;
          const float qv = bf2f(qpre[i]), kvv = bf2f(kpre[i]);
          QS[((d * 2 + h2) * 64 + t) * 72 + dk] = (bf16_t)f2bf(qv * 0.125f * __expf(bt - bref));
          KS[((d * 2 + h2) * 64 + t) * 72 + dk] = (bf16_t)f2bf(kvv * __expf(bref - bt)); if ((i & 7) == 7) __builtin_amdgcn_sched_barrier(0); }
      if (p == 0) xt[768 + d * 128 + c] = __expf(bref); }
    __syncthreads();
    {
        const int dd = wave >> 2, h2 = (wave >> 1) & 1, lh = wave & 1;
        f32x4 sc[2][4];
#pragma unroll
        for (int li = 0; li < 2; ++li) { const LAS bf16_t* qp = QS + ((dd * 2 + h2) * 64 + (2 * lh + li) * 16 + fr) * 72 + fq * 8;
            const bf16x8 q0 = *(const LAS bf16x8*)qp, q1 = *(const LAS bf16x8*)(qp + 32);
#pragma unroll
            for (int mt = 0; mt < 4; ++mt) { const LAS bf16_t* kp = KS + ((dd * 2 + h2) * 64 + mt * 16 + fr) * 72 + fq * 8;
                const bf16x8 k0 = *(const LAS bf16x8*)kp, k1 = *(const LAS bf16x8*)(kp + 32);
                f32x4 s = (f32x4){0.f, 0.f, 0.f, 0.f}; s = MFMA16(k0, q0, s); s = MFMA16(k1, q1, s); sc[li][mt] = s; } }
        __syncthreads();
#pragma unroll
        for (int li = 0; li < 2; ++li) { const int lrow = (2 * lh + li) * 16 + fr;
#pragma unroll
            for (int mt = 0; mt < 4; ++mt) { float v[4];
#pragma unroll
                for (int j = 0; j < 4; ++j) { const int mcol = mt * 16 + fq * 4 + j; const bool keep = dd ? (mcol >= lrow) : (mcol <= lrow); v[j] = keep ? sc[li][mt][j] : 0.f; }
                u32x2 w; w.x = pk2(v[0], v[1]); w.y = pk2(v[2], v[3]);
                *(LAS u32x2*)(KS + ((dd * 2 + h2) * 64 + lrow) * 72 + mt * 16 + fq * 4) = w; } }
    }
    __syncthreads();
    {
        const int h2 = wave >> 2, lt = wave & 3; const int h = hp * 2 + h2;
        f32x4 acc[8];
#pragma unroll
        for (int i = 0; i < 8; ++i) acc[i] = (f32x4){0.f, 0.f, 0.f, 0.f};
#pragma unroll 1
        for (int dd = 0; dd < 2; ++dd) {
            const LAS bf16_t* pp = KS + ((dd * 2 + h2) * 64 + lt * 16 + fr) * 72 + fq * 8;
            const LAS bf16_t* qp = QS + ((dd * 2 + h2) * 64 + lt * 16 + fr) * 72 + fq * 8;
            const bf16x8 p0 = *(const LAS bf16x8*)pp, p1 = *(const LAS bf16x8*)(pp + 32), q0 = *(const LAS bf16x8*)qp, q1 = *(const LAS bf16x8*)(qp + 32);
            float e0[8], e1[8];
#pragma unroll
            for (int j = 0; j < 8; ++j) { e0[j] = xt[768 + dd * 128 + h2 * 64 + fq * 8 + j]; e1[j] = xt[768 + dd * 128 + h2 * 64 + 32 + fq * 8 + j]; }
            u32x4 spre[8][2];
#pragma unroll
            for (int dvt = 0; dvt < 8; ++dvt) { const GAS bf16_t* sp = sin + (size_t)((dd * 4 + h) * 128 + dvt * 16 + fr) * 64 + fq * 8; spre[dvt][0] = *(const GAS u32x4*)sp; spre[dvt][1] = *(const GAS u32x4*)(sp + 32); }
#pragma unroll
            for (int dvt = 0; dvt < 8; ++dvt) {
                const LAS bf16_t* vp = VT + (h2 * 128 + dvt * 16 + fr) * 72 + fq * 8;
                const bf16x8 v0 = *(const LAS bf16x8*)vp, v1 = *(const LAS bf16x8*)(vp + 32);
                acc[dvt] = MFMA16(v0, p0, acc[dvt]); acc[dvt] = MFMA16(v1, p1, acc[dvt]);
                const u32x4 s0 = spre[dvt][0], s1 = spre[dvt][1];
                float f0[8], f1[8]; unpack8(s0, f0); unpack8(s1, f1);
#pragma unroll
                for (int j = 0; j < 8; ++j) { f0[j] *= e0[j]; f1[j] *= e1[j]; }
                const u32x4 t0 = pack8(f0), t1 = pack8(f1);
                acc[dvt] = MFMA16(__builtin_bit_cast(bf16x8, t0), q0, acc[dvt]); acc[dvt] = MFMA16(__builtin_bit_cast(bf16x8, t1), q1, acc[dvt]);
                __builtin_amdgcn_sched_barrier(0);
            }
        }
        float ss = 0.f;
#pragma unroll
        for (int i = 0; i < 8; ++i) ss += (acc[i][0] * acc[i][0] + acc[i][1] * acc[i][1]) + (acc[i][2] * acc[i][2] + acc[i][3] * acc[i][3]);
        ss += __shfl_xor(ss, 16); ss += __shfl_xor(ss, 32);
        const float rstd = rsqrtf(ss * (1.f / 128.f) + EPSV);
        GAS bf16_t* rp = P + (size_t)(lt * 16 + fr) * LDP + C_RC + h * 128;
#pragma unroll
        for (int dvt = 0; dvt < 8; ++dvt) { const int dv = dvt * 16 + fq * 4; const u32x2 rw = *(const GAS u32x2*)(rp + dv); const f32x4 gn = *(const GAS f32x4*)(gnorm + dv);
            float rv[4] = {__uint_as_float(rw.x << 16), __uint_as_float(rw.x & 0xffff0000u), __uint_as_float(rw.y << 16), __uint_as_float(rw.y & 0xffff0000u)}; float o[4];
#pragma unroll
            for (int j = 0; j < 4; ++j) o[j] = acc[dvt][j] * rstd * gn[j] * (rv[j] * frcp(1.f + __expf(-rv[j])));
            u32x2 w; w.x = pk2(o[0], o[1]); w.y = pk2(o[2], o[3]); *DST((GAS u32x2*)(rp + dv)) = w; }
    }
    __syncthreads();
}

DI void gla_scan_item(const Args& a, int hf, int b, int d, int slice, bool dry) {
    GAS char* g_sink = (GAS char*)(AWS + WS_PART);
    const int tid = otid(); const int e = slice * 2048 + tid * 4; const int h = e >> 13, dk = e & 63;
    GAS bf16_t* KV = (GAS bf16_t*)(AWS + WS_KV); const GAS float* DEC = (const GAS float*)(AWS + WS_DEC); GAS float* CST = (GAS float*)(AWS + WS_CTXST) + (size_t)(b * 2 + d) * 32768 + e;
    f32x4 st;
    if (hf == 0) {
        { float z0 = 0.f; asm volatile("" : "+v"(z0)); st = (f32x4){z0, z0, z0, z0}; }
#pragma unroll
        for (int s = 0; s < 4; ++s) { const int cid = b * 4 + (d ? 3 - s : s);
            GAS bf16_t* kp = KV + (size_t)cid * 65536 + d * 32768 + e; const u32x2 kw = *(const GAS u32x2*)kp; const f32x4 dc = *(const GAS f32x4*)(DEC + cid * 512 + d * 256 + h * 64 + dk);
            u32x2 w; w.x = pk2(st.x, st.y); w.y = pk2(st.z, st.w); *DST((GAS u32x2*)kp) = w;
            const f32x4 kvv = (f32x4){__uint_as_float(kw.x << 16), __uint_as_float(kw.x & 0xffff0000u), __uint_as_float(kw.y << 16), __uint_as_float(kw.y & 0xffff0000u)};
            st = st * dc + kvv; }
        *DST((GAS f32x4*)CST) = st;
        if (b >= 4) return;
    } else { st = *(const GAS f32x4*)CST; }
    const int cbase = 32 + (b & 3) * 64;
    u32x2 kwn[4]; f32x4 dcn[4];
#pragma unroll
    for (int k = 0; k < 4; ++k) { const int cid = cbase + (d ? 63 - k : k);
        kwn[k] = *(const GAS u32x2*)(KV + (size_t)cid * 65536 + d * 32768 + e); dcn[k] = *(const GAS f32x4*)(DEC + cid * 512 + d * 256 + h * 64 + dk); }
    for (int s0 = 0; s0 < 64; s0 += 4) {
        u32x2 kw[4]; f32x4 dc[4]; GAS bf16_t* kp[4];
#pragma unroll
        for (int k = 0; k < 4; ++k) { const int s = s0 + k; const int cid = cbase + (d ? 63 - s : s); kp[k] = KV + (size_t)cid * 65536 + d * 32768 + e; kw[k] = kwn[k]; dc[k] = dcn[k]; }
        if (s0 + 4 < 64) {
#pragma unroll
            for (int k = 0; k < 4; ++k) { const int s = s0 + 4 + k; const int cid = cbase + (d ? 63 - s : s);
                kwn[k] = *(const GAS u32x2*)(KV + (size_t)cid * 65536 + d * 32768 + e); dcn[k] = *(const GAS f32x4*)(DEC + cid * 512 + d * 256 + h * 64 + dk); } }
#pragma unroll
        for (int k = 0; k < 4; ++k) { u32x2 w; w.x = pk2(st.x, st.y); w.y = pk2(st.z, st.w); *DST((GAS u32x2*)kp[k]) = w;
            const f32x4 kvv = (f32x4){__uint_as_float(kw[k].x << 16), __uint_as_float(kw[k].x & 0xffff0000u), __uint_as_float(kw[k].y << 16), __uint_as_float(kw[k].y & 0xffff0000u)};
            st = st * dc[k] + kvv; }
    }
}

DI void sgu_item(GAS bf16_t* P, int g, const GAS float* ws_l  , const GAS float* bs_l  , const GAS float* gn_l  , LAS unsigned char* lds, bool dry) {
    GAS char* g_sink = (GAS char*)*(volatile LAS unsigned long long*)(lds + 143376);
    const int tid = otid(), lane = tid & 63, wave = tid >> 6, fr = lane & 15, fq = lane >> 4;
    LAS bf16_t* VT = (LAS bf16_t*)lds;
    const float g0 = gn_l[g * 128 + lane], g1 = gn_l[g * 128 + 64 + lane];
    { unsigned short r0[16], r1[16];
#pragma unroll
      for (int i = 0; i < 16; ++i) { const GAS bf16_t* vp = P + (size_t)(wave + 8 * i) * LDP + C_VA + g * 128; r0[i] = vp[lane]; r1[i] = vp[64 + lane]; }
#pragma unroll
      for (int i = 0; i < 16; ++i) { const int q = wave + 8 * i;
        const float x0 = gelu_tanh(bf2f(r0[i])), x1 = gelu_tanh(bf2f(r1[i]));
        const float rstd = rsqrtf(wave_sum(x0 * x0 + x1 * x1) * (1.f / 128.f) + EPSV);
        VT[lane * 136 + q] = (bf16_t)f2bf(x0 * rstd * g0); VT[(64 + lane) * 136 + q] = (bf16_t)f2bf(x1 * rstd * g1); } }
    bf16x8 wf[4];
    { const GAS float* wp = ws_l + (size_t)(g * 128 + wave * 16 + fr) * 128 + fq * 8;
#pragma unroll
      for (int ks = 0; ks < 4; ++ks) { const f32x4 w0 = *(const GAS f32x4*)(wp + ks * 32), w1 = *(const GAS f32x4*)(wp + ks * 32 + 4);
          u32x4 t; t.x = pk2(w0.x, w0.y); t.y = pk2(w0.z, w0.w); t.z = pk2(w1.x, w1.y); t.w = pk2(w1.z, w1.w); wf[ks] = __builtin_bit_cast(bf16x8, t); } }
    __syncthreads();
    const int prow = wave * 16 + fr; const float bias = bs_l[g * 128 + prow];
    GAS bf16_t* up = P + (size_t)prow * LDP + C_U + g * 128;
#pragma unroll
    for (int dt = 0; dt < 8; ++dt) { f32x4 acc = (f32x4){0.f, 0.f, 0.f, 0.f};
#pragma unroll
        for (int ks = 0; ks < 4; ++ks) { const bf16x8 av = *(const LAS bf16x8*)(VT + (dt * 16 + fr) * 136 + ks * 32 + fq * 8); acc = MFMA16(av, wf[ks], acc); }
        const int dcol = dt * 16 + fq * 4; const u32x2 uw = *(const GAS u32x2*)(up + dcol);
        const float uv[4] = {__uint_as_float(uw.x << 16), __uint_as_float(uw.x & 0xffff0000u), __uint_as_float(uw.y << 16), __uint_as_float(uw.y & 0xffff0000u)}; float o[4];
#pragma unroll
        for (int j = 0; j < 4; ++j) o[j] = gelu_tanh(uv[j]) * (acc[j] + bias);
        u32x2 w; w.x = pk2(o[0], o[1]); w.y = pk2(o[2], o[3]); *DST((GAS u32x2*)(up + dcol)) = w; }
    __syncthreads();
}

DI void qkprep_item(GAS bf16_t* P, int t0, bool doq, const GAS float* qn, const GAS float* kn, const GAS float* rope, bool dry, LAS unsigned char* lds) {
    GAS char* g_sink = (GAS char*)*(volatile LAS unsigned long long*)(lds + 143376);
    const int tid = otid(), lane = tid & 63, wave = tid >> 6, sub = lane & 7;
    LAS float* rtab = (LAS float*)lds;
    LAS float* gtab = (LAS float*)(lds + 8192);
    *(LAS f32x4*)(rtab + 4 * tid) = *(const GAS f32x4*)(rope + 4 * tid);
    if (tid < 128) gtab[tid] = tid < 64 ? qn[tid] : kn[tid - 64];
    __syncthreads();
    u32x4 xpre[10];
#pragma unroll
    for (int ii = 0; ii < 10; ++ii) { const int pr = (wave + 8 * ii) * 8 + (lane >> 3); const int r = pr / 10, hh = pr - r * 10; const bool isq = hh < 8;
        xpre[ii] = *(const GAS u32x4*)(P + (size_t)r * LDP + (isq ? C_QB + hh * 64 : C_KB + (hh - 8) * 64) + sub * 8); }
#pragma unroll
    for (int ii = 0; ii < 10; ++ii) { const int it = wave + 8 * ii; const int pr = it * 8 + (lane >> 3); const int r = pr / 10, hh = pr - r * 10; const bool isq = hh < 8;
        if (isq && !doq) continue;
        GAS bf16_t* xp = P + (size_t)r * LDP + (isq ? C_QB + hh * 64 : C_KB + (hh - 8) * 64) + sub * 8;
        const u32x4 xw = xpre[ii]; float x[8]; unpack8(xw, x);
        float ss = 0.f;
#pragma unroll
        for (int j = 0; j < 8; ++j) ss += x[j] * x[j];
        ss += __shfl_xor(ss, 1); ss += __shfl_xor(ss, 2); ss += __shfl_xor(ss, 4);
        const float rstd = rsqrtf(ss * (1.f / 64.f) + EPSV);
        const LAS float* gp = gtab + (isq ? 0 : 64) + sub * 8;
#pragma unroll
        for (int j = 0; j < 8; ++j) x[j] = x[j] * rstd * gp[j];
        if (t0 >= 0) { const int t = t0 + r; const int pos = (sub < 4) ? (t >> 6) : (t & 63); const LAS float* tb = rtab + (pos * 16 + 8 * (sub & 1)) * 2;
#pragma unroll
            for (int j = 0; j < 8; ++j) { const float o = __shfl_xor(x[j], 2); const float cs = tb[2 * j], sn = tb[2 * j + 1]; x[j] = (sub & 2) ? (o * sn + x[j] * cs) : (x[j] * cs - o * sn); } }
        if (isq) {
#pragma unroll
            for (int j = 0; j < 8; ++j) x[j] *= 0.125f * LOG2E; }
        *DST((GAS u32x4*)xp) = pack8(x);
    }
    __syncthreads();
}

DI void attn_item(GAS bf16_t* Q, const GAS bf16_t* Klat, const GAS bf16_t* Vlat, int qb, const GAS bf16_t* Kctx, const GAS bf16_t* Vctx, const GAS float* sink4, LAS unsigned char* lds, bool dry) {
    GAS char* g_sink = (GAS char*)*(volatile LAS unsigned long long*)(lds + 143376);
    const int tid = otid(), lane = tid & 63, wave = tid >> 6, fr = lane & 15, fq = lane >> 4;
    const int g = wave & 3, half = wave >> 2;
    LAS bf16_t* Ks0 = (LAS bf16_t*)lds;
    LAS bf16_t* Vt0 = (LAS bf16_t*)(lds + 9216);
    bf16x8 qf[4][2];
#pragma unroll
    for (int rt = 0; rt < 4; ++rt) { const GAS bf16_t* qp = Q + (size_t)(half * 64 + rt * 16 + fr) * LDP + g * 64 + fq * 8;
        qf[rt][0] = *(const GAS bf16x8*)qp; qf[rt][1] = *(const GAS bf16x8*)(qp + 32); }
    const float snk = sink4[g] * LOG2E;
    float mrow[4], lrow[4]; f32x4 O[4][4];
#pragma unroll
    for (int rt = 0; rt < 4; ++rt) { mrow[rt] = snk; lrow[rt] = (fq == 0) ? 1.f : 0.f;
#pragma unroll
        for (int dt = 0; dt < 4; ++dt) O[dt][rt] = (f32x4){0.f, 0.f, 0.f, 0.f}; }
    const int ntl = Klat ? 6 : 0, ntile = ntl + 4;
    const int kr = tid >> 3, kc = tid & 7;
    const int vtp = tid & 31, vcg = (tid >> 5) & 7;
    u32x4 kreg, v0reg, v1reg; int jn = 0;
    auto tile_valid = [&](int j) -> bool { if (j >= ntl) return true; const int kp0 = qb * 128 - 128 + 64 * j; return kp0 >= 0 && kp0 < SEQ; };
    auto tile_k = [&](int j) -> const GAS bf16_t* { return j < ntl ? Klat + (size_t)(qb * 128 - 128 + 64 * j) * LDP : Kctx + (size_t)((j - ntl) * 64) * LDP; };
    auto tile_v = [&](int j) -> const GAS bf16_t* { return j < ntl ? Vlat + (size_t)(qb * 128 - 128 + 64 * j) * LDP : Vctx + (size_t)((j - ntl) * 64) * LDP; };
    while (jn < ntile && !tile_valid(jn)) ++jn;
    { const GAS bf16_t* kp = tile_k(jn); const GAS bf16_t* vp = tile_v(jn);
      kreg = *(const GAS u32x4*)(kp + (size_t)kr * LDP + kc * 8);
      if (tid < 256) { v0reg = *(const GAS u32x4*)(vp + (size_t)(2 * vtp) * LDP + vcg * 8); v1reg = *(const GAS u32x4*)(vp + (size_t)(2 * vtp + 1) * LDP + vcg * 8); } }
    int pp = 0;
    while (jn < ntile) {
        const int j = jn;
        LAS bf16_t* Ks = Ks0 + pp * 9216; LAS bf16_t* Vt = Vt0 + pp * 9216; pp ^= 1;
        *(LAS u32x4*)(Ks + kr * 72 + kc * 8) = kreg;
        if (tid < 256) { LAS unsigned* dp = (LAS unsigned*)(Vt + (8 * vcg) * 72 + 2 * vtp);
#pragma unroll
            for (int i = 0; i < 4; ++i) { dp[(2 * i) * 36] = (v0reg[i] & 0xffffu) | (v1reg[i] << 16); dp[(2 * i + 1) * 36] = (v0reg[i] >> 16) | (v1reg[i] & 0xffff0000u); } }
        __syncthreads();
        ++jn; while (jn < ntile && !tile_valid(jn)) ++jn;
        if (jn < ntile && !(dry && (ATT_DRY_MODE & 2))) { const GAS bf16_t* kp = tile_k(jn); const GAS bf16_t* vp = tile_v(jn);
            kreg = *(const GAS u32x4*)(kp + (size_t)kr * LDP + kc * 8);
            if (tid < 256) { v0reg = *(const GAS u32x4*)(vp + (size_t)(2 * vtp) * LDP + vcg * 8); v1reg = *(const GAS u32x4*)(vp + (size_t)(2 * vtp + 1) * LDP + vcg * 8); } }
        const bool local = j < ntl;
        if (local && ((half == 0 && j == 5) || (half == 1 && j == 0))) continue;
        f32x4 S[4][4];
#pragma unroll
        for (int kt = 0; kt < 4; ++kt) { const LAS bf16_t* kp = Ks + (kt * 16 + fr) * 72 + fq * 8; const bf16x8 k0 = *(const LAS bf16x8*)kp, k1 = *(const LAS bf16x8*)(kp + 32);
#pragma unroll
            for (int rt = 0; rt < 4; ++rt) { f32x4 sv = (f32x4){0.f, 0.f, 0.f, 0.f}; sv = MFMA16(k0, qf[rt][0], sv); sv = MFMA16(k1, qf[rt][1], sv); S[rt][kt] = sv; } }
        if (dry && (ATT_DRY_MODE & 1)) { O[0][0] += S[0][0] + S[1][1] + S[2][2] + S[3][3]; continue; }
        if (local && (64 * j - 64 * half == 0 || 64 * j - 64 * half == 256)) { const int kk0 = -128 + 64 * j;
#pragma unroll
            for (int rt = 0; rt < 4; ++rt) { const int qq = half * 64 + rt * 16 + fr;
#pragma unroll
                for (int kt = 0; kt < 4; ++kt)
#pragma unroll
                    for (int e = 0; e < 4; ++e) { const int df = kk0 + kt * 16 + fq * 4 + e - qq; if (df < -128 || df > 128) S[rt][kt][e] = -INFINITY; } } }
        bf16x8 pb[4][2];
#pragma unroll
        for (int rt = 0; rt < 4; ++rt) { float mx = -INFINITY;
#pragma unroll
            for (int kt = 0; kt < 4; ++kt) mx = fmaxf(mx, fmaxf(fmaxf(S[rt][kt][0], S[rt][kt][1]), fmaxf(S[rt][kt][2], S[rt][kt][3])));
            mx = fmaxf(mx, __shfl_xor(mx, 16)); mx = fmaxf(mx, __shfl_xor(mx, 32));
            const float mnew = fmaxf(mrow[rt], mx), alpha = __builtin_amdgcn_exp2f(mrow[rt] - mnew); mrow[rt] = mnew;
            float ps = 0.f;
#pragma unroll
            for (int kt = 0; kt < 4; ++kt)
#pragma unroll
                for (int e = 0; e < 4; ++e) { const float pv = __builtin_amdgcn_exp2f(S[rt][kt][e] - mnew); S[rt][kt][e] = pv; ps += pv; }
            lrow[rt] = lrow[rt] * alpha + ps;
#pragma unroll
            for (int dt = 0; dt < 4; ++dt) O[dt][rt] = O[dt][rt] * alpha;
#pragma unroll
            for (int sidx = 0; sidx < 2; ++sidx) { u32x4 t; t.x = pk2(S[rt][2 * sidx][0], S[rt][2 * sidx][1]); t.y = pk2(S[rt][2 * sidx][2], S[rt][2 * sidx][3]); t.z = pk2(S[rt][2 * sidx + 1][0], S[rt][2 * sidx + 1][1]); t.w = pk2(S[rt][2 * sidx + 1][2], S[rt][2 * sidx + 1][3]);
                pb[rt][sidx] = __builtin_bit_cast(bf16x8, t); } }
#pragma unroll
        for (int dt = 0; dt < 4; ++dt)
#pragma unroll
            for (int sidx = 0; sidx < 2; ++sidx) { const LAS bf16_t* vp = Vt + (dt * 16 + fr) * 72 + 32 * sidx + 4 * fq;
                const u32x2 lo = *(const LAS u32x2*)vp, hi = *(const LAS u32x2*)(vp + 16);
                const u32x4 t = (u32x4){lo.x, lo.y, hi.x, hi.y}; const bf16x8 av = __builtin_bit_cast(bf16x8, t);
#pragma unroll
                for (int rt = 0; rt < 4; ++rt) O[dt][rt] = MFMA16(av, pb[rt][sidx], O[dt][rt]); }
    }
#pragma unroll
    for (int rt = 0; rt < 4; ++rt) { float l = lrow[rt]; l += __shfl_xor(l, 16); l += __shfl_xor(l, 32); const float inv = 1.f / l;
        GAS bf16_t* op = Q + (size_t)(half * 64 + rt * 16 + fr) * LDP + g * 64;
#pragma unroll
        for (int dt = 0; dt < 4; ++dt) { const f32x4 o = O[dt][rt] * inv; u32x2 w; w.x = pk2(o[0], o[1]); w.y = pk2(o[2], o[3]); *DST((GAS u32x2*)(op + dt * 16 + fq * 4)) = w; } }
    __syncthreads();
}

DI void phase_x1(const Args& a, int l, int hf, LAS unsigned char* lds, bool dry) {
    GAS bf16_t* PJ = (GAS bf16_t*)(AWS + WS_BIG);
    const int c0 = hf ? 32 : 0;
    const int nch = hf ? 256 : 288;
    const bool ctx_mix = (hf == 0 && l == 0);
    const int s0 = (hf == 0 && !ctx_mix) ? 16 : (hf ? 16 : 0);
    const int nsg = 144 - s0;
    const int n_sgu = nsg * 4, n_g1 = nch * 2, n_pp = nch;
    const GlaW gw{AIN(13) + l * 16 * 256, AIN(14) + l * 256, AIN(15) + l * 16 * 256, AIN(16) + l * 256};
    for (int it = blockIdx.x; it < n_sgu + n_g1 + n_pp; it += gridDim.x) {
        if (it < n_sgu) { const int ck = s0 + (it >> 2), g = it & 3;
            if (!dry || (DRYSEL & 1)) sgu_item(PJ + (size_t)ck * 128 * LDP, g, AIN(11) + (size_t)l * 4 * 128 * 128, AIN(12) + l * 512, AIN(10) + l * 512, lds, dry);
        } else if (it < n_sgu + n_g1) { const int r = it - n_sgu; const int cid = c0 + (r >> 1), hp = r & 1;
            if (!dry || (DRYSEL & 2)) gla_pass1_item(PJ + (size_t)cid * 64 * LDP, hp, (GAS bf16_t*)(AWS + WS_KV) + (size_t)cid * 65536, (GAS float*)(AWS + WS_DEC) + cid * 512, gw, lds, dry);
        } else { const int cid = c0 + (it - n_sgu - n_g1); const bool isctx = cid < 32;
            const int t0 = isctx ? -1 : (((cid - 32) * 64) & 4095);
            if (!dry || (DRYSEL & 4)) qkprep_item(PJ + (size_t)cid * 64 * LDP, t0, !isctx || l == 0, AIN(7) + l * 64, AIN(8) + l * 64, (const GAS float*)(AWS + WS_ROPE), dry, lds);
        }
    }
}

DI void phase_x2(const Args& a, int l, int hf, LAS unsigned char* lds, bool dry) {
    GAS bf16_t* PJ = (GAS bf16_t*)(AWS + WS_BIG);
    const int n_att_lat = 256, n_att_ctx = 0;
    const int n_scan = hf ? 128 : 256;
    const int n_att = n_att_lat + n_att_ctx;
    for (int it = blockIdx.x; it < n_att + n_scan; it += gridDim.x) {
        if (it < n_att_lat) { const int kh = it & 1, qb = (it >> 1) & 31, bl = it >> 6;
            const int b = hf * 4 + bl;
            GAS bf16_t* lat0 = PJ + (size_t)(NCTX + bl * SEQ) * LDP;
            const GAS bf16_t* cx0 = PJ + (size_t)(b * CTXL) * LDP;
            if (!dry || (DRYSEL & 1)) attn_item(lat0 + (size_t)(qb * 128) * LDP + C_QB + kh * 256, lat0 + C_KB + kh * 64, lat0 + C_VB + kh * 64, qb, cx0 + C_KB + kh * 64, cx0 + C_VB + kh * 64, AIN(9) + l * 8 + kh * 4, lds, dry);
        } else if (it < n_att) { const int r = it - n_att_lat; const int kh = r & 1, qb = (r >> 1) & 1, b = r >> 2;
            GAS bf16_t* cx0 = PJ + (size_t)(b * CTXL) * LDP;
            if (!dry || (DRYSEL & 1)) attn_item(cx0 + (size_t)(qb * 128) * LDP + C_QB + kh * 256, nullptr, nullptr, qb, cx0 + C_KB + kh * 64, cx0 + C_VB + kh * 64, AIN(9) + l * 8 + kh * 4, lds, dry);
        } else { const int r = it - n_att; const int slice = r & 15, d = (r >> 4) & 1, bb = r >> 5;
            if (!dry || (DRYSEL & 2)) gla_scan_item(a, hf, hf ? 4 + bb : bb, d, slice, dry);
        }
    }
}

DI void phase_x3(const Args& a, int l, int hf, LAS unsigned char* lds, bool dry) {
    GAS bf16_t* PJ = (GAS bf16_t*)(AWS + WS_BIG);
    const int c0 = (hf == 0 && l == 0) ? 0 : 32;
    const int nch = 288 - c0;
    const GlaW gw{AIN(13) + l * 16 * 256, AIN(14) + l * 256, AIN(15) + l * 16 * 256, AIN(16) + l * 256};
    for (int it = blockIdx.x; it < nch * 2; it += gridDim.x) { const int cid = c0 + (it >> 1), hp = it & 1;
        gla_pass3_item(PJ + (size_t)cid * 64 * LDP, hp, (const GAS bf16_t*)(AWS + WS_KV) + (size_t)cid * 65536, gw, AIN(17) + l * 128, lds, dry); }
    if (hf == 0 && l == 0 && (int)blockIdx.x >= (int)gridDim.x - 32) {
        const int r = (int)blockIdx.x - ((int)gridDim.x - 32); const int kh = r & 1, qb = (r >> 1) & 1, b = r >> 2;
        GAS bf16_t* cx0 = PJ + (size_t)(b * CTXL) * LDP;
        attn_item(cx0 + (size_t)(qb * 128) * LDP + C_QB + kh * 256, nullptr, nullptr, qb, cx0 + C_KB + kh * 64, cx0 + C_VB + kh * 64, AIN(9) + l * 8 + kh * 4, lds, dry); }
}


#define XB_TMO      128
#define XB_XCNT(j)  (256  + 64 * (j))
#define XB_XSUB(j)  (1280 + 64 * (j))
#define XB_XGEN(j)  (2304 + 64 * (j))
#define XB_TOP      3328
#define XB_TOPGEN   3392
#define XCD_BAR_WORDS 3456
#define XB_SPIN_CAP (1u << 18)
DI unsigned xb_ld(unsigned* p)              { return __hip_atomic_load(p, __ATOMIC_RELAXED, __HIP_MEMORY_SCOPE_AGENT); }
DI unsigned xb_add(unsigned* p, unsigned v) { return __hip_atomic_fetch_add(p, v, __ATOMIC_RELAXED, __HIP_MEMORY_SCOPE_AGENT); }
DI unsigned xb_xcc_id() { return (unsigned)__builtin_amdgcn_s_getreg((3 << 11) | 20) & 0xFu; }
#define XB_SPIN(cond, bar) do { unsigned _sp = 0; while (cond) { __builtin_amdgcn_s_sleep(1); \
    if ((++_sp & 255u) == 0u) { if (xb_ld(&(bar)[XB_TMO])) break; if (_sp > XB_SPIN_CAP) { atomicAdd(&(bar)[XB_TMO], 1u); break; } } } } while (0)
struct XcdBarrier { unsigned* bar; unsigned x; volatile LAS unsigned* st; };
DI XcdBarrier xcd_barrier_post(unsigned* bar, volatile LAS unsigned* st) {
    XcdBarrier b; b.bar = bar; b.x = xb_xcc_id(); b.st = st;
    if (threadIdx.x == 0) (void)xb_add(&bar[XB_XCNT(b.x)], 1u);
    return b;
}
DI void xcd_barrier_complete(unsigned* bar, unsigned x, unsigned& nloc, unsigned& nx) {
    const unsigned G = gridDim.x * gridDim.y * gridDim.z;
    unsigned sum, cnt, mine, sp = 0u;
    for (;;) {
        sum = 0u; cnt = 0u; mine = 0u;
#pragma unroll
        for (unsigned j = 0; j < 16; ++j) { const unsigned c = xb_ld(&bar[XB_XCNT(j)]); sum += c; cnt += (c > 0u) ? 1u : 0u; mine = (j == x) ? c : mine; }
        if (sum == G) break;
        __builtin_amdgcn_s_sleep(1);
        if ((++sp & 255u) == 0u) { if (xb_ld(&bar[XB_TMO])) break; if (sp > XB_SPIN_CAP) { atomicAdd(&bar[XB_TMO], 1u); break; } }
    }
    nloc = mine > 0u ? mine : 1u; nx = cnt > 0u ? cnt : 1u;
}
template <int NOFENCE = 0> DI void xcd_barrier(const XcdBarrier& b) {
    asm volatile("s_waitcnt vmcnt(0)" ::: "memory");
    __syncthreads();
    if (threadIdx.x == 0) {
        unsigned* bar = b.bar;
        __builtin_amdgcn_s_waitcnt(0);
        unsigned nloc = b.st[0], nx = b.st[1]; const unsigned round = b.st[2];
        if (nloc == 0u) { xcd_barrier_complete(bar, b.x, nloc, nx); b.st[0] = nloc; b.st[1] = nx; }
        b.st[2] = round + 1u;
        const unsigned old = xb_add(&bar[XB_XSUB(b.x)], 1u);
        if (old + 1u == (round + 1u) * nloc) {
            __builtin_amdgcn_fence(__ATOMIC_RELEASE, "agent");
            asm volatile("s_waitcnt vmcnt(0)" ::: "memory");
            const unsigned og = xb_add(&bar[XB_TOP], 1u);
            if (og + 1u == (round + 1u) * nx) xb_add(&bar[XB_TOPGEN], 1u);
        }
        XB_SPIN(xb_ld(&bar[XB_TOPGEN]) == round, bar);
        __builtin_amdgcn_fence(__ATOMIC_ACQUIRE, "agent");
        asm volatile("s_waitcnt vmcnt(0)" ::: "memory");
    }
    __syncthreads();
}

constexpr int NPHASE = 31;
#ifndef DBG_N
#define DBG_N NPHASE
#endif
#ifndef DBG_NELEM
#define DBG_NELEM 0
#endif
#ifndef DBG_OFF
#define DBG_OFF 0
#endif
#ifndef DBG_F32
#define DBG_F32 0
#endif
#ifndef DBG_NELEM2
#define DBG_NELEM2 0
#endif
#ifndef DBG_OFF2
#define DBG_OFF2 0
#endif
#ifndef PHM
#define PHM 0xFFFF
#endif

DI void run_phase(const Args& a, int ph, LAS unsigned char* lds, bool dry) {
    if (ph == 0) { if (PHM & 1) phase_prologue(a, lds); return; }
    const int l = (ph - 1) / 15, q = (ph - 1) % 15;
    GAS GAS unsigned char* wt = AWS + WS_WT + (size_t)l * WT_LAYER;
    const int G = gridDim.x, cidx = blockIdx.x;
    const GAS float* MOD = (const GAS float*)(AWS + WS_MOD);
    if (q == 0) { if (PHM & 2) phase_modulate(a, l, 0, 0); return; }
    if (q >= 1 && q <= 10) {
        const int hf = (q - 1) / 5, k = (q - 1) % 5;
        const int rowshift = hf ? HALF_ROWS : 0;
        if (k == 0) { if (PHM & 4) {
            pg8::Gemm g{(const GAS char*)(AWS + WS_H) + (size_t)rowshift * DM * 2, (const GAS char*)(wt + WT_IN), DM, DM, DM, 0, 0, 0, 0};
            pg8::EpiProj E{(GAS bf16_t*)(AWS + WS_BIG), 0};
            const int prune = (l == 1 && hf == 0) ? 1 : 0;
            for (int part = 0; part <= prune; ++part) {
                pg8::Order S;
                if (part == 0) S.init((hf || prune) ? 8 : 0, (hf || prune) ? 64 : 72, NPAD / 256, 1, G, cidx);
                else S.init(0, 8, NPAD / 256, 1, G, cidx, 2);
                pg8::gemm_phase<pg8::EpiProj>(lds, g, S, E); } }
        } else if (k == 1) { if (PHM & 8) phase_x1(a, l, hf, lds, dry); }
        else if (k == 2) { if (PHM & 16) phase_x2(a, l, hf, lds, dry); }
        else if (k == 3) { if (PHM & 32) phase_x3(a, l, hf, lds, dry); }
        else if (PHM & 64) {
            const bool withctx = (hf == 0 && l == 0);
            pg8::Gemm g{(const GAS char*)(AWS + WS_BIG), (const GAS char*)(wt + WT_BR), LDP, 512, 512, C_U * 2, (C_QB - C_U) * 2, (C_RC - 2 * C_QB + C_U) * 2, 1024 * 512 * 2};
            pg8::Order S; S.init(withctx ? 0 : 8, withctx ? 72 : 64, 4, 3, G, cidx);
            pg8::EpiMerge E{(const GAS bf16_t*)(AWS + WS_BIG), 0, (GAS bf16_t*)(AWS + WS_H) + (size_t)rowshift * DM};
            pg8::gemm_phase<pg8::EpiMerge>(lds, g, S, E);
        }
        return;
    }
    const int pm0 = (l == 0) ? 0 : 8, nM = 136 - pm0;
    if (q == 11) { if (PHM & 128) {
        pg8::Gemm g{(const GAS char*)(AWS + WS_H), (const GAS char*)(wt + WT_O), DM, DM, DM, 0, 0, 0, 0};
        pg8::Order S; S.init(pm0, nM, 4, 1, G, cidx);
        pg8::EpiResid E{l == 0 ? AIN(2) : (const GAS float*)(AWS + WS_CTXBUF), l == 0 ? AIN(0) : (const GAS float*)AOUT, (GAS float*)(AWS + WS_CTXBUF), AOUT, MOD + (size_t)(l * 9) * 6144 + 2 * 1024};
        pg8::gemm_phase<pg8::EpiResid>(lds, g, S, E); }
    } else if (q == 12) { if (PHM & 2) phase_modulate(a, l, 1, pm0 * 256);
    } else if (q == 13) { if (PHM & 256) {
        pg8::Gemm g{(const GAS char*)(AWS + WS_H), (const GAS char*)(wt + WT_F1), DM, DM, DM, 0, 0, 0, 0};
        pg8::Order S; S.init(pm0, nM, 16, 1, G, cidx);
        pg8::EpiFF1 E{(GAS bf16_t*)(AWS + WS_BIG)};
        pg8::gemm_phase<pg8::EpiFF1>(lds, g, S, E); }
    } else if (PHM & 512) {
        { pg8::Gemm g{(const GAS char*)(AWS + WS_BIG), (const GAS char*)(wt + WT_F2), FF, FF, FF, 0, 0, 0, 0};
          pg8::Order S; S.init(8, 128, 4, 1, G, cidx);
          pg8::EpiResid E{(const GAS float*)(AWS + WS_CTXBUF), (const GAS float*)AOUT, (GAS float*)(AWS + WS_CTXBUF), AOUT, MOD + (size_t)(l * 9) * 6144 + 5 * 1024};
          pg8::gemm_phase<pg8::EpiResid>(lds, g, S, E); }
        if (l == 0) {
          pg8::Gemm g{(const GAS char*)(AWS + WS_BIG), (const GAS char*)(wt + WT_F2), FF, FF, 1024, 0, 2048, 0, 2048};
          pg8::Order S; S.init(0, 8, 4, 4, G, cidx, 1);
          pg8::EpiPartial E{(GAS float*)(AWS + WS_PART), MOD + (size_t)(l * 9) * 6144 + 5 * 1024};
          pg8::gemm_phase<pg8::EpiPartial>(lds, g, S, E); }
    }
}

__global__ void __launch_bounds__(512, 2) mega_fwd(Args a) {
    extern __shared__ __attribute__((aligned(16))) unsigned char lds_raw[];
    LAS unsigned char* lds = (LAS unsigned char*)lds_raw;
    cg::grid_group grid = cg::this_grid();
    volatile LAS unsigned* misc = (volatile LAS unsigned*)(lds + 143360);
    if (threadIdx.x < 4) misc[threadIdx.x] = 0u;
    if (threadIdx.x == 0) *(volatile LAS unsigned long long*)(lds + 143376) = (unsigned long long)(AWS + WS_PART);
    __syncthreads();
    XcdBarrier bar = xcd_barrier_post((unsigned*)AWS + 4096, misc);
    if (a.ph_lo < 0) grid.sync();
    for (int ph = a.ph_lo; ph < a.ph_hi; ++ph) {
        Args b = a; int phv = ph;
        asm volatile("" : "+s"(b.ws), "+s"(b.out), "+s"(phv));
        int nrep = 1, drymatch = 0;
        if (DRYMASK && phv > 0) { const int q_ = (phv - 1) % 15; const int k_ = (q_ >= 1 && q_ <= 10) ? (q_ - 1) % 5 : 0;
            if (k_ >= 1 && k_ <= 3 && ((DRYMASK >> (k_ - 1)) & 1)) { nrep = 2; drymatch = 1; } }
        if (DUPMASK) { const int q_ = (phv - 1) % 15; bool dup = false;
            if (phv > 0) { if ((DUPMASK & 1) && (q_ == 1 || q_ == 6)) dup = true; if ((DUPMASK & 2) && q_ == 13) dup = true; if ((DUPMASK & 4) && (q_ == 0 || q_ == 12)) dup = true; if ((DUPMASK & 8) && (q_ == 5 || q_ == 10)) dup = true; }
            else if (DUPMASK & 16) dup = true;
            if (dup) nrep = 2; }
        nrep = __builtin_amdgcn_readfirstlane(nrep); drymatch = __builtin_amdgcn_readfirstlane(drymatch);
        for (int rep = 0; rep < nrep; ++rep) {
            run_phase(b, phv, lds, drymatch != 0 && rep == 0);
            if (rep + 1 < nrep) xcd_barrier(bar);
        }
        if (ph + 1 < a.ph_hi) { xcd_barrier(bar); if (DBL_BAR) xcd_barrier(bar); }
    }
    if (DBG_NELEM > 0) {
        xcd_barrier(bar);
        for (size_t i = (size_t)blockIdx.x * 512 + threadIdx.x; i < (size_t)NLAT * DM; i += (size_t)gridDim.x * 512) {
            float v = DBG_F32 ? ((const GAS float*)(AWS + (size_t)DBG_OFF))[i % (size_t)DBG_NELEM] : bf2f(((const GAS bf16_t*)(AWS + (size_t)DBG_OFF))[i % (size_t)DBG_NELEM]);
            if (DBG_NELEM2 > 0) v += bf2f(((const GAS bf16_t*)(AWS + (size_t)DBG_OFF2))[i % (size_t)DBG_NELEM2]);
            AOUT[i] = v; }
    }
}

extern "C" void kernel_launch(void* const* d_in, const int* in_sizes, int n_in, void* d_out, int out_size, void* d_ws, size_t ws_size, hipStream_t stream) {
    static int grid = 0;
    if (grid == 0) {
        int dev = 0, cus = 0, per_cu = 0;
        hipGetDevice(&dev);
        hipDeviceGetAttribute(&cus, hipDeviceAttributeMultiprocessorCount, dev);
        hipFuncSetAttribute((const void*)mega_fwd, hipFuncAttributeMaxDynamicSharedMemorySize, LDS_BYTES);
        hipOccupancyMaxActiveBlocksPerMultiprocessor(&per_cu, (const void*)mega_fwd, 512, LDS_BYTES);
        (void)hipGetLastError();
        if (per_cu < 1) per_cu = 1;
        grid = cus * 1;
        if (ws_size < WS_END) fprintf(stderr, "kernel_launch: workspace too small: %zu < %zu\n", ws_size, (size_t)WS_END);
        if (n_in != 22) fprintf(stderr, "kernel_launch: expected 22 inputs, got %d\n", n_in);
    }
    if (hipMemsetAsync(d_ws, 0, 65536, stream) != hipSuccess) fprintf(stderr, "kernel_launch: memset failed\n");
    Args a{};
    for (int i = 0; i < 22; ++i) a.in[i] = (const float*)d_in[i];
    a.out = (float*)d_out; a.ws = (unsigned char*)d_ws; a.ph_lo = 0; a.ph_hi = DBG_N;
    void* args[] = {&a};
    hipError_t e = hipLaunchCooperativeKernel((const void*)mega_fwd, dim3(grid), dim3(512), args, LDS_BYTES, stream);
    if (e != hipSuccess) fprintf(stderr, "cooperative launch failed: %s (grid %d)\n", hipGetErrorString(e), grid);
}
```

```cpp
#include <hip/hip_runtime.h>
#include <hip/hip_cooperative_groups.h>
#include <cstdio>
#include <cstdint>
namespace cg = cooperative_groups;

#define DI __device__ __forceinline__
#define LAS __attribute__((address_space(3)))
#define GAS __attribute__((address_space(1)))
#define AIN(k) ((const GAS float*)a.in[k])
#define AOUT ((GAS float*)a.out)
#define AWS ((GAS unsigned char*)a.ws)
typedef unsigned short bf16_t;
typedef short bf16x8 __attribute__((ext_vector_type(8)));
typedef float f32x4 __attribute__((ext_vector_type(4)));
typedef unsigned u32x4 __attribute__((ext_vector_type(4)));
typedef unsigned u32x2 __attribute__((ext_vector_type(2)));

#define DST(p) (dry ? (decltype(p))(g_sink + ((size_t)(p) & 0xFFFFF0u)) : (p))
#ifndef DBL_BAR
#define DBL_BAR 0
#endif
#ifndef DRY_NOFENCE
#define DRY_NOFENCE 0
#endif
#ifndef P1_DRY_MODE
#define P1_DRY_MODE 0
#endif
#ifndef ATT_DRY_MODE
#define ATT_DRY_MODE 0
#endif
#ifndef DRYSEL
#define DRYSEL 7
#endif
#ifndef DRYMASK
#define DRYMASK 0
#endif
#ifndef DUPMASK
#define DUPMASK 0
#endif
#ifndef X1MASK
#define X1MASK 7
#endif
constexpr int DM = 1024, NB = 8, SEQ = 4096, CTXL = 256;
constexpr int NCTX = NB * CTXL;
constexpr int NLAT = NB * SEQ;
constexpr int NROW = NCTX + NLAT;
constexpr int LDP = 6432;
constexpr int NPAD = 6656;
constexpr int FF = 4096;
constexpr int C_U = 0, C_VA = 512, C_QB = 1024, C_KB = 1536, C_VB = 1664, C_QC = 1792, C_KC = 2048, C_VC = 2304, C_RC = 2816, C_ZF = 3328, C_ZB = 3344, C_G = 3360;
constexpr int HALF_ROWS = 16384;
constexpr float EPSV = 1e-6f;
constexpr float LOG2E = 1.4426950408889634f;

constexpr size_t MiB = 1u << 20;
constexpr size_t WS_ROPE = 1 * MiB;
constexpr size_t WS_MOD = 1 * MiB + 65536;
constexpr size_t WS_CTXST = 2 * MiB;
constexpr size_t WS_DEC = 4 * MiB;
constexpr size_t WS_WT = 8 * MiB;
constexpr size_t WT_LAYER = 34 * MiB;
constexpr size_t WT_IN = 0;
constexpr size_t WT_BR = (size_t)NPAD * 1024 * 2;
constexpr size_t WT_O = WT_BR + 3u * 1024 * 512 * 2;
constexpr size_t WT_F1 = WT_O + 1024u * 1024 * 2;
constexpr size_t WT_F2 = WT_F1 + 4096u * 1024 * 2;
constexpr size_t WS_CTXBUF = 76 * MiB;
constexpr size_t WS_H = 84 * MiB;
constexpr size_t WS_KV = 152 * MiB;
constexpr size_t WS_BIG = 188 * MiB;
constexpr size_t WS_PART = 460 * MiB;
constexpr size_t WS_END = 492 * MiB;
static_assert(WT_F2 + 1024u * 4096 * 2 <= WT_LAYER, "wt");

constexpr int LDS_BYTES = 147456;

struct Args { const float* in[22]; float* out; unsigned char* ws; int ph_lo, ph_hi; };

DI int otid() { int t = threadIdx.x; asm volatile("" : "+v"(t)); return t; }
DI int obid() { int t = blockIdx.x; asm volatile("" : "+s"(t)); return t; }
DI float bf2f(unsigned short h) { return __uint_as_float((unsigned)h << 16); }
DI unsigned f2bf(float f) { unsigned u = __float_as_uint(f); return (u + 0x7fffu + ((u >> 16) & 1u)) >> 16; }
typedef __bf16 bf16x2_t __attribute__((ext_vector_type(2)));
typedef float f32x2_t __attribute__((ext_vector_type(2)));
DI unsigned pk2(float lo, float hi) { f32x2_t v = {lo, hi}; bf16x2_t b = __builtin_convertvector(v, bf16x2_t); return __builtin_bit_cast(unsigned, b); }
DI void unpack8(const u32x4 w, float* f) {
#pragma unroll
    for (int i = 0; i < 4; ++i) { f[2 * i] = __uint_as_float(w[i] << 16); f[2 * i + 1] = __uint_as_float(w[i] & 0xffff0000u); }
}
DI u32x4 pack8(const float* f) { u32x4 w; w.x = pk2(f[0], f[1]); w.y = pk2(f[2], f[3]); w.z = pk2(f[4], f[5]); w.w = pk2(f[6], f[7]); return w; }
template <int CTRL, int RM> DI float dpp_f(float x) { return __builtin_bit_cast(float, __builtin_amdgcn_update_dpp(0, __builtin_bit_cast(int, x), CTRL, RM, 0xF, false)); }
DI float wave_sum(float v) {
#pragma unroll
    for (int o = 1; o < 64; o <<= 1) v += __shfl_xor(v, o);
    return v;
}
DI float sum8(float v) {
    v += dpp_f<0xB1, 0xF>(v); v += dpp_f<0x4E, 0xF>(v); v += dpp_f<0x141, 0xF>(v); return v;
}
DI float frcp(float x) { return __builtin_amdgcn_rcpf(x); }
DI float gelu_tanh(float x) { const float y = 0.7978845608028654f * (x + 0.044715f * x * x * x); return x * (1.f - frcp(1.f + __expf(2.f * y))); }
DI float log_sigmoid(float x) { return fminf(x, 0.f) - 0.6931471805599453f * __builtin_amdgcn_logf(1.f + __builtin_amdgcn_exp2f(-1.4426950408889634f * fabsf(x))); }
#define MFMA16(a, b, c) __builtin_amdgcn_mfma_f32_16x16x32_bf16((a), (b), (c), 0, 0, 0)

namespace pg8 {
constexpr int BM = 256, BK = 64, HALF = 128, HTB = HALF * BK * 2, STAGE_BYTES = 8 * HTB, NXCD = 8, WGM = 8;
DI int lds_byte(int r, int c) { const int st = (r >> 4) * 2 + (c >> 5), rr = r & 15, cc = c & 31, ob = rr * 64 + cc * 2; return st * 1024 + (ob ^ (((ob >> 9) & 1) << 5)); }
DI void stage_rc(int b, int& R, int& C) { const int st = b / 1024, sb = b % 1024, swz = sb ^ (((sb >> 9) & 1) << 5); R = (st >> 1) * 16 + swz / 64; C = (st & 1) * 32 + (swz % 64) / 2; }
DI int perm32(int rho) { const int n = rho >> 4, i = rho & 15; return 8 * (i >> 2) + 4 * n + (i & 3); }

struct Unit { int pm, pn, z; };
struct Gemm { const GAS char* A; const GAS char* Bt; int lda, ldb, K; int zA0, dA1, dA2, dB;
    DI size_t za(int z) const { return (size_t)(zA0 + z * dA1 + (z >> 1) * dA2); }
    DI size_t zb(int z) const { return (size_t)z * (size_t)dB; } };

struct Order {
    int pm0, nM, nN, nwg, G, c, nz, spread;
    DI void init(int pm0_, int nM_, int nN_, int nz_, int G_, int c_, int spread_ = 0) { pm0 = pm0_; nM = nM_; nN = nN_; nwg = nM * nN; G = G_; c = c_; nz = nz_; spread = spread_; }
    DI bool next(int i, Unit& u) const {
        if (spread == 2) {
            const int cc = c - 128; if (cc < 0) return false;
            const long L = (long)i * G + cc; if (L >= 40) return false;
            const int t = (int)L, k = t % 5; u.pm = t / 5; u.pn = 6 + k + (k > 0 ? 1 : 0) + (k == 4 ? 2 : 0); u.z = 0; return true; }
        if (spread) {
            const long L = (long)i * G + c; if (L >= (long)nwg * nz) return false;
            const int t = (int)(L / nz); u.z = (int)(L - (long)t * nz); u.pm = pm0 + t / nN; u.pn = t % nN; return true; }
        const int ti = i / nz; const int z = i - ti * nz;
        const long L = (long)ti * G + c; if (L >= nwg) return false;
        int wgid = (int)L; { const int q = nwg / NXCD, r = nwg % NXCD, xcd = wgid % NXCD, off = wgid / NXCD; wgid = (xcd < r ? xcd * (q + 1) : r * (q + 1) + (xcd - r) * q) + off; }
        const int nig = WGM * nN, gid = wgid / nig, fm = gid * WGM, gsz = (nM - fm) < WGM ? (nM - fm) : WGM;
        u.pm = pm0 + fm + ((wgid % nig) % gsz); u.pn = (wgid % nig) / gsz; u.z = z; return true;
    }
};

template <class Epi>
DI void gemm_phase(LAS unsigned char* lds, const Gemm g, const Order& S, const Epi& E) {
    const int tid = otid(), wid = __builtin_amdgcn_readfirstlane(tid >> 6), lane = tid & 63, wr = wid >> 2, wc = wid & 3, fr = lane & 15, fq = lane >> 4;
    const int nt = g.K / BK;
    unsigned voffA[2], voffB[2];
#pragma unroll
    for (int i = 0; i < 2; ++i) { int R, C; stage_rc(tid * 16 + i * 8192, R, C); const int Rb = (R & ~31) + perm32(R & 31);
        voffA[i] = (unsigned)(R * g.lda + C) * 2u; voffB[i] = (unsigned)(Rb * g.ldb + C) * 2u; }
    const size_t kstep = (size_t)(BK * 2);
    const size_t hstepA = (size_t)HALF * g.lda * 2, hstepB = (size_t)HALF * g.ldb * 2;
    const size_t tstepA = 2 * hstepA, tstepB = 2 * hstepB;
    const unsigned ldsw = (unsigned)wid * 1024u;
    const int aoff = lds_byte(wr * 64 + fr, fq * 8), boff = lds_byte(wc * 32 + fr, fq * 8);
#define PG8_SA(b, h) (((b) * 2 + (h)) * HTB)
#define PG8_SB(b, h) ((4 + (b) * 2 + (h)) * HTB)
#define PG8_STAGE(bufoff, gbase, voff) do { _Pragma("unroll") for (int _i = 0; _i < 2; ++_i) \
        __builtin_amdgcn_global_load_lds((const unsigned*)((const GAS char*)(gbase) + (voff)[_i]), (LAS unsigned*)(lds + (bufoff) + ldsw + _i * 8192), 16, 0, 0); } while (0)
#define PG8_LDA(dst, b, h) do { _Pragma("unroll") for (int m = 0; m < 4; ++m) _Pragma("unroll") for (int k = 0; k < 2; ++k) dst[m][k] = *(const LAS bf16x8*)(lds + PG8_SA(b, h) + aoff + m * 2048 + k * 1024); } while (0)
#define PG8_LDB(dst, b, h) do { _Pragma("unroll") for (int n = 0; n < 2; ++n) _Pragma("unroll") for (int k = 0; k < 2; ++k) dst[n][k] = *(const LAS bf16x8*)(lds + PG8_SB(b, h) + boff + n * 2048 + k * 1024); } while (0)
#define PG8_MMA(ai, bj, At, Bt) do { __builtin_amdgcn_s_setprio(1); _Pragma("unroll") for (int m = 0; m < 4; ++m) _Pragma("unroll") for (int n = 0; n < 2; ++n) _Pragma("unroll") for (int k = 0; k < 2; ++k) \
        acc[ai][bj][m][n] = __builtin_amdgcn_mfma_f32_16x16x32_bf16(Bt[n][k], At[m][k], acc[ai][bj][m][n], 0, 0, 0); __builtin_amdgcn_s_setprio(0); } while (0)
#define PG8_WAIT_V(n) asm volatile("s_waitcnt vmcnt(" #n ")" ::: "memory")
#define PG8_WAIT_L(n) asm volatile("s_waitcnt lgkmcnt(" #n ")" ::: "memory")
#define PG8_BAR __builtin_amdgcn_s_barrier()
#define PG8_SCHED __builtin_amdgcn_sched_barrier(0)
    Unit cur, nxt; int ui = 0;
    if (!S.next(0, cur)) return;
    f32x4 acc[2][2][4][2];
#pragma unroll
    for (int a = 0; a < 2; ++a)
#pragma unroll
        for (int b = 0; b < 2; ++b)
#pragma unroll
            for (int m = 0; m < 4; ++m)
#pragma unroll
                for (int n = 0; n < 2; ++n) acc[a][b][m][n] = (f32x4){0.f, 0.f, 0.f, 0.f};
    bf16x8 At[4][2], B0[2][2], B1[2][2];
    const GAS char* cA = g.A + (size_t)cur.pm * tstepA + g.za(cur.z); const GAS char* cB = g.Bt + (size_t)cur.pn * tstepB + g.zb(cur.z);
    PG8_STAGE(PG8_SB(0, 0), cB, voffB); PG8_STAGE(PG8_SB(0, 1), cB + hstepB, voffB); PG8_STAGE(PG8_SA(0, 0), cA, voffA); PG8_STAGE(PG8_SA(0, 1), cA + hstepA, voffA);
    if (wr == 1) PG8_BAR;
    PG8_WAIT_V(2); PG8_BAR;
    PG8_STAGE(PG8_SB(1, 0), cB + kstep, voffB); PG8_STAGE(PG8_SA(1, 0), cA + kstep, voffA); PG8_STAGE(PG8_SB(1, 1), cB + hstepB + kstep, voffB);
    PG8_WAIT_V(6); PG8_BAR;
    for (;;) {
        const bool has_next = S.next(ui + 1, nxt);
        const GAS char* nA = has_next ? g.A + (size_t)nxt.pm * tstepA + g.za(nxt.z) : cA; const GAS char* nB = has_next ? g.Bt + (size_t)nxt.pn * tstepB + g.zb(nxt.z) : cB;
        for (int t = 0; t < nt; t += 2) {
            const bool last = (t == nt - 2);
            const GAS char* a1 = cA + (size_t)(t + 1) * kstep;
            const GAS char* a2 = last ? nA : cA + (size_t)(t + 2) * kstep; const GAS char* b2 = last ? nB : cB + (size_t)(t + 2) * kstep;
            const GAS char* a3 = a2 + kstep; const GAS char* b3 = b2 + kstep;
            PG8_LDB(B0, 0, 0); PG8_LDB(B1, 0, 1); PG8_SCHED; PG8_LDA(At, 0, 0); PG8_STAGE(PG8_SA(1, 1), a1 + hstepA, voffA);
            PG8_WAIT_V(8); PG8_WAIT_L(0); PG8_BAR; PG8_MMA(0, 0, At, B0); PG8_MMA(0, 1, At, B1); PG8_BAR; PG8_SCHED;
            PG8_LDA(At, 0, 1); PG8_STAGE(PG8_SB(0, 0), b2, voffB); PG8_STAGE(PG8_SB(0, 1), b2 + hstepB, voffB); PG8_STAGE(PG8_SA(0, 0), a2, voffA);
            PG8_WAIT_V(8); PG8_WAIT_L(0); PG8_BAR; PG8_MMA(1, 0, At, B0); PG8_MMA(1, 1, At, B1); PG8_BAR; PG8_SCHED;
            PG8_LDB(B0, 1, 0); PG8_LDB(B1, 1, 1); PG8_SCHED; PG8_LDA(At, 1, 0); PG8_STAGE(PG8_SA(0, 1), a2 + hstepA, voffA);
            PG8_WAIT_V(8); PG8_WAIT_L(0); PG8_BAR; PG8_MMA(0, 0, At, B0); PG8_MMA(0, 1, At, B1); PG8_BAR; PG8_SCHED;
            PG8_LDA(At, 1, 1); PG8_STAGE(PG8_SB(1, 0), b3, voffB); PG8_STAGE(PG8_SB(1, 1), b3 + hstepB, voffB); PG8_STAGE(PG8_SA(1, 0), a3, voffA);
            PG8_WAIT_V(8); PG8_WAIT_L(0); PG8_BAR; PG8_MMA(1, 0, At, B0); PG8_MMA(1, 1, At, B1); PG8_BAR; PG8_SCHED;
        }
        if (wr == 0) PG8_BAR;
        E(acc, cur, wr, wc, fr, fq);
        if (!has_next) break;
#pragma unroll
        for (int a = 0; a < 2; ++a)
#pragma unroll
            for (int b = 0; b < 2; ++b)
#pragma unroll
                for (int m = 0; m < 4; ++m)
#pragma unroll
                    for (int n = 0; n < 2; ++n) acc[a][b][m][n] = (f32x4){0.f, 0.f, 0.f, 0.f};
        cur = nxt; cA = nA; cB = nB; ++ui;
        if (wr == 1) PG8_BAR;
    }
    PG8_WAIT_V(0);
    PG8_BAR;
#undef PG8_SA
#undef PG8_SB
#undef PG8_STAGE
#undef PG8_LDA
#undef PG8_LDB
#undef PG8_MMA
#undef PG8_WAIT_V
#undef PG8_WAIT_L
#undef PG8_BAR
#undef PG8_SCHED
}

struct EpiProj {
    GAS bf16_t* O; int rowshift;
    DI void operator()(const f32x4 (&acc)[2][2][4][2], const Unit& u, int wr, int wc, int fr, int fq) const {
        const int row0 = u.pm * BM + wr * 64 + fr - rowshift, col0 = u.pn * BM + wc * 32 + 8 * fq;
#pragma unroll
        for (int ai = 0; ai < 2; ++ai)
#pragma unroll
            for (int m = 0; m < 4; ++m) { GAS bf16_t* rowp = O + (size_t)(row0 + ai * HALF + m * 16) * LDP + col0;
#pragma unroll
                for (int bj = 0; bj < 2; ++bj) { if (col0 + bj * HALF < LDP) { const f32x4 v0 = acc[ai][bj][m][0], v1 = acc[ai][bj][m][1];
                    u32x4 w; w.x = pk2(v0[0], v0[1]); w.y = pk2(v0[2], v0[3]); w.z = pk2(v1[0], v1[1]); w.w = pk2(v1[2], v1[3]);
                    *(GAS u32x4*)(rowp + bj * HALF) = w; } } }
    }
};
struct EpiFF1 {
    GAS bf16_t* O;
    DI void operator()(const f32x4 (&acc)[2][2][4][2], const Unit& u, int wr, int wc, int fr, int fq) const {
        const int row0 = u.pm * BM + wr * 64 + fr, col0 = u.pn * BM + wc * 32 + 8 * fq;
#pragma unroll
        for (int ai = 0; ai < 2; ++ai)
#pragma unroll
            for (int m = 0; m < 4; ++m) { GAS bf16_t* rowp = O + (size_t)(row0 + ai * HALF + m * 16) * FF + col0;
#pragma unroll
                for (int bj = 0; bj < 2; ++bj) { f32x4 v0 = acc[ai][bj][m][0], v1 = acc[ai][bj][m][1];
#pragma unroll
                    for (int e = 0; e < 4; ++e) { const float a = fmaxf(v0[e], 0.f), b = fmaxf(v1[e], 0.f); v0[e] = a * a; v1[e] = b * b; }
                    u32x4 w; w.x = pk2(v0[0], v0[1]); w.y = pk2(v0[2], v0[3]); w.z = pk2(v1[0], v1[1]); w.w = pk2(v1[2], v1[3]);
                    *(GAS u32x4*)(rowp + bj * HALF) = w; } }
    }
};
struct EpiMerge {
    const GAS bf16_t* P; int rowshift; GAS bf16_t* Mg;
    DI void operator()(const f32x4 (&acc)[2][2][4][2], const Unit& u, int wr, int wc, int fr, int fq) const {
        const int row0 = u.pm * BM + wr * 64 + fr, col0 = u.pn * BM + wc * 32 + 8 * fq;
#pragma unroll
        for (int ai = 0; ai < 2; ++ai)
#pragma unroll
            for (int m = 0; m < 4; ++m) { const int row = row0 + ai * HALF + m * 16;
                const GAS bf16_t* gp = P + (size_t)(row - rowshift) * LDP + C_G + u.z * 1024 + col0; GAS bf16_t* op = Mg + (size_t)row * DM + col0;
#pragma unroll
                for (int bj = 0; bj < 2; ++bj) { const u32x4 gw = *(const GAS u32x4*)(gp + bj * HALF); float gv[8]; unpack8(gw, gv); float r[8];
#pragma unroll
                    for (int e = 0; e < 4; ++e) { r[e] = acc[ai][bj][m][0][e] * frcp(1.f + __expf(-gv[e])); r[4 + e] = acc[ai][bj][m][1][e] * frcp(1.f + __expf(-gv[4 + e])); }
                    if (u.z > 0) { const u32x4 ow = *(const GAS u32x4*)(op + bj * HALF); float ov[8]; unpack8(ow, ov);
#pragma unroll
                        for (int e = 0; e < 8; ++e) r[e] += ov[e]; }
                    *(GAS u32x4*)(op + bj * HALF) = pack8(r); } }
    }
};
struct EpiResid {
    const GAS float* base_ctx; const GAS float* base_lat; GAS float* out_ctx; GAS float* out_lat; const GAS float* gate;
    DI void operator()(const f32x4 (&acc)[2][2][4][2], const Unit& u, int wr, int wc, int fr, int fq) const {
        const int u0 = u.pm * BM; const bool isctx = u0 < NCTX; const int mi = isctx ? 8 : ((u0 - NCTX) >> 12);
        const GAS float* bp = isctx ? base_ctx + (size_t)u0 * DM : base_lat + (size_t)(u0 - NCTX) * DM;
        GAS float* op = isctx ? out_ctx + (size_t)u0 * DM : out_lat + (size_t)(u0 - NCTX) * DM;
        const int r0 = wr * 64 + fr, col0 = u.pn * BM + wc * 32 + 8 * fq;
        const GAS float* gp = gate + (size_t)mi * 6144 + col0;
        f32x4 gv[2][2];
#pragma unroll
        for (int bj = 0; bj < 2; ++bj)
#pragma unroll
            for (int n = 0; n < 2; ++n) gv[bj][n] = *(const GAS f32x4*)(gp + bj * HALF + 4 * n);
#pragma unroll
        for (int ai = 0; ai < 2; ++ai)
#pragma unroll
            for (int m = 0; m < 4; ++m) { const size_t off = (size_t)(r0 + ai * HALF + m * 16) * DM + col0;
#pragma unroll
                for (int bj = 0; bj < 2; ++bj)
#pragma unroll
                    for (int n = 0; n < 2; ++n) { const f32x4 b = *(const GAS f32x4*)(bp + off + bj * HALF + 4 * n);
                        *(GAS f32x4*)(op + off + bj * HALF + 4 * n) = b + gv[bj][n] * acc[ai][bj][m][n]; } }
    }
};
struct EpiPartial {
    GAS float* part; const GAS float* gate;
    DI void operator()(const f32x4 (&acc)[2][2][4][2], const Unit& u, int wr, int wc, int fr, int fq) const {
        GAS float* op = part + ((size_t)u.z * NCTX + (size_t)(u.pm * BM)) * DM;
        const int r0 = wr * 64 + fr, col0 = u.pn * BM + wc * 32 + 8 * fq;
        const GAS float* gp = gate + (size_t)8 * 6144 + col0;
        f32x4 gv[2][2];
#pragma unroll
        for (int bj = 0; bj < 2; ++bj)
#pragma unroll
            for (int n = 0; n < 2; ++n) gv[bj][n] = *(const GAS f32x4*)(gp + bj * HALF + 4 * n);
#pragma unroll
        for (int ai = 0; ai < 2; ++ai)
#pragma unroll
            for (int m = 0; m < 4; ++m) { const size_t off = (size_t)(r0 + ai * HALF + m * 16) * DM + col0;
#pragma unroll
                for (int bj = 0; bj < 2; ++bj)
#pragma unroll
                    for (int n = 0; n < 2; ++n) *(GAS f32x4*)(op + off + bj * HALF + 4 * n) = gv[bj][n] * acc[ai][bj][m][n]; }
    }
};
}

DI void p0_transpose_item(const GAS float* W, int K, int N, GAS bf16_t* WT, LAS float* scr, int item, int lane) {
    const int nblk = N / 32, kb = item / nblk, nb = item % nblk, k0 = 64 * kb, n0 = 32 * nb;
#pragma unroll 8
    for (int i = 0; i < 32; ++i) { const int kk = 2 * i + (lane >> 5); scr[kk * 33 + (lane & 31)] = W[(size_t)(k0 + kk) * N + n0 + (lane & 31)]; }
    asm volatile("s_waitcnt lgkmcnt(0)" ::: "memory");
    const int c = lane & 7;
#pragma unroll
    for (int j = 0; j < 4; ++j) { const int n = (lane >> 3) + 8 * j; const LAS float* s = scr + (8 * c) * 33 + n;
        u32x4 o; o.x = pk2(s[0 * 33], s[1 * 33]); o.y = pk2(s[2 * 33], s[3 * 33]); o.z = pk2(s[4 * 33], s[5 * 33]); o.w = pk2(s[6 * 33], s[7 * 33]);
        *(GAS u32x4*)(WT + (size_t)(n0 + n) * K + k0 + 8 * c) = o; }
    asm volatile("s_waitcnt lgkmcnt(0)" ::: "memory");
}

constexpr int I_IN = 16 * 201, I_BR = 8 * 32, I_O = 16 * 32, I_1 = 16 * 128, I_2 = 64 * 32;
constexpr int PER_L_ITEMS = I_IN + 3 * I_BR + I_O + I_1 + I_2;
DI void transpose_item_of_layer(const Args& a, int l, int r, LAS float* scr, int lane) {
    GAS GAS unsigned char* wt = AWS + WS_WT + (size_t)l * WT_LAYER;
    if (r < I_IN) { p0_transpose_item(AIN(6) + (size_t)l * 1024 * LDP, 1024, LDP, (GAS bf16_t*)(wt + WT_IN), scr, r, lane); return; } r -= I_IN;
    if (r < 3 * I_BR) { const int k = r / I_BR; p0_transpose_item(AIN(18) + (size_t)(l * 3 + k) * 512 * 1024, 512, 1024, (GAS bf16_t*)(wt + WT_BR) + (size_t)k * 1024 * 512, scr, r % I_BR, lane); return; } r -= 3 * I_BR;
    if (r < I_O) { p0_transpose_item(AIN(19) + (size_t)l * 1024 * 1024, 1024, 1024, (GAS bf16_t*)(wt + WT_O), scr, r, lane); return; } r -= I_O;
    if (r < I_1) { p0_transpose_item(AIN(20) + (size_t)l * 1024 * 4096, 1024, 4096, (GAS bf16_t*)(wt + WT_F1), scr, r, lane); return; } r -= I_1;
    p0_transpose_item(AIN(21) + (size_t)l * 4096 * 1024, 4096, 1024, (GAS bf16_t*)(wt + WT_F2), scr, r, lane);
}
DI void phase_prologue(const Args& a, LAS unsigned char* lds) {
    const int tid = otid(), lane = tid & 63, wave = tid >> 6;
    GAS float* MOD = (GAS float*)(AWS + WS_MOD);
    if (blockIdx.x < 192) {
        LAS float* sc = (LAS float*)lds;
        LAS float* red = (LAS float*)(lds + 36864);
        for (int i = tid; i < 9 * 1024; i += 512) { const int mi = i >> 10, k = i & 1023; const float v = mi < 8 ? AIN(1)[mi * 1024 + k] : AIN(3)[k]; sc[i] = v / (1.f + __expf(-v)); }
        __syncthreads();
        const int l = blockIdx.x / 96, cgp = blockIdx.x % 96, col = cgp * 64 + lane;
        const GAS float* W = AIN(4) + (size_t)l * 1024 * 6144;
        float acc[9];
#pragma unroll
        for (int mi = 0; mi < 9; ++mi) acc[mi] = 0.f;
#pragma unroll 8
        for (int k = wave * 128; k < wave * 128 + 128; ++k) { const float w = W[(size_t)k * 6144 + col];
#pragma unroll
            for (int mi = 0; mi < 9; ++mi) acc[mi] += sc[mi * 1024 + k] * w; }
#pragma unroll
        for (int mi = 0; mi < 9; ++mi) red[(wave * 9 + mi) * 64 + lane] = acc[mi];
        __syncthreads();
        for (int idx = tid; idx < 576; idx += 512) { const int mi = idx >> 6, ln = idx & 63; float s = 0.f;
            for (int w = 0; w < 8; ++w) s += red[(w * 9 + mi) * 64 + ln];
            MOD[(size_t)(l * 9 + mi) * 6144 + cgp * 64 + ln] = s + AIN(5)[l * 6144 + cgp * 64 + ln]; }
        __syncthreads();
    }
    if (blockIdx.x == gridDim.x - 1) {
        GAS float* rope = (GAS float*)(AWS + WS_ROPE);
        for (int i = tid; i < 1024; i += 512) { const int pos = i >> 4, f = i & 15; const float freq = powf(10000.0f, -(float)f / 16.0f); const float ang = (float)pos * freq;
            rope[2 * i] = cosf(ang); rope[2 * i + 1] = sinf(ang); }
    }
    { const int gw = blockIdx.x * 8 + wave, NGW = gridDim.x * 8;
      for (int it = gw; it < PER_L_ITEMS; it += NGW) transpose_item_of_layer(a, 0, it, (LAS float*)(lds + wave * 16384), lane); }
    for (int l = 0; l < 2; ++l) { GAS u32x4* z = (GAS u32x4*)(AWS + WS_WT + (size_t)l * WT_LAYER + WT_IN + (size_t)LDP * 1024 * 2);
        const int n16 = (NPAD - LDP) * 1024 * 2 / 16;
        for (int i = blockIdx.x * 512 + tid; i < n16; i += gridDim.x * 512) z[i] = (u32x4){0u, 0u, 0u, 0u}; }
}

DI void phase_modulate(const Args& a, int l, int which, int u_lo) {
    const int tid_ = otid(); const int lane = tid_ & 63, wave = tid_ >> 6;
    const GAS float* MOD = (const GAS float*)(AWS + WS_MOD);
    GAS bf16_t* H = (GAS bf16_t*)(AWS + WS_H);
    const bool from_in = (l == 0 && which == 0);
    const GAS float* xc = from_in ? AIN(2) : (const GAS float*)(AWS + WS_CTXBUF);
    const GAS float* xl = from_in ? AIN(0) : AOUT;
    const int gw = blockIdx.x * 8 + wave, NGW = gridDim.x * 8;
    for (int u = u_lo + gw; u < NROW; u += NGW) {
        const GAS float* xr = u < NCTX ? xc + (size_t)u * DM : xl + (size_t)(u - NCTX) * DM;
        const int mi = u < NCTX ? 8 : ((u - NCTX) >> 12);
        const GAS float* shift = MOD + (size_t)(l * 9 + mi) * 6144 + (which ? 3 : 0) * 1024;
        const GAS float* scale = shift + 1024;
        f32x4 v[4]; float ss = 0.f;
        const bool addpart = (l == 1 && which == 0 && u < NCTX);
#pragma unroll
        for (int j = 0; j < 4; ++j) { v[j] = *(const GAS f32x4*)(xr + 4 * lane + 256 * j);
            if (addpart) { const GAS float* pp = (const GAS float*)(AWS + WS_PART) + (size_t)u * DM + 4 * lane + 256 * j;
#pragma unroll
                for (int z = 0; z < 4; ++z) v[j] += *(const GAS f32x4*)(pp + (size_t)z * NCTX * DM); }
            ss += (v[j].x * v[j].x + v[j].y * v[j].y) + (v[j].z * v[j].z + v[j].w * v[j].w); }
        const float rstd = rsqrtf(wave_sum(ss) * (1.f / DM) + EPSV);
#pragma unroll
        for (int j = 0; j < 4; ++j) { const f32x4 sh = *(const GAS f32x4*)(shift + 4 * lane + 256 * j), sc = *(const GAS f32x4*)(scale + 4 * lane + 256 * j);
            const f32x4 o = v[j] * rstd * (sc + 1.f) + sh; u32x2 w; w.x = pk2(o.x, o.y); w.y = pk2(o.z, o.w);
            *(GAS u32x2*)(H + (size_t)u * DM + 4 * lane + 256 * j) = w; }
    }
}

DI void stage_T(LAS bf16_t* dst, const GAS bf16_t* src, int ncols, int tid) {
    const int ntask = (ncols >> 3) * 32;
    for (int task = tid; task < ntask; task += 512) { const int tp = task & 31, cgp = task >> 5;
        const u32x4 v0 = *(const GAS u32x4*)(src + (size_t)(2 * tp) * LDP + 8 * cgp), v1 = *(const GAS u32x4*)(src + (size_t)(2 * tp + 1) * LDP + 8 * cgp);
        LAS unsigned* d = (LAS unsigned*)(dst + (8 * cgp) * 72 + 2 * tp);
#pragma unroll
        for (int i = 0; i < 4; ++i) { d[(2 * i) * 36] = (v0[i] & 0xffffu) | (v1[i] << 16); d[(2 * i + 1) * 36] = (v0[i] >> 16) | (v1[i] & 0xffff0000u); } }
}

struct GlaW { const GAS float *wf, *bf, *wb, *bb; };

#define GLA_SWEEP() \
    const int d = tid >> 8, p = (tid >> 7) & 1, c = tid & 127, C = hp * 128 + c; \
    float bl[32]; { const GAS float* wg = d ? gw.wb : gw.wf; float w2[16]; _Pragma("unroll") for (int r = 0; r < 16; ++r) w2[r] = wg[r * 256 + C]; \
      const float bias = (d ? gw.bb : gw.bf)[C]; float cum = 0.f; \
      _Pragma("unroll") for (int i = 0; i < 32; ++i) { const int s = 32 * p + i, t = d ? 63 - s : s; float lg = bias, lg1 = 0.f, lg2 = 0.f, lg3 = 0.f; \
          _Pragma("unroll") for (int r = 0; r < 16; r += 4) { lg += zs[t * 32 + d * 16 + r] * w2[r]; lg1 += zs[t * 32 + d * 16 + r + 1] * w2[r + 1]; lg2 += zs[t * 32 + d * 16 + r + 2] * w2[r + 2]; lg3 += zs[t * 32 + d * 16 + r + 3] * w2[r + 3]; } \
          lg = (lg + lg1) + (lg2 + lg3); \
          cum += log_sigmoid(lg) * (1.f / 16.f); bl[i] = cum; if ((i & 3) == 3) __builtin_amdgcn_sched_barrier(0); } \
      xt[(d * 2 + p) * 128 + c] = cum; if (p) xt[512 + d * 128 + c] = bl[0]; }

DI void gla_pass1_item(const GAS bf16_t* P, int hp, GAS bf16_t* kv, GAS float* dec, const GlaW& gw, LAS unsigned char* lds, bool dry) {
    GAS char* g_sink = (GAS char*)*(volatile LAS unsigned long long*)(lds + 143376);
    const int tid = otid(), lane = tid & 63, wave = tid >> 6, fr = lane & 15, fq = lane >> 4;
    LAS float* zs = (LAS float*)lds; LAS float* xt = (LAS float*)(lds + 8192);
    LAS bf16_t* KO = (LAS bf16_t*)(lds + 16384);
    LAS bf16_t* VT = (LAS bf16_t*)(lds + 53248);
    if (!(dry && (P1_DRY_MODE & 8))) {
    if (tid < 256) { const int r = tid >> 2, cc = tid & 3; const u32x4 v = *(const GAS u32x4*)(P + (size_t)r * LDP + C_ZF + cc * 8); float f[8]; unpack8(v, f);
#pragma unroll
        for (int j = 0; j < 8; ++j) zs[r * 32 + cc * 8 + j] = f[j]; }
    stage_T(VT, P + C_VC + hp * 256, 256, tid); }
    unsigned short kpre[32];
    { const int d_ = tid >> 8, p_ = (tid >> 7) & 1, C_ = hp * 128 + (tid & 127);
#pragma unroll
      for (int i = 0; i < 32; ++i) { const int s = 32 * p_ + i, t = d_ ? 63 - s : s; kpre[i] = (dry && (P1_DRY_MODE & 16)) ? (unsigned short)i : P[(size_t)t * LDP + C_KC + C_]; } }
    __syncthreads();
    GLA_SWEEP();
    __syncthreads();
    if (!(dry && (P1_DRY_MODE & 2)))
    { const float off = p ? xt[(d * 2) * 128 + c] : 0.f; const float btot = xt[(d * 2) * 128 + c] + xt[(d * 2 + 1) * 128 + c];
#pragma unroll
      for (int i = 0; i < 32; ++i) { const int s = 32 * p + i, t = d ? 63 - s : s; const float kvv = bf2f(kpre[i]);
          KO[(d * 128 + c) * 72 + t] = (bf16_t)f2bf(kvv * __expf(btot - (bl[i] + off))); if ((i & 7) == 7) __builtin_amdgcn_sched_barrier(0); }
      if (p == 0) *DST(dec + d * 256 + C) = __expf(btot); }
    __syncthreads();
    if (!(dry && (P1_DRY_MODE & 1)))
    { const int dd = wave >> 2, h2 = (wave >> 1) & 1, dvh = wave & 1;
#pragma unroll
      for (int dkt = 0; dkt < 4; ++dkt) {
          const LAS bf16_t* ap = KO + (dd * 128 + h2 * 64 + dkt * 16 + fr) * 72 + fq * 8;
          const bf16x8 a0 = *(const LAS bf16x8*)ap, a1 = *(const LAS bf16x8*)(ap + 32);
#pragma unroll
          for (int dvt = 0; dvt < 4; ++dvt) { const int dv = (dvh * 4 + dvt) * 16 + fr;
              const LAS bf16_t* bp = VT + (h2 * 128 + dv) * 72 + fq * 8;
              const bf16x8 b0 = *(const LAS bf16x8*)bp, b1 = *(const LAS bf16x8*)(bp + 32);
              f32x4 acc = (f32x4){0.f, 0.f, 0.f, 0.f}; acc = MFMA16(a0, b0, acc); acc = MFMA16(a1, b1, acc);
              u32x2 w; w.x = pk2(acc[0], acc[1]); w.y = pk2(acc[2], acc[3]);
              *DST((GAS u32x2*)(kv + (size_t)((dd * 4 + hp * 2 + h2) * 128 + dv) * 64 + dkt * 16 + fq * 4)) = w; } } }
    __syncthreads();
}

DI void gla_pass3_item(GAS bf16_t* P, int hp, const GAS bf16_t* sin, const GlaW& gw, const GAS float* gnorm, LAS unsigned char* lds, bool dry) {
    GAS char* g_sink = (GAS char*)*(volatile LAS unsigned long long*)(lds + 143376);
    const int tid = otid(), lane = tid & 63, wave = tid >> 6, fr = lane & 15, fq = lane >> 4;
    LAS float* zs = (LAS float*)lds; LAS float* xt = (LAS float*)(lds + 8192);
    LAS bf16_t* QS = (LAS bf16_t*)(lds + 16384);
    LAS bf16_t* KS = (LAS bf16_t*)(lds + 53248);
    LAS bf16_t* VT = (LAS bf16_t*)(lds + 90112);
    if (tid < 256) { const int r = tid >> 2, cc = tid & 3; const u32x4 v = *(const GAS u32x4*)(P + (size_t)r * LDP + C_ZF + cc * 8); float f[8]; unpack8(v, f);
#pragma unroll
        for (int j = 0; j < 8; ++j) zs[r * 32 + cc * 8 + j] = f[j]; }
    stage_T(VT, P + C_VC + hp * 256, 256, tid);
    unsigned short kpre[32], qpre[32];
    { const int d_ = tid >> 8, p_ = (tid >> 7) & 1, C_ = hp * 128 + (tid & 127);
#pragma unroll
      for (int i = 0; i < 32; ++i) { const int s = 32 * p_ + i, t = d_ ? 63 - s : s; kpre[i] = P[(size_t)t * LDP + C_KC + C_]; qpre[i] = P[(size_t)t * LDP + C_QC + C_]; } }
    __syncthreads();
    GLA_SWEEP();
    __syncthreads();
    { const float off = p ? xt[(d * 2) * 128 + c] : 0.f; const float bref = xt[(d * 2) * 128 + c] + xt[512 + d * 128 + c];
      const int h2 = c >> 6, dk = c & 63;
#pragma unroll
      for (int i = 0; i < 32; ++i) { const int s = 32 * p + i, t = d ? 63 - s : s; const float bt = bl[i] + off;
          const float qv = bf2f(qpre[i]), kvv = bf2f(kpre[i]);
          QS[((d * 2 + h2) * 64 + t) * 72 + dk] = (bf16_t)f2bf(qv * 0.125f * __expf(bt - bref));
          KS[((d * 2 + h2) * 64 + t) * 72 + dk] = (bf16_t)f2bf(kvv * __expf(bref - bt)); if ((i & 7) == 7) __builtin_amdgcn_sched_barrier(0); }
      if (p == 0) xt[768 + d * 128 + c] = __expf(bref); }
    __syncthreads();
    {
        const int dd = wave >> 2, h2 = (wave >> 1) & 1, lh = wave & 1;
        f32x4 sc[2][4];
#pragma unroll
        for (int li = 0; li < 2; ++li) { const LAS bf16_t* qp = QS + ((dd * 2 + h2) * 64 + (2 * lh + li) * 16 + fr) * 72 + fq * 8;
            const bf16x8 q0 = *(const LAS bf16x8*)qp, q1 = *(const LAS bf16x8*)(qp + 32);
#pragma unroll
            for (int mt = 0; mt < 4; ++mt) { const LAS bf16_t* kp = KS + ((dd * 2 + h2) * 64 + mt * 16 + fr) * 72 + fq * 8;
                const bf16x8 k0 = *(const LAS bf16x8*)kp, k1 = *(const LAS bf16x8*)(kp + 32);
                f32x4 s = (f32x4){0.f, 0.f, 0.f, 0.f}; s = MFMA16(k0, q0, s); s = MFMA16(k1, q1, s); sc[li][mt] = s; } }
        __syncthreads();
#pragma unroll
        for (int li = 0; li < 2; ++li) { const int lrow = (2 * lh + li) * 16 + fr;
#pragma unroll
            for (int mt = 0; mt < 4; ++mt) { float v[4];
#pragma unroll
                for (int j = 0; j < 4; ++j) { const int mcol = mt * 16 + fq * 4 + j; const bool keep = dd ? (mcol >= lrow) : (mcol <= lrow); v[j] = keep ? sc[li][mt][j] : 0.f; }
                u32x2 w; w.x = pk2(v[0], v[1]); w.y = pk2(v[2], v[3]);
                *(LAS u32x2*)(KS + ((dd * 2 + h2) * 64 + lrow) * 72 + mt * 16 + fq * 4) = w; } }
    }
    __syncthreads();
    {
        const int h2 = wave >> 2, lt = wave & 3; const int h = hp * 2 + h2;
        f32x4 acc[8];
#pragma unroll
        for (int i = 0; i < 8; ++i) acc[i] = (f32x4){0.f, 0.f, 0.f, 0.f};
#pragma unroll 1
        for (int dd = 0; dd < 2; ++dd) {
            const LAS bf16_t* pp = KS + ((dd * 2 + h2) * 64 + lt * 16 + fr) * 72 + fq * 8;
            const LAS bf16_t* qp = QS + ((dd * 2 + h2) * 64 + lt * 16 + fr) * 72 + fq * 8;
            const bf16x8 p0 = *(const LAS bf16x8*)pp, p1 = *(const LAS bf16x8*)(pp + 32), q0 = *(const LAS bf16x8*)qp, q1 = *(const LAS bf16x8*)(qp + 32);
            float e0[8], e1[8];
#pragma unroll
            for (int j = 0; j < 8; ++j) { e0[j] = xt[768 + dd * 128 + h2 * 64 + fq * 8 + j]; e1[j] = xt[768 + dd * 128 + h2 * 64 + 32 + fq * 8 + j]; }
            u32x4 spre[8][2];
#pragma unroll
            for (int dvt = 0; dvt < 8; ++dvt) { const GAS bf16_t* sp = sin + (size_t)((dd * 4 + h) * 128 + dvt * 16 + fr) * 64 + fq * 8; spre[dvt][0] = *(const GAS u32x4*)sp; spre[dvt][1] = *(const GAS u32x4*)(sp + 32); }
#pragma unroll
            for (int dvt = 0; dvt < 8; ++dvt) {
                const LAS bf16_t* vp = VT + (h2 * 128 + dvt * 16 + fr) * 72 + fq * 8;
                const bf16x8 v0 = *(const LAS bf16x8*)vp, v1 = *(const LAS bf16x8*)(vp + 32);
                acc[dvt] = MFMA16(v0, p0, acc[dvt]); acc[dvt] = MFMA16(v1, p1, acc[dvt]);
                const u32x4 s0 = spre[dvt][0], s1 = spre[dvt][1];
                float f0[8], f1[8]; unpack8(s0, f0); unpack8(s1, f1);
#pragma unroll
                for (int j = 0; j < 8; ++j) { f0[j] *= e0[j]; f1[j] *= e1[j]; }
                const u32x4 t0 = pack8(f0), t1 = pack8(f1);
                acc[dvt] = MFMA16(__builtin_bit_cast(bf16x8, t0), q0, acc[dvt]); acc[dvt] = MFMA16(__builtin_bit_cast(bf16x8, t1), q1, acc[dvt]);
                __builtin_amdgcn_sched_barrier(0);
            }
        }
        float ss = 0.f;
#pragma unroll
        for (int i = 0; i < 8; ++i) ss += (acc[i][0] * acc[i][0] + acc[i][1] * acc[i][1]) + (acc[i][2] * acc[i][2] + acc[i][3] * acc[i][3]);
        ss += __shfl_xor(ss, 16); ss += __shfl_xor(ss, 32);
        const float rstd = rsqrtf(ss * (1.f / 128.f) + EPSV);
        GAS bf16_t* rp = P + (size_t)(lt * 16 + fr) * LDP + C_RC + h * 128;
#pragma unroll
        for (int dvt = 0; dvt < 8; ++dvt) { const int dv = dvt * 16 + fq * 4; const u32x2 rw = *(const GAS u32x2*)(rp + dv); const f32x4 gn = *(const GAS f32x4*)(gnorm + dv);
            float rv[4] = {__uint_as_float(rw.x << 16), __uint_as_float(rw.x & 0xffff0000u), __uint_as_float(rw.y << 16), __uint_as_float(rw.y & 0xffff0000u)}; float o[4];
#pragma unroll
            for (int j = 0; j < 4; ++j) o[j] = acc[dvt][j] * rstd * gn[j] * (rv[j] * frcp(1.f + __expf(-rv[j])));
            u32x2 w; w.x = pk2(o[0], o[1]); w.y = pk2(o[2], o[3]); *DST((GAS u32x2*)(rp + dv)) = w; }
    }
    __syncthreads();
}

DI void gla_scan_item(const Args& a, int hf, int b, int d, int slice, bool dry) {
    GAS char* g_sink = (GAS char*)(AWS + WS_PART);
    const int tid = otid(); const int e = slice * 2048 + tid * 4; const int h = e >> 13, dk = e & 63;
    GAS bf16_t* KV = (GAS bf16_t*)(AWS + WS_KV); const GAS float* DEC = (const GAS float*)(AWS + WS_DEC); GAS float* CST = (GAS float*)(AWS + WS_CTXST) + (size_t)(b * 2 + d) * 32768 + e;
    f32x4 st;
    if (hf == 0) {
        { float z0 = 0.f; asm volatile("" : "+v"(z0)); st = (f32x4){z0, z0, z0, z0}; }
#pragma unroll
        for (int s = 0; s < 4; ++s) { const int cid = b * 4 + (d ? 3 - s : s);
            GAS bf16_t* kp = KV + (size_t)cid * 65536 + d * 32768 + e; const u32x2 kw = *(const GAS u32x2*)kp; const f32x4 dc = *(const GAS f32x4*)(DEC + cid * 512 + d * 256 + h * 64 + dk);
            u32x2 w; w.x = pk2(st.x, st.y); w.y = pk2(st.z, st.w); *DST((GAS u32x2*)kp) = w;
            const f32x4 kvv = (f32x4){__uint_as_float(kw.x << 16), __uint_as_float(kw.x & 0xffff0000u), __uint_as_float(kw.y << 16), __uint_as_float(kw.y & 0xffff0000u)};
            st = st * dc + kvv; }
        *DST((GAS f32x4*)CST) = st;
        if (b >= 4) return;
    } else { st = *(const GAS f32x4*)CST; }
    const int cbase = 32 + (b & 3) * 64;
    u32x2 kwn[4]; f32x4 dcn[4];
#pragma unroll
    for (int k = 0; k < 4; ++k) { const int cid = cbase + (d ? 63 - k : k);
        kwn[k] = *(const GAS u32x2*)(KV + (size_t)cid * 65536 + d * 32768 + e); dcn[k] = *(const GAS f32x4*)(DEC + cid * 512 + d * 256 + h * 64 + dk); }
    for (int s0 = 0; s0 < 64; s0 += 4) {
        u32x2 kw[4]; f32x4 dc[4]; GAS bf16_t* kp[4];
#pragma unroll
        for (int k = 0; k < 4; ++k) { const int s = s0 + k; const int cid = cbase + (d ? 63 - s : s); kp[k] = KV + (size_t)cid * 65536 + d * 32768 + e; kw[k] = kwn[k]; dc[k] = dcn[k]; }
        if (s0 + 4 < 64) {
#pragma unroll
            for (int k = 0; k < 4; ++k) { const int s = s0 + 4 + k; const int cid = cbase + (d ? 63 - s : s);
                kwn[k] = *(const GAS u32x2*)(KV + (size_t)cid * 65536 + d * 32768 + e); dcn[k] = *(const GAS f32x4*)(DEC + cid * 512 + d * 256 + h * 64 + dk); } }
#pragma unroll
        for (int k = 0; k < 4; ++k) { u32x2 w; w.x = pk2(st.x, st.y); w.y = pk2(st.z, st.w); *DST((GAS u32x2*)kp[k]) = w;
            const f32x4 kvv = (f32x4){__uint_as_float(kw[k].x << 16), __uint_as_float(kw[k].x & 0xffff0000u), __uint_as_float(kw[k].y << 16), __uint_as_float(kw[k].y & 0xffff0000u)};
            st = st * dc[k] + kvv; }
    }
}

DI void sgu_item(GAS bf16_t* P, int g, const GAS float* ws_l  , const GAS float* bs_l  , const GAS float* gn_l  , LAS unsigned char* lds, bool dry) {
    GAS char* g_sink = (GAS char*)*(volatile LAS unsigned long long*)(lds + 143376);
    const int tid = otid(), lane = tid & 63, wave = tid >> 6, fr = lane & 15, fq = lane >> 4;
    LAS bf16_t* VT = (LAS bf16_t*)lds;
    const float g0 = gn_l[g * 128 + lane], g1 = gn_l[g * 128 + 64 + lane];
    { unsigned short r0[16], r1[16];
#pragma unroll
      for (int i = 0; i < 16; ++i) { const GAS bf16_t* vp = P + (size_t)(wave + 8 * i) * LDP + C_VA + g * 128; r0[i] = vp[lane]; r1[i] = vp[64 + lane]; }
#pragma unroll
      for (int i = 0; i < 16; ++i) { const int q = wave + 8 * i;
        const float x0 = gelu_tanh(bf2f(r0[i])), x1 = gelu_tanh(bf2f(r1[i]));
        const float rstd = rsqrtf(wave_sum(x0 * x0 + x1 * x1) * (1.f / 128.f) + EPSV);
        VT[lane * 136 + q] = (bf16_t)f2bf(x0 * rstd * g0); VT[(64 + lane) * 136 + q] = (bf16_t)f2bf(x1 * rstd * g1); } }
    bf16x8 wf[4];
    { const GAS float* wp = ws_l + (size_t)(g * 128 + wave * 16 + fr) * 128 + fq * 8;
#pragma unroll
      for (int ks = 0; ks < 4; ++ks) { const f32x4 w0 = *(const GAS f32x4*)(wp + ks * 32), w1 = *(const GAS f32x4*)(wp + ks * 32 + 4);
          u32x4 t; t.x = pk2(w0.x, w0.y); t.y = pk2(w0.z, w0.w); t.z = pk2(w1.x, w1.y); t.w = pk2(w1.z, w1.w); wf[ks] = __builtin_bit_cast(bf16x8, t); } }
    __syncthreads();
    const int prow = wave * 16 + fr; const float bias = bs_l[g * 128 + prow];
    GAS bf16_t* up = P + (size_t)prow * LDP + C_U + g * 128;
#pragma unroll
    for (int dt = 0; dt < 8; ++dt) { f32x4 acc = (f32x4){0.f, 0.f, 0.f, 0.f};
#pragma unroll
        for (int ks = 0; ks < 4; ++ks) { const bf16x8 av = *(const LAS bf16x8*)(VT + (dt * 16 + fr) * 136 + ks * 32 + fq * 8); acc = MFMA16(av, wf[ks], acc); }
        const int dcol = dt * 16 + fq * 4; const u32x2 uw = *(const GAS u32x2*)(up + dcol);
        const float uv[4] = {__uint_as_float(uw.x << 16), __uint_as_float(uw.x & 0xffff0000u), __uint_as_float(uw.y << 16), __uint_as_float(uw.y & 0xffff0000u)}; float o[4];
#pragma unroll
        for (int j = 0; j < 4; ++j) o[j] = gelu_tanh(uv[j]) * (acc[j] + bias);
        u32x2 w; w.x = pk2(o[0], o[1]); w.y = pk2(o[2], o[3]); *DST((GAS u32x2*)(up + dcol)) = w; }
    __syncthreads();
}

DI void qkprep_item(GAS bf16_t* P, int t0, bool doq, const GAS float* qn, const GAS float* kn, const GAS float* rope, bool dry, LAS unsigned char* lds) {
    GAS char* g_sink = (GAS char*)*(volatile LAS unsigned long long*)(lds + 143376);
    const int tid = otid(), lane = tid & 63, wave = tid >> 6, sub = lane & 7;
    LAS float* rtab = (LAS float*)lds;
    LAS float* gtab = (LAS float*)(lds + 8192);
    *(LAS f32x4*)(rtab + 4 * tid) = *(const GAS f32x4*)(rope + 4 * tid);
    if (tid < 128) gtab[tid] = tid < 64 ? qn[tid] : kn[tid - 64];
    __syncthreads();
    u32x4 xpre[10];
#pragma unroll
    for (int ii = 0; ii < 10; ++ii) { const int pr = (wave + 8 * ii) * 8 + (lane >> 3); const int r = pr / 10, hh = pr - r * 10; const bool isq = hh < 8;
        xpre[ii] = *(const GAS u32x4*)(P + (size_t)r * LDP + (isq ? C_QB + hh * 64 : C_KB + (hh - 8) * 64) + sub * 8); }
#pragma unroll
    for (int ii = 0; ii < 10; ++ii) { const int it = wave + 8 * ii; const int pr = it * 8 + (lane >> 3); const int r = pr / 10, hh = pr - r * 10; const bool isq = hh < 8;
        if (isq && !doq) continue;
        GAS bf16_t* xp = P + (size_t)r * LDP + (isq ? C_QB + hh * 64 : C_KB + (hh - 8) * 64) + sub * 8;
        const u32x4 xw = xpre[ii]; float x[8]; unpack8(xw, x);
        float ss = 0.f;
#pragma unroll
        for (int j = 0; j < 8; ++j) ss += x[j] * x[j];
        ss += __shfl_xor(ss, 1); ss += __shfl_xor(ss, 2); ss += __shfl_xor(ss, 4);
        const float rstd = rsqrtf(ss * (1.f / 64.f) + EPSV);
        const LAS float* gp = gtab + (isq ? 0 : 64) + sub * 8;
#pragma unroll
        for (int j = 0; j < 8; ++j) x[j] = x[j] * rstd * gp[j];
        if (t0 >= 0) { const int t = t0 + r; const int pos = (sub < 4) ? (t >> 6) : (t & 63); const LAS float* tb = rtab + (pos * 16 + 8 * (sub & 1)) * 2;
#pragma unroll
            for (int j = 0; j < 8; ++j) { const float o = __shfl_xor(x[j], 2); const float cs = tb[2 * j], sn = tb[2 * j + 1]; x[j] = (sub & 2) ? (o * sn + x[j] * cs) : (x[j] * cs - o * sn); } }
        if (isq) {
#pragma unroll
            for (int j = 0; j < 8; ++j) x[j] *= 0.125f * LOG2E; }
        *DST((GAS u32x4*)xp) = pack8(x);
    }
    __syncthreads();
}

DI void attn_item(GAS bf16_t* Q, const GAS bf16_t* Klat, const GAS bf16_t* Vlat, int qb, const GAS bf16_t* Kctx, const GAS bf16_t* Vctx, const GAS float* sink4, LAS unsigned char* lds, bool dry) {
    GAS char* g_sink = (GAS char*)*(volatile LAS unsigned long long*)(lds + 143376);
    const int tid = otid(), lane = tid & 63, wave = tid >> 6, fr = lane & 15, fq = lane >> 4;
    const int g = wave & 3, half = wave >> 2;
    LAS bf16_t* Ks0 = (LAS bf16_t*)lds;
    LAS bf16_t* Vt0 = (LAS bf16_t*)(lds + 9216);
    bf16x8 qf[4][2];
#pragma unroll
    for (int rt = 0; rt < 4; ++rt) { const GAS bf16_t* qp = Q + (size_t)(half * 64 + rt * 16 + fr) * LDP + g * 64 + fq * 8;
        qf[rt][0] = *(const GAS bf16x8*)qp; qf[rt][1] = *(const GAS bf16x8*)(qp + 32); }
    const float snk = sink4[g] * LOG2E;
    float mrow[4], lrow[4]; f32x4 O[4][4];
#pragma unroll
    for (int rt = 0; rt < 4; ++rt) { mrow[rt] = snk; lrow[rt] = (fq == 0) ? 1.f : 0.f;
#pragma unroll
        for (int dt = 0; dt < 4; ++dt) O[dt][rt] = (f32x4){0.f, 0.f, 0.f, 0.f}; }
    const int ntl = Klat ? 6 : 0, ntile = ntl + 4;
    const int kr = tid >> 3, kc = tid & 7;
    const int vtp = tid & 31, vcg = (tid >> 5) & 7;
    u32x4 kreg, v0reg, v1reg; int jn = 0;
    auto tile_valid = [&](int j) -> bool { if (j >= ntl) return true; const int kp0 = qb * 128 - 128 + 64 * j; return kp0 >= 0 && kp0 < SEQ; };
    auto tile_k = [&](int j) -> const GAS bf16_t* { return j < ntl ? Klat + (size_t)(qb * 128 - 128 + 64 * j) * LDP : Kctx + (size_t)((j - ntl) * 64) * LDP; };
    auto tile_v = [&](int j) -> const GAS bf16_t* { return j < ntl ? Vlat + (size_t)(qb * 128 - 128 + 64 * j) * LDP : Vctx + (size_t)((j - ntl) * 64) * LDP; };
    while (jn < ntile && !tile_valid(jn)) ++jn;
    { const GAS bf16_t* kp = tile_k(jn); const GAS bf16_t* vp = tile_v(jn);
      kreg = *(const GAS u32x4*)(kp + (size_t)kr * LDP + kc * 8);
      if (tid < 256) { v0reg = *(const GAS u32x4*)(vp + (size_t)(2 * vtp) * LDP + vcg * 8); v1reg = *(const GAS u32x4*)(vp + (size_t)(2 * vtp + 1) * LDP + vcg * 8); } }
    int pp = 0;
    while (jn < ntile) {
        const int j = jn;
        LAS bf16_t* Ks = Ks0 + pp * 9216; LAS bf16_t* Vt = Vt0 + pp * 9216; pp ^= 1;
        *(LAS u32x4*)(Ks + kr * 72 + kc * 8) = kreg;
        if (tid < 256) { LAS unsigned* dp = (LAS unsigned*)(Vt + (8 * vcg) * 72 + 2 * vtp);
#pragma unroll
            for (int i = 0; i < 4; ++i) { dp[(2 * i) * 36] = (v0reg[i] & 0xffffu) | (v1reg[i] << 16); dp[(2 * i + 1) * 36] = (v0reg[i] >> 16) | (v1reg[i] & 0xffff0000u); } }
        __syncthreads();
        ++jn; while (jn < ntile && !tile_valid(jn)) ++jn;
        if (jn < ntile && !(dry && (ATT_DRY_MODE & 2))) { const GAS bf16_t* kp = tile_k(jn); const GAS bf16_t* vp = tile_v(jn);
            kreg = *(const GAS u32x4*)(kp + (size_t)kr * LDP + kc * 8);
            if (tid < 256) { v0reg = *(const GAS u32x4*)(vp + (size_t)(2 * vtp) * LDP + vcg * 8); v1reg = *(const GAS u32x4*)(vp + (size_t)(2 * vtp + 1) * LDP + vcg * 8); } }
        const bool local = j < ntl;
        if (local && ((half == 0 && j == 5) || (half == 1 && j == 0))) continue;
        f32x4 S[4][4];
#pragma unroll
        for (int kt = 0; kt < 4; ++kt) { const LAS bf16_t* kp = Ks + (kt * 16 + fr) * 72 + fq * 8; const bf16x8 k0 = *(const LAS bf16x8*)kp, k1 = *(const LAS bf16x8*)(kp + 32);
#pragma unroll
            for (int rt = 0; rt < 4; ++rt) { f32x4 sv = (f32x4){0.f, 0.f, 0.f, 0.f}; sv = MFMA16(k0, qf[rt][0], sv); sv = MFMA16(k1, qf[rt][1], sv); S[rt][kt] = sv; } }
        if (dry && (ATT_DRY_MODE & 1)) { O[0][0] += S[0][0] + S[1][1] + S[2][2] + S[3][3]; continue; }
        if (local && (64 * j - 64 * half == 0 || 64 * j - 64 * half == 256)) { const int kk0 = -128 + 64 * j;
#pragma unroll
            for (int rt = 0; rt < 4; ++rt) { const int qq = half * 64 + rt * 16 + fr;
#pragma unroll
                for (int kt = 0; kt < 4; ++kt)
#pragma unroll
                    for (int e = 0; e < 4; ++e) { const int df = kk0 + kt * 16 + fq * 4 + e - qq; if (df < -128 || df > 128) S[rt][kt][e] = -INFINITY; } } }
        bf16x8 pb[4][2];
#pragma unroll
        for (int rt = 0; rt < 4; ++rt) { float mx = -INFINITY;
#pragma unroll
            for (int kt = 0; kt < 4; ++kt) mx = fmaxf(mx, fmaxf(fmaxf(S[rt][kt][0], S[rt][kt][1]), fmaxf(S[rt][kt][2], S[rt][kt][3])));
            mx = fmaxf(mx, __shfl_xor(mx, 16)); mx = fmaxf(mx, __shfl_xor(mx, 32));
            const float mnew = fmaxf(mrow[rt], mx), alpha = __builtin_amdgcn_exp2f(mrow[rt] - mnew); mrow[rt] = mnew;
            float ps = 0.f;
#pragma unroll
            for (int kt = 0; kt < 4; ++kt)
#pragma unroll
                for (int e = 0; e < 4; ++e) { const float pv = __builtin_amdgcn_exp2f(S[rt][kt][e] - mnew); S[rt][kt][e] = pv; ps += pv; }
            lrow[rt] = lrow[rt] * alpha + ps;
#pragma unroll
            for (int dt = 0; dt < 4; ++dt) O[dt][rt] = O[dt][rt] * alpha;
#pragma unroll
            for (int sidx = 0; sidx < 2; ++sidx) { u32x4 t; t.x = pk2(S[rt][2 * sidx][0], S[rt][2 * sidx][1]); t.y = pk2(S[rt][2 * sidx][2], S[rt][2 * sidx][3]); t.z = pk2(S[rt][2 * sidx + 1][0], S[rt][2 * sidx + 1][1]); t.w = pk2(S[rt][2 * sidx + 1][2], S[rt][2 * sidx + 1][3]);
                pb[rt][sidx] = __builtin_bit_cast(bf16x8, t); } }
#pragma unroll
        for (int dt = 0; dt < 4; ++dt)
#pragma unroll
            for (int sidx = 0; sidx < 2; ++sidx) { const LAS bf16_t* vp = Vt + (dt * 16 + fr) * 72 + 32 * sidx + 4 * fq;
                const u32x2 lo = *(const LAS u32x2*)vp, hi = *(const LAS u32x2*)(vp + 16);
                const u32x4 t = (u32x4){lo.x, lo.y, hi.x, hi.y}; const bf16x8 av = __builtin_bit_cast(bf16x8, t);
#pragma unroll
                for (int rt = 0; rt < 4; ++rt) O[dt][rt] = MFMA16(av, pb[rt][sidx], O[dt][rt]); }
    }
#pragma unroll
    for (int rt = 0; rt < 4; ++rt) { float l = lrow[rt]; l += __shfl_xor(l, 16); l += __shfl_xor(l, 32); const float inv = 1.f / l;
        GAS bf16_t* op = Q + (size_t)(half * 64 + rt * 16 + fr) * LDP + g * 64;
#pragma unroll
        for (int dt = 0; dt < 4; ++dt) { const f32x4 o = O[dt][rt] * inv; u32x2 w; w.x = pk2(o[0], o[1]); w.y = pk2(o[2], o[3]); *DST((GAS u32x2*)(op + dt * 16 + fq * 4)) = w; } }
    __syncthreads();
}

DI void phase_x1(const Args& a, int l, int hf, LAS unsigned char* lds, bool dry) {
    GAS bf16_t* PJ = (GAS bf16_t*)(AWS + WS_BIG);
    const int c0 = hf ? 32 : 0;
    const int nch = hf ? 256 : 288;
    const bool ctx_mix = (hf == 0 && l == 0);
    const int s0 = (hf == 0 && !ctx_mix) ? 16 : (hf ? 16 : 0);
    const int nsg = 144 - s0;
    const int n_sgu = nsg * 4, n_g1 = nch * 2, n_pp = nch;
    const GlaW gw{AIN(13) + l * 16 * 256, AIN(14) + l * 256, AIN(15) + l * 16 * 256, AIN(16) + l * 256};
    for (int it = blockIdx.x; it < n_sgu + n_g1 + n_pp; it += gridDim.x) {
        if (it < n_sgu) { const int ck = s0 + (it >> 2), g = it & 3;
            if (!dry || (DRYSEL & 1)) sgu_item(PJ + (size_t)ck * 128 * LDP, g, AIN(11) + (size_t)l * 4 * 128 * 128, AIN(12) + l * 512, AIN(10) + l * 512, lds, dry);
        } else if (it < n_sgu + n_g1) { const int r = it - n_sgu; const int cid = c0 + (r >> 1), hp = r & 1;
            if (!dry || (DRYSEL & 2)) gla_pass1_item(PJ + (size_t)cid * 64 * LDP, hp, (GAS bf16_t*)(AWS + WS_KV) + (size_t)cid * 65536, (GAS float*)(AWS + WS_DEC) + cid * 512, gw, lds, dry);
        } else { const int cid = c0 + (it - n_sgu - n_g1); const bool isctx = cid < 32;
            const int t0 = isctx ? -1 : (((cid - 32) * 64) & 4095);
            if (!dry || (DRYSEL & 4)) qkprep_item(PJ + (size_t)cid * 64 * LDP, t0, !isctx || l == 0, AIN(7) + l * 64, AIN(8) + l * 64, (const GAS float*)(AWS + WS_ROPE), dry, lds);
        }
    }
}

DI void phase_x2(const Args& a, int l, int hf, LAS unsigned char* lds, bool dry) {
    GAS bf16_t* PJ = (GAS bf16_t*)(AWS + WS_BIG);
    const int n_att_lat = 256, n_att_ctx = 0;
    const int n_scan = hf ? 128 : 256;
    const int n_att = n_att_lat + n_att_ctx;
    for (int it = blockIdx.x; it < n_att + n_scan; it += gridDim.x) {
        if (it < n_att_lat) { const int kh = it & 1, qb = (it >> 1) & 31, bl = it >> 6;
            const int b = hf * 4 + bl;
            GAS bf16_t* lat0 = PJ + (size_t)(NCTX + bl * SEQ) * LDP;
            const GAS bf16_t* cx0 = PJ + (size_t)(b * CTXL) * LDP;
            if (!dry || (DRYSEL & 1)) attn_item(lat0 + (size_t)(qb * 128) * LDP + C_QB + kh * 256, lat0 + C_KB + kh * 64, lat0 + C_VB + kh * 64, qb, cx0 + C_KB + kh * 64, cx0 + C_VB + kh * 64, AIN(9) + l * 8 + kh * 4, lds, dry);
        } else if (it < n_att) { const int r = it - n_att_lat; const int kh = r & 1, qb = (r >> 1) & 1, b = r >> 2;
            GAS bf16_t* cx0 = PJ + (size_t)(b * CTXL) * LDP;
            if (!dry || (DRYSEL & 1)) attn_item(cx0 + (size_t)(qb * 128) * LDP + C_QB + kh * 256, nullptr, nullptr, qb, cx0 + C_KB + kh * 64, cx0 + C_VB + kh * 64, AIN(9) + l * 8 + kh * 4, lds, dry);
        } else { const int r = it - n_att; const int slice = r & 15, d = (r >> 4) & 1, bb = r >> 5;
            if (!dry || (DRYSEL & 2)) gla_scan_item(a, hf, hf ? 4 + bb : bb, d, slice, dry);
        }
    }
}

DI void phase_x3(const Args& a, int l, int hf, LAS unsigned char* lds, bool dry) {
    GAS bf16_t* PJ = (GAS bf16_t*)(AWS + WS_BIG);
    const int c0 = (hf == 0 && l == 0) ? 0 : 32;
    const int nch = 288 - c0;
    const GlaW gw{AIN(13) + l * 16 * 256, AIN(14) + l * 256, AIN(15) + l * 16 * 256, AIN(16) + l * 256};
    for (int it = blockIdx.x; it < nch * 2; it += gridDim.x) { const int cid = c0 + (it >> 1), hp = it & 1;
        gla_pass3_item(PJ + (size_t)cid * 64 * LDP, hp, (const GAS bf16_t*)(AWS + WS_KV) + (size_t)cid * 65536, gw, AIN(17) + l * 128, lds, dry); }
    if (hf == 0 && l == 0 && (int)blockIdx.x >= (int)gridDim.x - 32) {
        const int r = (int)blockIdx.x - ((int)gridDim.x - 32); const int kh = r & 1, qb = (r >> 1) & 1, b = r >> 2;
        GAS bf16_t* cx0 = PJ + (size_t)(b * CTXL) * LDP;
        attn_item(cx0 + (size_t)(qb * 128) * LDP + C_QB + kh * 256, nullptr, nullptr, qb, cx0 + C_KB + kh * 64, cx0 + C_VB + kh * 64, AIN(9) + l * 8 + kh * 4, lds, dry); }
}


#define XB_TMO      128
#define XB_XCNT(j)  (256  + 64 * (j))
#define XB_XSUB(j)  (1280 + 64 * (j))
#define XB_XGEN(j)  (2304 + 64 * (j))
#define XB_TOP      3328
#define XB_TOPGEN   3392
#define XCD_BAR_WORDS 3456
#define XB_SPIN_CAP (1u << 18)
DI unsigned xb_ld(unsigned* p)              { return __hip_atomic_load(p, __ATOMIC_RELAXED, __HIP_MEMORY_SCOPE_AGENT); }
DI unsigned xb_add(unsigned* p, unsigned v) { return __hip_atomic_fetch_add(p, v, __ATOMIC_RELAXED, __HIP_MEMORY_SCOPE_AGENT); }
DI unsigned xb_xcc_id() { return (unsigned)__builtin_amdgcn_s_getreg((3 << 11) | 20) & 0xFu; }
#define XB_SPIN(cond, bar) do { unsigned _sp = 0; while (cond) { __builtin_amdgcn_s_sleep(1); \
    if ((++_sp & 255u) == 0u) { if (xb_ld(&(bar)[XB_TMO])) break; if (_sp > XB_SPIN_CAP) { atomicAdd(&(bar)[XB_TMO], 1u); break; } } } } while (0)
struct XcdBarrier { unsigned* bar; unsigned x; volatile LAS unsigned* st; };
DI XcdBarrier xcd_barrier_post(unsigned* bar, volatile LAS unsigned* st) {
    XcdBarrier b; b.bar = bar; b.x = xb_xcc_id(); b.st = st;
    if (threadIdx.x == 0) (void)xb_add(&bar[XB_XCNT(b.x)], 1u);
    return b;
}
DI void xcd_barrier_complete(unsigned* bar, unsigned x, unsigned& nloc, unsigned& nx) {
    const unsigned G = gridDim.x * gridDim.y * gridDim.z;
    unsigned sum, cnt, mine, sp = 0u;
    for (;;) {
        sum = 0u; cnt = 0u; mine = 0u;
#pragma unroll
        for (unsigned j = 0; j < 16; ++j) { const unsigned c = xb_ld(&bar[XB_XCNT(j)]); sum += c; cnt += (c > 0u) ? 1u : 0u; mine = (j == x) ? c : mine; }
        if (sum == G) break;
        __builtin_amdgcn_s_sleep(1);
        if ((++sp & 255u) == 0u) { if (xb_ld(&bar[XB_TMO])) break; if (sp > XB_SPIN_CAP) { atomicAdd(&bar[XB_TMO], 1u); break; } }
    }
    nloc = mine > 0u ? mine : 1u; nx = cnt > 0u ? cnt : 1u;
}
template <int NOFENCE = 0> DI void xcd_barrier(const XcdBarrier& b) {
    asm volatile("s_waitcnt vmcnt(0)" ::: "memory");
    __syncthreads();
    if (threadIdx.x == 0) {
        unsigned* bar = b.bar;
        __builtin_amdgcn_s_waitcnt(0);
        unsigned nloc = b.st[0], nx = b.st[1]; const unsigned round = b.st[2];
        if (nloc == 0u) { xcd_barrier_complete(bar, b.x, nloc, nx); b.st[0] = nloc; b.st[1] = nx; }
        b.st[2] = round + 1u;
        const unsigned old = xb_add(&bar[XB_XSUB(b.x)], 1u);
        if (old + 1u == (round + 1u) * nloc) {
            __builtin_amdgcn_fence(__ATOMIC_RELEASE, "agent");
            asm volatile("s_waitcnt vmcnt(0)" ::: "memory");
            const unsigned og = xb_add(&bar[XB_TOP], 1u);
            if (og + 1u == (round + 1u) * nx) xb_add(&bar[XB_TOPGEN], 1u);
        }
        XB_SPIN(xb_ld(&bar[XB_TOPGEN]) == round, bar);
        __builtin_amdgcn_fence(__ATOMIC_ACQUIRE, "agent");
        asm volatile("s_waitcnt vmcnt(0)" ::: "memory");
    }
    __syncthreads();
}

constexpr int NPHASE = 31;
#ifndef DBG_N
#define DBG_N NPHASE
#endif
#ifndef DBG_NELEM
#define DBG_NELEM 0
#endif
#ifndef DBG_OFF
#define DBG_OFF 0
#endif
#ifndef DBG_F32
#define DBG_F32 0
#endif
#ifndef DBG_NELEM2
#define DBG_NELEM2 0
#endif
#ifndef DBG_OFF2
#define DBG_OFF2 0
#endif
#ifndef PHM
#define PHM 0xFFFF
#endif

DI void run_phase(const Args& a, int ph, LAS unsigned char* lds, bool dry) {
    if (ph == 0) { if (PHM & 1) phase_prologue(a, lds); return; }
    const int l = (ph - 1) / 15, q = (ph - 1) % 15;
    GAS GAS unsigned char* wt = AWS + WS_WT + (size_t)l * WT_LAYER;
    const int G = gridDim.x, cidx = blockIdx.x;
    const GAS float* MOD = (const GAS float*)(AWS + WS_MOD);
    if (q == 0) { if (PHM & 2) phase_modulate(a, l, 0, 0); return; }
    if (q >= 1 && q <= 10) {
        const int hf = (q - 1) / 5, k = (q - 1) % 5;
        const int rowshift = hf ? HALF_ROWS : 0;
        if (k == 0) { if (PHM & 4) {
            pg8::Gemm g{(const GAS char*)(AWS + WS_H) + (size_t)rowshift * DM * 2, (const GAS char*)(wt + WT_IN), DM, DM, DM, 0, 0, 0, 0};
            pg8::EpiProj E{(GAS bf16_t*)(AWS + WS_BIG), 0};
            const int prune = (l == 1 && hf == 0) ? 1 : 0;
            for (int part = 0; part <= prune; ++part) {
                pg8::Order S;
                if (part == 0) S.init((hf || prune) ? 8 : 0, (hf || prune) ? 64 : 72, NPAD / 256, 1, G, cidx);
                else S.init(0, 8, NPAD / 256, 1, G, cidx, 2);
                pg8::gemm_phase<pg8::EpiProj>(lds, g, S, E); }
            if (l == 0) {
                const int nwg = (hf ? 64 : 72) * (NPAD / 256), busy = nwg % G;
                if (busy != 0 && cidx >= busy) { const int tid_ = otid(), wave = tid_ >> 6, lane = tid_ & 63;
                    const int worker = (cidx - busy) * 8 + wave, nworker = (G - busy) * 8;
                    const int lo = hf ? 4980 : 0, hi = hf ? PER_L_ITEMS : 4980;
                    for (int it = lo + worker; it < hi; it += nworker) transpose_item_of_layer(a, 1, it, (LAS float*)(lds + wave * 16384), lane); } } }
        } else if (k == 1) { if (PHM & 8) phase_x1(a, l, hf, lds, dry); }
        else if (k == 2) { if (PHM & 16) phase_x2(a, l, hf, lds, dry); }
        else if (k == 3) { if (PHM & 32) phase_x3(a, l, hf, lds, dry); }
        else if (PHM & 64) {
            const bool withctx = (hf == 0 && l == 0);
            pg8::Gemm g{(const GAS char*)(AWS + WS_BIG), (const GAS char*)(wt + WT_BR), LDP, 512, 512, C_U * 2, (C_QB - C_U) * 2, (C_RC - 2 * C_QB + C_U) * 2, 1024 * 512 * 2};
            pg8::Order S; S.init(withctx ? 0 : 8, withctx ? 72 : 64, 4, 3, G, cidx);
            pg8::EpiMerge E{(const GAS bf16_t*)(AWS + WS_BIG), 0, (GAS bf16_t*)(AWS + WS_H) + (size_t)rowshift * DM};
            pg8::gemm_phase<pg8::EpiMerge>(lds, g, S, E);
        }
        return;
    }
    const int pm0 = (l == 0) ? 0 : 8, nM = 136 - pm0;
    if (q == 11) { if (PHM & 128) {
        pg8::Gemm g{(const GAS char*)(AWS + WS_H), (const GAS char*)(wt + WT_O), DM, DM, DM, 0, 0, 0, 0};
        pg8::Order S; S.init(pm0, nM, 4, 1, G, cidx);
        pg8::EpiResid E{l == 0 ? AIN(2) : (const GAS float*)(AWS + WS_CTXBUF), l == 0 ? AIN(0) : (const GAS float*)AOUT, (GAS float*)(AWS + WS_CTXBUF), AOUT, MOD + (size_t)(l * 9) * 6144 + 2 * 1024};
        pg8::gemm_phase<pg8::EpiResid>(lds, g, S, E); }
    } else if (q == 12) { if (PHM & 2) phase_modulate(a, l, 1, pm0 * 256);
    } else if (q == 13) { if (PHM & 256) {
        pg8::Gemm g{(const GAS char*)(AWS + WS_H), (const GAS char*)(wt + WT_F1), DM, DM, DM, 0, 0, 0, 0};
        pg8::Order S; S.init(pm0, nM, 16, 1, G, cidx);
        pg8::EpiFF1 E{(GAS bf16_t*)(AWS + WS_BIG)};
        pg8::gemm_phase<pg8::EpiFF1>(lds, g, S, E); }
    } else if (PHM & 512) {
        { pg8::Gemm g{(const GAS char*)(AWS + WS_BIG), (const GAS char*)(wt + WT_F2), FF, FF, FF, 0, 0, 0, 0};
          pg8::Order S; S.init(8, 128, 4, 1, G, cidx);
          pg8::EpiResid E{(const GAS float*)(AWS + WS_CTXBUF), (const GAS float*)AOUT, (GAS float*)(AWS + WS_CTXBUF), AOUT, MOD + (size_t)(l * 9) * 6144 + 5 * 1024};
          pg8::gemm_phase<pg8::EpiResid>(lds, g, S, E); }
        if (l == 0) {
          pg8::Gemm g{(const GAS char*)(AWS + WS_BIG), (const GAS char*)(wt + WT_F2), FF, FF, 1024, 0, 2048, 0, 2048};
          pg8::Order S; S.init(0, 8, 4, 4, G, cidx, 1);
          pg8::EpiPartial E{(GAS float*)(AWS + WS_PART), MOD + (size_t)(l * 9) * 6144 + 5 * 1024};
          pg8::gemm_phase<pg8::EpiPartial>(lds, g, S, E); }
    }
}

__global__ void __launch_bounds__(512, 2) mega_fwd(Args a) {
    extern __shared__ __attribute__((aligned(16))) unsigned char lds_raw[];
    LAS unsigned char* lds = (LAS unsigned char*)lds_raw;
    cg::grid_group grid = cg::this_grid();
    volatile LAS unsigned* misc = (volatile LAS unsigned*)(lds + 143360);
    if (threadIdx.x < 4) misc[threadIdx.x] = 0u;
    if (threadIdx.x == 0) *(volatile LAS unsigned long long*)(lds + 143376) = (unsigned long long)(AWS + WS_PART);
    __syncthreads();
    XcdBarrier bar = xcd_barrier_post((unsigned*)AWS + 4096, misc);
    if (a.ph_lo < 0) grid.sync();
    for (int ph = a.ph_lo; ph < a.ph_hi; ++ph) {
        Args b = a; int phv = ph;
        asm volatile("" : "+s"(b.ws), "+s"(b.out), "+s"(phv));
        int nrep = 1, drymatch = 0;
        if (DRYMASK && phv > 0) { const int q_ = (phv - 1) % 15; const int k_ = (q_ >= 1 && q_ <= 10) ? (q_ - 1) % 5 : 0;
            if (k_ >= 1 && k_ <= 3 && ((DRYMASK >> (k_ - 1)) & 1)) { nrep = 2; drymatch = 1; } }
        if (DUPMASK) { const int q_ = (phv - 1) % 15; bool dup = false;
            if (phv > 0) { if ((DUPMASK & 1) && (q_ == 1 || q_ == 6)) dup = true; if ((DUPMASK & 2) && q_ == 13) dup = true; if ((DUPMASK & 4) && (q_ == 0 || q_ == 12)) dup = true; if ((DUPMASK & 8) && (q_ == 5 || q_ == 10)) dup = true; }
            else if (DUPMASK & 16) dup = true;
            if (dup) nrep = 2; }
        nrep = __builtin_amdgcn_readfirstlane(nrep); drymatch = __builtin_amdgcn_readfirstlane(drymatch);
        for (int rep = 0; rep < nrep; ++rep) {
            run_phase(b, phv, lds, drymatch != 0 && rep == 0);
            if (rep + 1 < nrep) xcd_barrier(bar);
        }
        if (ph + 1 < a.ph_hi) { xcd_barrier(bar); if (DBL_BAR) xcd_barrier(bar); }
    }
    if (DBG_NELEM > 0) {
        xcd_barrier(bar);
        for (size_t i = (size_t)blockIdx.x * 512 + threadIdx.x; i < (size_t)NLAT * DM; i += (size_t)gridDim.x * 512) {
            float v = DBG_F32 ? ((const GAS float*)(AWS + (size_t)DBG_OFF))[i % (size_t)DBG_NELEM] : bf2f(((const GAS bf16_t*)(AWS + (size_t)DBG_OFF))[i % (size_t)DBG_NELEM]);
            if (DBG_NELEM2 > 0) v += bf2f(((const GAS bf16_t*)(AWS + (size_t)DBG_OFF2))[i % (size_t)DBG_NELEM2]);
            AOUT[i] = v; }
    }
}

extern "C" void kernel_launch(void* const* d_in, const int* in_sizes, int n_in, void* d_out, int out_size, void* d_ws, size_t ws_size, hipStream_t stream) {
    static int grid = 0;
    if (grid == 0) {
        int dev = 0, cus = 0, per_cu = 0;
        hipGetDevice(&dev);
        hipDeviceGetAttribute(&cus, hipDeviceAttributeMultiprocessorCount, dev);
        hipFuncSetAttribute((const void*)mega_fwd, hipFuncAttributeMaxDynamicSharedMemorySize, LDS_BYTES);
        hipOccupancyMaxActiveBlocksPerMultiprocessor(&per_cu, (const void*)mega_fwd, 512, LDS_BYTES);
        (void)hipGetLastError();
        if (per_cu < 1) per_cu = 1;
        grid = cus * 1;
        if (ws_size < WS_END) fprintf(stderr, "kernel_launch: workspace too small: %zu < %zu\n", ws_size, (size_t)WS_END);
        if (n_in != 22) fprintf(stderr, "kernel_launch: expected 22 inputs, got %d\n", n_in);
    }
    if (hipMemsetAsync(d_ws, 0, 65536, stream) != hipSuccess) fprintf(stderr, "kernel_launch: memset failed\n");
    Args a{};
    for (int i = 0; i < 22; ++i) a.in[i] = (const float*)d_in[i];
    a.out = (float*)d_out; a.ws = (unsigned char*)d_ws; a.ph_lo = 0; a.ph_hi = DBG_N;
    void* args[] = {&a};
    hipError_t e = hipLaunchCooperativeKernel((const void*)mega_fwd, dim3(grid), dim3(512), args, LDS_BYTES, stream);
    if (e != hipSuccess) fprintf(stderr, "cooperative launch failed: %s (grid %d)\n", hipGetErrorString(e), grid);
}
```
